# Optimizing an MI355X kernel written in HIP

```python
import math
import jax, jax.numpy as jnp
from jax import lax
import numpy as np

D_MODEL = 1024
BATCH = 8
SEQ = 2048
DEPTH = 1
DEC_BATCH = 16
DEC_SEQ = 2048
PAST_LEN = 128

N_META = 16
SSM_HEADS = 16
SSM_HEAD_DIM = 64
D_SSM = SSM_HEADS * SSM_HEAD_DIM
SSM_GROUPS = 2
HEADS_PER_GROUP = SSM_HEADS // SSM_GROUPS
D_STATE = 128
D_CONV = 5
D_CONV_CH = D_SSM + 2 * SSM_GROUPS * D_STATE
CHUNK = 128
META_PAD = CHUNK - N_META
MLA_HEADS = 8
QK_NOPE_DIM = 64
QK_ROPE_DIM = 32
V_HEAD_DIM = 64
Q_LORA_RANK = 384
KV_LORA_RANK = 256
D_ATTN = MLA_HEADS * V_HEAD_DIM
ROPE_THETA = 10000.0
Q_BLOCK = 128
D_MIX = D_SSM + D_ATTN
SPLIT_Z = D_SSM
SPLIT_XBC = SPLIT_Z + D_CONV_CH
SPLIT_DT = SPLIT_XBC + 2 * SSM_HEADS
SPLIT_CQ = SPLIT_DT + Q_LORA_RANK
SPLIT_CKV = SPLIT_CQ + KV_LORA_RANK
D_IN_PROJ = SPLIT_CKV + QK_ROPE_DIM
PEER_HEADS = 8
N_KEYS = 128
N_EXPERTS = N_KEYS * N_KEYS
PEER_TOPK = 16
D_KEY = 256
D_SUBKEY = D_KEY // 2
PEER_BLOCK = 256
DEEPNORM_ALPHA = (2.0 * DEPTH) ** 0.25
DEEPNORM_BETA = (8.0 * DEPTH) ** -0.25
EPS = 1e-5

kernel_name = "hymba_ssd_mla_peer_encoder"


def layer_norm(x, g, b):
    xf = x.astype(jnp.float32)
    mu = jnp.mean(xf, -1, keepdims=True)
    var = jnp.mean(jnp.square(xf - mu), -1, keepdims=True)
    return ((xf - mu) * lax.rsqrt(var + EPS) * g.astype(jnp.float32) + b.astype(jnp.float32)).astype(x.dtype)


def rms_norm(x, g):
    xf = x.astype(jnp.float32)
    ms = jnp.mean(jnp.square(xf), -1, keepdims=True)
    return (xf * lax.rsqrt(ms + EPS) * g.astype(jnp.float32)).astype(x.dtype)


def depthwise_conv(x, w, bias):
    c = x.shape[-1]
    y = lax.conv_general_dilated(x, w[:, None, :].astype(x.dtype), window_strides=(1,),
                                 padding=[(D_CONV // 2, D_CONV // 2)],
                                 dimension_numbers=("NWC", "WIO", "NWC"), feature_group_count=c)
    return y + bias.astype(x.dtype)


def segsum(a):
    t = a.shape[-1]
    cs = jnp.cumsum(a, -1)
    d = cs[..., :, None] - cs[..., None, :]
    mask = jnp.tril(jnp.ones((t, t), dtype=bool))
    return jnp.where(mask, d, -jnp.inf)


def ssd_chunked(xdt, da, bm, cm):
    b, lp = xdt.shape[:2]
    nc = lp // CHUNK
    x = xdt.reshape(b, nc, CHUNK, SSM_GROUPS, HEADS_PER_GROUP, SSM_HEAD_DIM)
    bc = bm.reshape(b, nc, CHUNK, SSM_GROUPS, D_STATE)
    cc = cm.reshape(b, nc, CHUNK, SSM_GROUPS, D_STATE)
    a = da.reshape(b, nc, CHUNK, SSM_GROUPS, HEADS_PER_GROUP).transpose(0, 3, 4, 1, 2)
    a_cs = jnp.cumsum(a, -1)
    lmat = jnp.exp(segsum(a))
    cb = jnp.einsum("bclgn,bcsgn->bcgls", cc, bc)
    y_diag = jnp.einsum("bcgls,bghcls,bcsghp->bclghp", cb, lmat, x)
    decay_states = jnp.exp(a_cs[..., -1:] - a_cs)
    states = jnp.einsum("bclgn,bghcl,bclghp->bcghpn", bc, decay_states, x)
    states = jnp.concatenate([jnp.zeros_like(states[:, :1]), states], axis=1)
    a_last = jnp.pad(a_cs[..., -1], ((0, 0), (0, 0), (0, 0), (1, 0)))
    chunk_decay = jnp.exp(segsum(a_last))
    new_states = jnp.einsum("bghzc,bcghpn->bzghpn", chunk_decay, states)
    prev_states = new_states[:, :-1]
    y_off = jnp.einsum("bclgn,bcghpn,bghcl->bclghp", cc, prev_states, jnp.exp(a_cs))
    return (y_diag + y_off).reshape(b, lp, SSM_GROUPS, HEADS_PER_GROUP, SSM_HEAD_DIM)


def rope_tables(pos):
    half = QK_ROPE_DIM // 2
    inv = ROPE_THETA ** (-jnp.arange(half, dtype=jnp.float32) / half)
    ang = pos[:, None] * inv[None, :]
    return jnp.cos(ang), jnp.sin(ang)


def apply_rope(x, cos, sin):
    x1, x2 = jnp.split(x, 2, axis=-1)
    return jnp.concatenate([x1 * cos - x2 * sin, x1 * sin + x2 * cos], -1).astype(x.dtype)


def block_attention(q_nope, q_rope, k_nope, k_rope, v):
    b, l, h, _ = q_nope.shape
    nb = -(-l // Q_BLOCK)
    pad = nb * Q_BLOCK - l

    def to_blocks(t):
        t = jnp.pad(t, ((0, 0), (0, pad), (0, 0), (0, 0)))
        return t.reshape(b, nb, Q_BLOCK, h, t.shape[-1]).transpose(1, 0, 2, 3, 4)

    scale = 1.0 / math.sqrt(QK_NOPE_DIM + QK_ROPE_DIM)

    def one_block(qb):
        qn, qr = qb
        s = jnp.einsum("bqhd,bkhd->bhqk", qn, k_nope) + jnp.einsum("bqhr,bkr->bhqk", qr, k_rope)
        pr = jax.nn.softmax(s.astype(jnp.float32) * scale, axis=-1)
        return jnp.einsum("bhqk,bkhd->bqhd", pr.astype(v.dtype), v)

    o = lax.map(one_block, (to_blocks(q_nope), to_blocks(q_rope)))
    return o.transpose(1, 0, 2, 3, 4).reshape(b, nb * Q_BLOCK, h, V_HEAD_DIM)[:, :l]


def pad_front(t):
    return jnp.pad(t, [(0, 0), (META_PAD, 0)] + [(0, 0)] * (t.ndim - 2))


def hybrid_mixer(h, pos, p):
    b, l, _ = h.shape
    proj = h @ p["w_in"]
    z = proj[..., :SPLIT_Z]
    xbc = proj[..., SPLIT_Z:SPLIT_XBC]
    dt_raw = proj[..., SPLIT_XBC:SPLIT_DT].astype(jnp.float32)
    c_q = proj[..., SPLIT_DT:SPLIT_CQ]
    c_kv = proj[..., SPLIT_CQ:SPLIT_CKV]
    k_rope = proj[..., SPLIT_CKV:]

    xbc = jax.nn.silu(depthwise_conv(xbc, p["conv_w"], p["conv_b"]))
    xs = xbc[..., :D_SSM].reshape(b, l, SSM_GROUPS, HEADS_PER_GROUP, SSM_HEAD_DIM)
    bm = xbc[..., D_SSM:D_SSM + SSM_GROUPS * D_STATE].reshape(b, l, SSM_GROUPS, D_STATE)
    cm = xbc[..., D_SSM + SSM_GROUPS * D_STATE:].reshape(b, l, SSM_GROUPS, D_STATE)
    gh = (SSM_GROUPS, HEADS_PER_GROUP)
    dt_f = jax.nn.softplus(dt_raw[..., :SSM_HEADS] + p["dt_bias_fwd"].astype(jnp.float32)).reshape(b, l, *gh)
    dt_b = jax.nn.softplus(dt_raw[..., SSM_HEADS:] + p["dt_bias_bwd"].astype(jnp.float32)).reshape(b, l, *gh)
    a_f = -jnp.exp(p["a_log_fwd"].astype(jnp.float32)).reshape(gh)
    a_b = -jnp.exp(p["a_log_bwd"].astype(jnp.float32)).reshape(gh)
    xs_p, bm_p, cm_p = pad_front(xs), pad_front(bm), pad_front(cm)
    dt_f_p, dt_b_p = pad_front(dt_f), pad_front(dt_b)
    y_f = ssd_chunked(xs_p * dt_f_p[..., None], dt_f_p * a_f, bm_p, cm_p)
    flip = lambda t: jnp.flip(t, axis=1)
    y_b = flip(ssd_chunked(flip(xs_p * dt_b_p[..., None]), flip(dt_b_p * a_b), flip(bm_p), flip(cm_p)))
    y = (y_f + y_b)[:, META_PAD:] + p["d_skip"].astype(jnp.float32).reshape(*gh, 1) * xs
    y = y.reshape(b, l, D_SSM).astype(h.dtype)
    y_ssm = rms_norm(y * jax.nn.silu(z), p["ssm_norm_g"])

    q = (rms_norm(c_q, p["q_norm_g"]) @ p["w_uq"]).reshape(b, l, MLA_HEADS, QK_NOPE_DIM + QK_ROPE_DIM)
    kv = (rms_norm(c_kv, p["kv_norm_g"]) @ p["w_ukv"]).reshape(b, l, MLA_HEADS, QK_NOPE_DIM + V_HEAD_DIM)
    cos, sin = rope_tables(pos)
    q_nope = q[..., :QK_NOPE_DIM]
    q_rope = apply_rope(q[..., QK_NOPE_DIM:], cos[:, None, :], sin[:, None, :])
    k_nope = kv[..., :QK_NOPE_DIM]
    v = kv[..., QK_NOPE_DIM:]
    k_rope = apply_rope(k_rope, cos, sin)
    o = block_attention(q_nope, q_rope, k_nope, k_rope, v).reshape(b, l, D_ATTN)
    y_attn = rms_norm(o.astype(h.dtype), p["attn_norm_g"])

    return jnp.concatenate([y_ssm, y_attn], axis=-1) @ p["w_out"]


def peer_ffn(h, p):
    b, l, d = h.shape
    t = b * l
    nblk = -(-t // PEER_BLOCK)
    xt = jnp.pad(h.reshape(t, d), ((0, nblk * PEER_BLOCK - t), (0, 0))).reshape(nblk, PEER_BLOCK, d)
    w_q, sub_keys, u_tab, v_tab = p["peer_w_query"], p["peer_sub_keys"], p["peer_u"], p["peer_v"]

    def block(xb):
        q = (xb @ w_q).reshape(PEER_BLOCK, PEER_HEADS, 2, D_SUBKEY)
        s1 = jnp.einsum("thd,hnd->thn", q[:, :, 0], sub_keys[0]).astype(jnp.float32)
        s2 = jnp.einsum("thd,hnd->thn", q[:, :, 1], sub_keys[1]).astype(jnp.float32)
        v1, i1 = lax.top_k(s1, PEER_TOPK)
        v2, i2 = lax.top_k(s2, PEER_TOPK)
        cand = (v1[..., :, None] + v2[..., None, :]).reshape(PEER_BLOCK, PEER_HEADS, PEER_TOPK * PEER_TOPK)
        cidx = (i1[..., :, None] * N_KEYS + i2[..., None, :]).reshape(PEER_BLOCK, PEER_HEADS, PEER_TOPK * PEER_TOPK)
        top_s, sel = lax.top_k(cand, PEER_TOPK)
        experts = jnp.take_along_axis(cidx, sel, axis=-1)
        g = jax.nn.softmax(top_s, axis=-1)
        u = jnp.take(u_tab, experts, axis=0)
        act = jax.nn.gelu(jnp.einsum("thkd,td->thk", u, xb).astype(jnp.float32), approximate=False)
        ve = jnp.take(v_tab, experts, axis=0)
        return jnp.einsum("thk,thkd->td", (g * act).astype(ve.dtype), ve)

    out = lax.map(block, xt).reshape(nblk * PEER_BLOCK, d)[:t]
    return out.reshape(b, l, d).astype(h.dtype)


def encode(x, meta_tokens, ln_in_g, ln_in_b, layer_params):
    b, s, _ = x.shape
    meta = jnp.broadcast_to(meta_tokens.astype(x.dtype)[None], (b, N_META, D_MODEL))
    h = layer_norm(jnp.concatenate([meta, x], axis=1), ln_in_g, ln_in_b)
    pos = jnp.arange(s + N_META, dtype=jnp.float32)
    for li in range(DEPTH):
        p = {k: w[li] for k, w in layer_params.items()}
        h = layer_norm(DEEPNORM_ALPHA * h + hybrid_mixer(h, pos, p), p["ln1_g"], p["ln1_b"])
        h = layer_norm(DEEPNORM_ALPHA * h + peer_ffn(h, p), p["ln2_g"], p["ln2_b"])
    return h[:, N_META:]


def setup_inputs(seed: int = 0) -> dict:
    key = jax.random.key(seed)
    ks = jax.random.split(key, 32)
    nrm = lambda k, shape, s: jax.random.normal(k, shape, jnp.float32) * s
    gain = lambda k, n: 1.0 + 0.02 * jax.random.normal(k, (DEPTH, n), jnp.float32)
    bias = lambda k, n: 0.02 * jax.random.normal(k, (DEPTH, n), jnp.float32)

    def dt_bias(k):
        dt = jnp.exp(jax.random.uniform(k, (DEPTH, SSM_HEADS), jnp.float32, math.log(1e-3), math.log(1e-1)))
        return dt + jnp.log(-jnp.expm1(-dt))

    return {
        "x_prompt": jax.random.normal(ks[0], (BATCH, SEQ, D_MODEL), jnp.float32),
        "x_sample": jax.random.normal(ks[1], (DEC_BATCH, DEC_SEQ, D_MODEL), jnp.float32),
        "meta_tokens": nrm(ks[2], (N_META, D_MODEL), 1.0),
        "ln_in_g": 1.0 + 0.02 * jax.random.normal(ks[3], (D_MODEL,), jnp.float32),
        "ln_in_b": 0.02 * jax.random.normal(ks[4], (D_MODEL,), jnp.float32),
        "w_in": nrm(ks[5], (DEPTH, D_MODEL, D_IN_PROJ), D_MODEL ** -0.5),
        "conv_w": nrm(ks[6], (DEPTH, D_CONV, D_CONV_CH), D_CONV ** -0.5),
        "conv_b": bias(ks[7], D_CONV_CH),
        "dt_bias_fwd": dt_bias(ks[8]),
        "dt_bias_bwd": dt_bias(ks[9]),
        "a_log_fwd": jnp.log(jax.random.uniform(ks[10], (DEPTH, SSM_HEADS), jnp.float32, 1.0, 16.0)),
        "a_log_bwd": jnp.log(jax.random.uniform(ks[11], (DEPTH, SSM_HEADS), jnp.float32, 1.0, 16.0)),
        "d_skip": gain(ks[12], SSM_HEADS),
        "ssm_norm_g": gain(ks[13], D_SSM),
        "q_norm_g": gain(ks[14], Q_LORA_RANK),
        "w_uq": nrm(ks[15], (DEPTH, Q_LORA_RANK, MLA_HEADS * (QK_NOPE_DIM + QK_ROPE_DIM)), Q_LORA_RANK ** -0.5),
        "kv_norm_g": gain(ks[16], KV_LORA_RANK),
        "w_ukv": nrm(ks[17], (DEPTH, KV_LORA_RANK, MLA_HEADS * (QK_NOPE_DIM + V_HEAD_DIM)), KV_LORA_RANK ** -0.5),
        "attn_norm_g": gain(ks[18], D_ATTN),
        "w_out": nrm(ks[19], (DEPTH, D_MIX, D_MODEL), DEEPNORM_BETA * D_MIX ** -0.5),
        "ln1_g": gain(ks[20], D_MODEL),
        "ln1_b": bias(ks[21], D_MODEL),
        "peer_w_query": nrm(ks[22], (DEPTH, D_MODEL, PEER_HEADS * D_KEY), D_MODEL ** -0.5),
        "peer_sub_keys": nrm(ks[23], (DEPTH, 2, PEER_HEADS, N_KEYS, D_SUBKEY), D_SUBKEY ** -0.5),
        "peer_u": nrm(ks[24], (DEPTH, N_EXPERTS, D_MODEL), D_MODEL ** -0.5),
        "peer_v": nrm(ks[25], (DEPTH, N_EXPERTS, D_MODEL), DEEPNORM_BETA * PEER_HEADS ** -0.5),
        "ln2_g": gain(ks[26], D_MODEL),
        "ln2_b": bias(ks[27], D_MODEL),
    }


def reference(x_prompt, x_sample, meta_tokens, ln_in_g, ln_in_b, w_in, conv_w, conv_b,
              dt_bias_fwd, dt_bias_bwd, a_log_fwd, a_log_bwd, d_skip, ssm_norm_g,
              q_norm_g, w_uq, kv_norm_g, w_ukv, attn_norm_g, w_out, ln1_g, ln1_b,
              peer_w_query, peer_sub_keys, peer_u, peer_v, ln2_g, ln2_b):
    layer_params = dict(w_in=w_in, conv_w=conv_w, conv_b=conv_b, dt_bias_fwd=dt_bias_fwd,
                        dt_bias_bwd=dt_bias_bwd, a_log_fwd=a_log_fwd, a_log_bwd=a_log_bwd,
                        d_skip=d_skip, ssm_norm_g=ssm_norm_g, q_norm_g=q_norm_g, w_uq=w_uq,
                        kv_norm_g=kv_norm_g, w_ukv=w_ukv, attn_norm_g=attn_norm_g, w_out=w_out,
                        ln1_g=ln1_g, ln1_b=ln1_b, peer_w_query=peer_w_query,
                        peer_sub_keys=peer_sub_keys, peer_u=peer_u, peer_v=peer_v,
                        ln2_g=ln2_g, ln2_b=ln2_b)
    y_prompt = encode(x_prompt, meta_tokens, ln_in_g, ln_in_b, layer_params)
    y_sample = encode(x_sample, meta_tokens, ln_in_g, ln_in_b, layer_params)
    return (y_prompt, y_sample)
```

```cpp
#include <hip/hip_runtime.h>
#include <hip/hip_cooperative_groups.h>
#include <cstdio>
#include <cstdint>
namespace cg = cooperative_groups;

typedef unsigned short bf16_t;
typedef short bf16x8 __attribute__((ext_vector_type(8)));
typedef float f32x4 __attribute__((ext_vector_type(4)));
typedef float f32x16 __attribute__((ext_vector_type(16)));
typedef unsigned u32x4 __attribute__((ext_vector_type(4)));
typedef unsigned u32x2 __attribute__((ext_vector_type(2)));

#define NTHREADS 512
#define LAS __attribute__((address_space(3)))
constexpr int DM = 1024;
constexpr int NSEQ = 24, SEQ = 2048, NMETA = 16, LSEQ = 2064;
constexpr int TX = NSEQ * SEQ;
constexpr int TM = TX + NMETA;
constexpr int TP = 49408;
constexpr int LP = 2176, NCH = 17, MPAD = 112;
constexpr int DINP = 3328;
constexpr float EPS = 1e-5f;
constexpr float ALPHA = 1.189207115002721f;
constexpr size_t LDS_BYTES = 160 * 1024;

struct Params {
  const float *x_prompt, *x_sample, *meta, *ln_in_g, *ln_in_b, *w_in, *conv_w, *conv_b,
      *dt_bias_f, *dt_bias_b, *a_log_f, *a_log_b, *d_skip, *ssm_norm_g, *q_norm_g, *w_uq, *kv_norm_g, *w_ukv,
      *attn_norm_g, *w_out, *ln1_g, *ln1_b, *peer_wq, *peer_sk, *peer_u, *peer_v, *ln2_g, *ln2_b;
  float* out;
  bf16_t *h0, *WinT, *WuqT, *WkT, *WvT, *WoutT, *WpT, *z, *xbc_raw, *rest, *cqn, *ckvn, *kr;
  float *dtv, *Pv, *Atot;
  bf16_t *XT, *Cm, *Bm, *BmT;
  bf16_t *q, *Kb, *vT, *o, *Y, *Yb2, *ycat, *h1;
  unsigned char *Uq, *Vq;
  unsigned char* h1q;
  float *su, *sv, *sx;
  bf16_t* pd;
  bf16_t* pre2;
  unsigned char* cq;
  float* csc;
  unsigned* bar;
  bf16_t* pre;
  unsigned short* experts;
  float* gates;
};

__device__ __forceinline__ int phase_tid() { int t = threadIdx.x; asm volatile("" : "+v"(t)); return t; }
__device__ __forceinline__ void lds_barrier() {
  asm volatile("s_waitcnt lgkmcnt(0)" ::: "memory");
  __builtin_amdgcn_s_barrier();
  asm volatile("" ::: "memory");
}
__device__ __forceinline__ float bf2f(bf16_t v) { return __uint_as_float(((unsigned)v) << 16); }
__device__ __forceinline__ float bflo(unsigned v) { return __uint_as_float(v << 16); }
__device__ __forceinline__ float bfhi(unsigned v) { return __uint_as_float(v & 0xffff0000u); }
typedef __bf16 bf16x2_t __attribute__((ext_vector_type(2)));
typedef float f32x2_t __attribute__((ext_vector_type(2)));
__device__ __forceinline__ unsigned pk_bf16(float lo, float hi) {
  f32x2_t f = {lo, hi};
  bf16x2_t b = __builtin_convertvector(f, bf16x2_t);
  return __builtin_bit_cast(unsigned, b);
}
__device__ __forceinline__ bf16_t f2bf(float f) { return (bf16_t)(pk_bf16(f, 0.f) & 0xffffu); }
__device__ __forceinline__ float wave_sum(float v) {
#pragma unroll
  for (int o = 32; o >= 1; o >>= 1) v += __shfl_xor(v, o);
  return v;
}
__device__ __forceinline__ float silu_f(float x) { return x * __builtin_amdgcn_rcpf(1.f + __expf(-x)); }
__device__ __forceinline__ int row_of(int seq, int pos) { return pos < NMETA ? TX + pos : seq * SEQ + pos - NMETA; }
__device__ __forceinline__ bf16x8 as_bf16x8(u32x4 v) { return __builtin_bit_cast(bf16x8, v); }

__device__ void transpose_convert(const float* in, bf16_t* out, int R, int C, int CP, char* smem) {
  float* tile = (float*)smem;
  const int tr = (R + 63) / 64, tc = (CP + 63) / 64;
  for (int t = blockIdx.x; t < tr * tc; t += gridDim.x) {
    const int r0 = (t / tc) * 64, c0 = (t % tc) * 64;
    __syncthreads();
    for (int i = phase_tid(); i < 4096; i += NTHREADS) {
      int r = i >> 6, c = i & 63;
      float v = 0.f;
      if (r0 + r < R && c0 + c < C) v = in[(size_t)(r0 + r) * C + c0 + c];
      tile[r * 65 + c] = v;
    }
    __syncthreads();
    for (int i = phase_tid(); i < 4096; i += NTHREADS) {
      int c = i >> 6, r = i & 63;
      if (r0 + r < R && c0 + c < CP) out[(size_t)(c0 + c) * R + r0 + r] = f2bf(tile[r * 65 + c]);
    }
  }
}

__device__ void fold_peer(const Params& p, char* smem) {
  float* wq_s = (float*)smem;
  float* sk_s = wq_s + 32 * 128;
  for (int item = blockIdx.x; item < 16 * 32; item += gridDim.x) {
    const int hj2 = item >> 5, k0 = (item & 31) * 32;
    const int h = hj2 >> 1, j = hj2 & 1;
    const float* skp = p.peer_sk + (size_t)(j * 8 + h) * 128 * 128;
    __syncthreads();
    for (int i = phase_tid(); i < 32 * 128; i += NTHREADS) {
      int k = i >> 7, d = i & 127;
      wq_s[i] = p.peer_wq[(size_t)(k0 + k) * 2048 + hj2 * 128 + d];
    }
    for (int i = phase_tid(); i < 128 * 128; i += NTHREADS) {
      int n = i >> 7, d = i & 127;
      sk_s[n * 129 + d] = skp[i];
    }
    __syncthreads();
    const int n = phase_tid() & 127, kq = phase_tid() >> 7;
    float acc[8];
#pragma unroll
    for (int i = 0; i < 8; ++i) acc[i] = 0.f;
    for (int d = 0; d < 128; ++d) {
      float s = sk_s[n * 129 + d];
#pragma unroll
      for (int i = 0; i < 8; ++i) acc[i] += wq_s[(kq * 8 + i) * 128 + d] * s;
    }
    u32x4 v;
    v[0] = pk_bf16(acc[0], acc[1]); v[1] = pk_bf16(acc[2], acc[3]);
    v[2] = pk_bf16(acc[4], acc[5]); v[3] = pk_bf16(acc[6], acc[7]);
    *(u32x4*)(p.WpT + (size_t)(hj2 * 128 + n) * 1024 + k0 + kq * 8) = v;
  }
}

__device__ void ln_in_phase(const Params& p) {
  const int lane = phase_tid() & 63, wid = phase_tid() >> 6;
  const int stride = gridDim.x * 8;
  auto src_of = [&](int row) -> const float* {
    return row < 8 * SEQ ? p.x_prompt + (size_t)row * DM : row < TX ? p.x_sample + (size_t)(row - 8 * SEQ) * DM : p.meta + (size_t)(row - TX) * DM;
  };
  int row = blockIdx.x * 8 + wid;
  f32x4 nx[4];
  if (row < TM) { const float* sp = src_of(row);
#pragma unroll
    for (int c = 0; c < 4; ++c) nx[c] = *(const f32x4*)(sp + c * 256 + lane * 4); }
  for (; row < TP; row += stride) {
    bf16_t* dst = p.h0 + (size_t)row * DM;
    if (row >= TM) {
      u32x4 zv = {0u, 0u, 0u, 0u};
      *(u32x4*)(dst + lane * 8) = zv; *(u32x4*)(dst + 512 + lane * 8) = zv;
      continue;
    }
    float v[16];
#pragma unroll
    for (int c = 0; c < 4; ++c)
#pragma unroll
      for (int j = 0; j < 4; ++j) v[c * 4 + j] = nx[c][j];
    if (row + stride < TM) { const float* sp = src_of(row + stride);
#pragma unroll
      for (int c = 0; c < 4; ++c) nx[c] = *(const f32x4*)(sp + c * 256 + lane * 4); }
    float s = 0.f;
#pragma unroll
    for (int j = 0; j < 16; ++j) s += v[j];
    const float mu = wave_sum(s) * (1.f / DM);
    float s2 = 0.f;
#pragma unroll
    for (int j = 0; j < 16; ++j) { float d = v[j] - mu; s2 += d * d; }
    const float rstd = rsqrtf(wave_sum(s2) * (1.f / DM) + EPS);
#pragma unroll
    for (int c = 0; c < 4; ++c) {
      const f32x4 g = *(const f32x4*)(p.ln_in_g + c * 256 + lane * 4), bb = *(const f32x4*)(p.ln_in_b + c * 256 + lane * 4);
      float o[4];
#pragma unroll
      for (int j = 0; j < 4; ++j) o[j] = (v[c * 4 + j] - mu) * rstd * g[j] + bb[j];
      *(u32x2*)(dst + c * 256 + lane * 4) = (u32x2){pk_bf16(o[0], o[1]), pk_bf16(o[2], o[3])};
    }
  }
}

__device__ __forceinline__ u32x4 pack8(const float (&v)[8]) {
  u32x4 w;
  w[0] = pk_bf16(v[0], v[1]); w[1] = pk_bf16(v[2], v[3]); w[2] = pk_bf16(v[4], v[5]); w[3] = pk_bf16(v[6], v[7]);
  return w;
}
__device__ __forceinline__ unsigned fkey(float f) {
  unsigned u = __float_as_uint(f);
  return u ^ (((unsigned)((int)u >> 31)) | 0x80000000u);
}
__device__ __forceinline__ float keyf(unsigned k) {
  unsigned u = (k & 0x80000000u) ? (k ^ 0x80000000u) : ~k;
  return __uint_as_float(u);
}
__device__ __forceinline__ void sort16_desc(unsigned (&v)[16]) {
  { unsigned _h = max(v[0], v[1]); v[1] = min(v[0], v[1]); v[0] = _h; }
  { unsigned _h = max(v[2], v[3]); v[2] = min(v[2], v[3]); v[3] = _h; }
  { unsigned _h = max(v[4], v[5]); v[5] = min(v[4], v[5]); v[4] = _h; }
  { unsigned _h = max(v[6], v[7]); v[6] = min(v[6], v[7]); v[7] = _h; }
  { unsigned _h = max(v[8], v[9]); v[9] = min(v[8], v[9]); v[8] = _h; }
  { unsigned _h = max(v[10], v[11]); v[10] = min(v[10], v[11]); v[11] = _h; }
  { unsigned _h = max(v[12], v[13]); v[13] = min(v[12], v[13]); v[12] = _h; }
  { unsigned _h = max(v[14], v[15]); v[14] = min(v[14], v[15]); v[15] = _h; }
  { unsigned _h = max(v[0], v[2]); v[2] = min(v[0], v[2]); v[0] = _h; }
  { unsigned _h = max(v[1], v[3]); v[3] = min(v[1], v[3]); v[1] = _h; }
  { unsigned _h = max(v[4], v[6]); v[4] = min(v[4], v[6]); v[6] = _h; }
  { unsigned _h = max(v[5], v[7]); v[5] = min(v[5], v[7]); v[7] = _h; }
  { unsigned _h = max(v[8], v[10]); v[10] = min(v[8], v[10]); v[8] = _h; }
  { unsigned _h = max(v[9], v[11]); v[11] = min(v[9], v[11]); v[9] = _h; }
  { unsigned _h = max(v[12], v[14]); v[12] = min(v[12], v[14]); v[14] = _h; }
  { unsigned _h = max(v[13], v[15]); v[13] = min(v[13], v[15]); v[15] = _h; }
  { unsigned _h = max(v[0], v[1]); v[1] = min(v[0], v[1]); v[0] = _h; }
  { unsigned _h = max(v[2], v[3]); v[3] = min(v[2], v[3]); v[2] = _h; }
  { unsigned _h = max(v[4], v[5]); v[4] = min(v[4], v[5]); v[5] = _h; }
  { unsigned _h = max(v[6], v[7]); v[6] = min(v[6], v[7]); v[7] = _h; }
  { unsigned _h = max(v[8], v[9]); v[9] = min(v[8], v[9]); v[8] = _h; }
  { unsigned _h = max(v[10], v[11]); v[11] = min(v[10], v[11]); v[10] = _h; }
  { unsigned _h = max(v[12], v[13]); v[12] = min(v[12], v[13]); v[13] = _h; }
  { unsigned _h = max(v[14], v[15]); v[14] = min(v[14], v[15]); v[15] = _h; }
  { unsigned _h = max(v[0], v[4]); v[4] = min(v[0], v[4]); v[0] = _h; }
  { unsigned _h = max(v[1], v[5]); v[5] = min(v[1], v[5]); v[1] = _h; }
  { unsigned _h = max(v[2], v[6]); v[6] = min(v[2], v[6]); v[2] = _h; }
  { unsigned _h = max(v[3], v[7]); v[7] = min(v[3], v[7]); v[3] = _h; }
  { unsigned _h = max(v[8], v[12]); v[8] = min(v[8], v[12]); v[12] = _h; }
  { unsigned _h = max(v[9], v[13]); v[9] = min(v[9], v[13]); v[13] = _h; }
  { unsigned _h = max(v[10], v[14]); v[10] = min(v[10], v[14]); v[14] = _h; }
  { unsigned _h = max(v[11], v[15]); v[11] = min(v[11], v[15]); v[15] = _h; }
  { unsigned _h = max(v[0], v[2]); v[2] = min(v[0], v[2]); v[0] = _h; }
  { unsigned _h = max(v[1], v[3]); v[3] = min(v[1], v[3]); v[1] = _h; }
  { unsigned _h = max(v[4], v[6]); v[6] = min(v[4], v[6]); v[4] = _h; }
  { unsigned _h = max(v[5], v[7]); v[7] = min(v[5], v[7]); v[5] = _h; }
  { unsigned _h = max(v[8], v[10]); v[8] = min(v[8], v[10]); v[10] = _h; }
  { unsigned _h = max(v[9], v[11]); v[9] = min(v[9], v[11]); v[11] = _h; }
  { unsigned _h = max(v[12], v[14]); v[12] = min(v[12], v[14]); v[14] = _h; }
  { unsigned _h = max(v[13], v[15]); v[13] = min(v[13], v[15]); v[15] = _h; }
  { unsigned _h = max(v[0], v[1]); v[1] = min(v[0], v[1]); v[0] = _h; }
  { unsigned _h = max(v[2], v[3]); v[3] = min(v[2], v[3]); v[2] = _h; }
  { unsigned _h = max(v[4], v[5]); v[5] = min(v[4], v[5]); v[4] = _h; }
  { unsigned _h = max(v[6], v[7]); v[7] = min(v[6], v[7]); v[6] = _h; }
  { unsigned _h = max(v[8], v[9]); v[8] = min(v[8], v[9]); v[9] = _h; }
  { unsigned _h = max(v[10], v[11]); v[10] = min(v[10], v[11]); v[11] = _h; }
  { unsigned _h = max(v[12], v[13]); v[12] = min(v[12], v[13]); v[13] = _h; }
  { unsigned _h = max(v[14], v[15]); v[14] = min(v[14], v[15]); v[15] = _h; }
  { unsigned _h = max(v[0], v[8]); v[8] = min(v[0], v[8]); v[0] = _h; }
  { unsigned _h = max(v[1], v[9]); v[9] = min(v[1], v[9]); v[1] = _h; }
  { unsigned _h = max(v[2], v[10]); v[10] = min(v[2], v[10]); v[2] = _h; }
  { unsigned _h = max(v[3], v[11]); v[11] = min(v[3], v[11]); v[3] = _h; }
  { unsigned _h = max(v[4], v[12]); v[12] = min(v[4], v[12]); v[4] = _h; }
  { unsigned _h = max(v[5], v[13]); v[13] = min(v[5], v[13]); v[5] = _h; }
  { unsigned _h = max(v[6], v[14]); v[14] = min(v[6], v[14]); v[6] = _h; }
  { unsigned _h = max(v[7], v[15]); v[15] = min(v[7], v[15]); v[7] = _h; }
  { unsigned _h = max(v[0], v[4]); v[4] = min(v[0], v[4]); v[0] = _h; }
  { unsigned _h = max(v[1], v[5]); v[5] = min(v[1], v[5]); v[1] = _h; }
  { unsigned _h = max(v[2], v[6]); v[6] = min(v[2], v[6]); v[2] = _h; }
  { unsigned _h = max(v[3], v[7]); v[7] = min(v[3], v[7]); v[3] = _h; }
  { unsigned _h = max(v[8], v[12]); v[12] = min(v[8], v[12]); v[8] = _h; }
  { unsigned _h = max(v[9], v[13]); v[13] = min(v[9], v[13]); v[9] = _h; }
  { unsigned _h = max(v[10], v[14]); v[14] = min(v[10], v[14]); v[10] = _h; }
  { unsigned _h = max(v[11], v[15]); v[15] = min(v[11], v[15]); v[11] = _h; }
  { unsigned _h = max(v[0], v[2]); v[2] = min(v[0], v[2]); v[0] = _h; }
  { unsigned _h = max(v[1], v[3]); v[3] = min(v[1], v[3]); v[1] = _h; }
  { unsigned _h = max(v[4], v[6]); v[6] = min(v[4], v[6]); v[4] = _h; }
  { unsigned _h = max(v[5], v[7]); v[7] = min(v[5], v[7]); v[5] = _h; }
  { unsigned _h = max(v[8], v[10]); v[10] = min(v[8], v[10]); v[8] = _h; }
  { unsigned _h = max(v[9], v[11]); v[11] = min(v[9], v[11]); v[9] = _h; }
  { unsigned _h = max(v[12], v[14]); v[14] = min(v[12], v[14]); v[12] = _h; }
  { unsigned _h = max(v[13], v[15]); v[15] = min(v[13], v[15]); v[13] = _h; }
  { unsigned _h = max(v[0], v[1]); v[1] = min(v[0], v[1]); v[0] = _h; }
  { unsigned _h = max(v[2], v[3]); v[3] = min(v[2], v[3]); v[2] = _h; }
  { unsigned _h = max(v[4], v[5]); v[5] = min(v[4], v[5]); v[4] = _h; }
  { unsigned _h = max(v[6], v[7]); v[7] = min(v[6], v[7]); v[6] = _h; }
  { unsigned _h = max(v[8], v[9]); v[9] = min(v[8], v[9]); v[8] = _h; }
  { unsigned _h = max(v[10], v[11]); v[11] = min(v[10], v[11]); v[10] = _h; }
  { unsigned _h = max(v[12], v[13]); v[13] = min(v[12], v[13]); v[12] = _h; }
  { unsigned _h = max(v[14], v[15]); v[15] = min(v[14], v[15]); v[14] = _h; }
}
__device__ __forceinline__ void merge16_desc(unsigned (&v)[16], const unsigned (&o)[16]) {
  v[0] = max(v[0], o[15]);
  v[1] = max(v[1], o[14]);
  v[2] = max(v[2], o[13]);
  v[3] = max(v[3], o[12]);
  v[4] = max(v[4], o[11]);
  v[5] = max(v[5], o[10]);
  v[6] = max(v[6], o[9]);
  v[7] = max(v[7], o[8]);
  v[8] = max(v[8], o[7]);
  v[9] = max(v[9], o[6]);
  v[10] = max(v[10], o[5]);
  v[11] = max(v[11], o[4]);
  v[12] = max(v[12], o[3]);
  v[13] = max(v[13], o[2]);
  v[14] = max(v[14], o[1]);
  v[15] = max(v[15], o[0]);
  { unsigned _h = max(v[0], v[8]); v[8] = min(v[0], v[8]); v[0] = _h; }
  { unsigned _h = max(v[1], v[9]); v[9] = min(v[1], v[9]); v[1] = _h; }
  { unsigned _h = max(v[2], v[10]); v[10] = min(v[2], v[10]); v[2] = _h; }
  { unsigned _h = max(v[3], v[11]); v[11] = min(v[3], v[11]); v[3] = _h; }
  { unsigned _h = max(v[4], v[12]); v[12] = min(v[4], v[12]); v[4] = _h; }
  { unsigned _h = max(v[5], v[13]); v[13] = min(v[5], v[13]); v[5] = _h; }
  { unsigned _h = max(v[6], v[14]); v[14] = min(v[6], v[14]); v[6] = _h; }
  { unsigned _h = max(v[7], v[15]); v[15] = min(v[7], v[15]); v[7] = _h; }
  { unsigned _h = max(v[0], v[4]); v[4] = min(v[0], v[4]); v[0] = _h; }
  { unsigned _h = max(v[1], v[5]); v[5] = min(v[1], v[5]); v[1] = _h; }
  { unsigned _h = max(v[2], v[6]); v[6] = min(v[2], v[6]); v[2] = _h; }
  { unsigned _h = max(v[3], v[7]); v[7] = min(v[3], v[7]); v[3] = _h; }
  { unsigned _h = max(v[8], v[12]); v[12] = min(v[8], v[12]); v[8] = _h; }
  { unsigned _h = max(v[9], v[13]); v[13] = min(v[9], v[13]); v[9] = _h; }
  { unsigned _h = max(v[10], v[14]); v[14] = min(v[10], v[14]); v[10] = _h; }
  { unsigned _h = max(v[11], v[15]); v[15] = min(v[11], v[15]); v[11] = _h; }
  { unsigned _h = max(v[0], v[2]); v[2] = min(v[0], v[2]); v[0] = _h; }
  { unsigned _h = max(v[1], v[3]); v[3] = min(v[1], v[3]); v[1] = _h; }
  { unsigned _h = max(v[4], v[6]); v[6] = min(v[4], v[6]); v[4] = _h; }
  { unsigned _h = max(v[5], v[7]); v[7] = min(v[5], v[7]); v[5] = _h; }
  { unsigned _h = max(v[8], v[10]); v[10] = min(v[8], v[10]); v[8] = _h; }
  { unsigned _h = max(v[9], v[11]); v[11] = min(v[9], v[11]); v[9] = _h; }
  { unsigned _h = max(v[12], v[14]); v[14] = min(v[12], v[14]); v[12] = _h; }
  { unsigned _h = max(v[13], v[15]); v[15] = min(v[13], v[15]); v[13] = _h; }
  { unsigned _h = max(v[0], v[1]); v[1] = min(v[0], v[1]); v[0] = _h; }
  { unsigned _h = max(v[2], v[3]); v[3] = min(v[2], v[3]); v[2] = _h; }
  { unsigned _h = max(v[4], v[5]); v[5] = min(v[4], v[5]); v[4] = _h; }
  { unsigned _h = max(v[6], v[7]); v[7] = min(v[6], v[7]); v[6] = _h; }
  { unsigned _h = max(v[8], v[9]); v[9] = min(v[8], v[9]); v[8] = _h; }
  { unsigned _h = max(v[10], v[11]); v[11] = min(v[10], v[11]); v[10] = _h; }
  { unsigned _h = max(v[12], v[13]); v[13] = min(v[12], v[13]); v[12] = _h; }
  { unsigned _h = max(v[14], v[15]); v[15] = min(v[14], v[15]); v[14] = _h; }
}
#define TOPK_INSERT_FROM(V, X, J0) { _Pragma("unroll") for (int _j = (J0); _j < 16; ++_j) { unsigned _hi = max(V[_j], X); X = min(V[_j], X); V[_j] = _hi; } }
#define TOPK_INSERT(V, X) { _Pragma("unroll") for (int _j = 0; _j < 16; ++_j) { unsigned _hi = max(V[_j], X); X = min(V[_j], X); V[_j] = _hi; } }

namespace pg8 {
constexpr int BM = 256, BK = 64, HALF = 128, HTB = HALF * BK * 2, STAGE_BYTES = 8 * HTB, NXCD = 8, WGM = 8;
__device__ __forceinline__ int lds_byte(int r, int c) { const int st = (r >> 4) * 2 + (c >> 5), rr = r & 15, cc = c & 31, ob = rr * 64 + cc * 2; return st * 1024 + (ob ^ (((ob >> 9) & 1) << 5)); }
__device__ __forceinline__ void stage_rc(int b, int& R, int& C) { const int st = b / 1024, sb = b % 1024, swz = sb ^ (((sb >> 9) & 1) << 5); R = (st >> 1) * 16 + swz / 64; C = (st & 1) * 32 + (swz % 64) / 2; }
__device__ __forceinline__ int perm32(int rho) { const int n = rho >> 4, i = rho & 15; return 8 * (i >> 2) + 4 * n + (i & 3); }
struct Unit { int pm, pn; };
struct Gemm { const bf16_t* A; const bf16_t* Bt; int M, N, K; };
struct StaticOrder {
  int nM, nN, nwg, G, c;
  __device__ void init(int M, int N, int G_, int c_) { nM = M / BM; nN = N / BM; nwg = nM * nN; G = G_; c = c_; }
  __device__ bool next(int i, Unit& u) const {
    const long L = (long)i * G + c; if (L >= nwg) return false;
    int wgid = (int)L; { const int q = nwg / NXCD, r = nwg % NXCD, xcd = wgid % NXCD, off = wgid / NXCD; wgid = (xcd < r ? xcd * (q + 1) : r * (q + 1) + (xcd - r) * q) + off; }
    const int nig = WGM * nN, gid = wgid / nig, fm = gid * WGM, gsz = (nM - fm) < WGM ? (nM - fm) : WGM;
    u.pm = fm + ((wgid % nig) % gsz); u.pn = (wgid % nig) / gsz; return true;
  }
  __device__ __forceinline__ void a_ready(const Unit&) const {}
  __device__ __forceinline__ void done(const Unit&) const {}
};
template <class Epi, class Sched>
__device__ __forceinline__ void gemm_phase(LAS unsigned char* lds, const Gemm g, const Sched& S, const Epi& E) {
  const int tid = phase_tid(), wid = __builtin_amdgcn_readfirstlane(tid >> 6), lane = tid & 63, wr = wid >> 2, wc = wid & 3, fr = lane & 15, fq = lane >> 4;
  const int K = g.K, nt = K / BK;
  unsigned voffA[2], voffB[2];
#pragma unroll
  for (int i = 0; i < 2; ++i) { int R, C; stage_rc(tid * 16 + i * 8192, R, C); const int Rb = Epi::PERM ? ((R & ~31) + perm32(R & 31)) : R;
    voffA[i] = (unsigned)(R * K + C) * 2u; voffB[i] = (unsigned)(Rb * K + C) * 2u; }
  const size_t kstep = (size_t)(BK * 2);
  const size_t hstep = (size_t)HALF * K * 2;
  const size_t tstep = 2 * hstep;
  const unsigned ldsw = (unsigned)wid * 1024u;
  const int aoff = lds_byte(wr * 64 + fr, fq * 8), boff = lds_byte(wc * 32 + fr, fq * 8);
#define PG8_SA(b, h) (((b) * 2 + (h)) * HTB)
#define PG8_SB(b, h) ((4 + (b) * 2 + (h)) * HTB)
#define PG8_STAGE(bufoff, gbase, voff) do { _Pragma("unroll") for (int _i = 0; _i < 2; ++_i) \
    __builtin_amdgcn_global_load_lds((const unsigned*)((const char*)(gbase) + (voff)[_i]), (LAS unsigned*)(lds + (bufoff) + ldsw + _i * 8192), 16, 0, 0); } while (0)
#define PG8_LDA(dst, b, h) do { _Pragma("unroll") for (int m = 0; m < 4; ++m) _Pragma("unroll") for (int k = 0; k < 2; ++k) dst[m][k] = *(const LAS bf16x8*)(lds + PG8_SA(b, h) + aoff + m * 2048 + k * 1024); } while (0)
#define PG8_LDB(dst, b, h) do { _Pragma("unroll") for (int n = 0; n < 2; ++n) _Pragma("unroll") for (int k = 0; k < 2; ++k) dst[n][k] = *(const LAS bf16x8*)(lds + PG8_SB(b, h) + boff + n * 2048 + k * 1024); } while (0)
#define PG8_MMA(ai, bj, At, Bt) do { __builtin_amdgcn_s_setprio(1); _Pragma("unroll") for (int m = 0; m < 4; ++m) _Pragma("unroll") for (int n = 0; n < 2; ++n) _Pragma("unroll") for (int k = 0; k < 2; ++k) \
    acc[ai][bj][m][n] = __builtin_amdgcn_mfma_f32_16x16x32_bf16(Bt[n][k], At[m][k], acc[ai][bj][m][n], 0, 0, 0); __builtin_amdgcn_s_setprio(0); } while (0)
#define PG8_WAIT_V(n) asm volatile("s_waitcnt vmcnt(" #n ")" ::: "memory")
#define PG8_WAIT_L(n) asm volatile("s_waitcnt lgkmcnt(" #n ")" ::: "memory")
#define PG8_BAR __builtin_amdgcn_s_barrier()
#define PG8_SCHED __builtin_amdgcn_sched_barrier(0)
  Unit cur, nxt; int ui = 0;
  if (!S.next(0, cur)) return;
  f32x4 acc[2][2][4][2];
#pragma unroll
  for (int a = 0; a < 2; ++a)
#pragma unroll
    for (int b = 0; b < 2; ++b)
#pragma unroll
      for (int m = 0; m < 4; ++m)
#pragma unroll
        for (int n = 0; n < 2; ++n) acc[a][b][m][n] = (f32x4){0.f, 0.f, 0.f, 0.f};
  bf16x8 At[4][2], B0[2][2], B1[2][2];
  const char* cA = (const char*)g.A + (size_t)cur.pm * tstep; const char* cB = (const char*)g.Bt + (size_t)cur.pn * tstep;
  S.a_ready(cur);
  PG8_STAGE(PG8_SB(0, 0), cB, voffB); PG8_STAGE(PG8_SA(0, 0), cA, voffA); PG8_STAGE(PG8_SB(0, 1), cB + hstep, voffB); PG8_STAGE(PG8_SA(0, 1), cA + hstep, voffA);
  if (wr == 1) PG8_BAR;
  PG8_WAIT_V(4); PG8_BAR;
  PG8_STAGE(PG8_SB(1, 0), cB + kstep, voffB); PG8_STAGE(PG8_SA(1, 0), cA + kstep, voffA); PG8_STAGE(PG8_SB(1, 1), cB + hstep + kstep, voffB);
  PG8_WAIT_V(6); PG8_BAR;
  for (;;) {
    const bool has_next = S.next(ui + 1, nxt);
    const char* nA = has_next ? (const char*)g.A + (size_t)nxt.pm * tstep : cA; const char* nB = has_next ? (const char*)g.Bt + (size_t)nxt.pn * tstep : cB;
    for (int t = 0; t < nt; t += 2) {
      const bool last = (t == nt - 2);
      const char* a1 = cA + (size_t)(t + 1) * kstep;
      const char* a2 = last ? nA : cA + (size_t)(t + 2) * kstep; const char* b2 = last ? nB : cB + (size_t)(t + 2) * kstep;
      const char* a3 = a2 + kstep; const char* b3 = b2 + kstep;
      if (last && has_next) S.a_ready(nxt);
      PG8_LDB(B0, 0, 0); PG8_SCHED; PG8_LDA(At, 0, 0); PG8_STAGE(PG8_SA(1, 1), a1 + hstep, voffA);
      PG8_WAIT_L(8); PG8_BAR; PG8_WAIT_L(0); PG8_MMA(0, 0, At, B0); PG8_BAR; PG8_SCHED;
      PG8_LDB(B1, 0, 1); PG8_STAGE(PG8_SB(0, 0), b2, voffB);
      PG8_BAR; PG8_WAIT_L(0); PG8_MMA(0, 1, At, B1); PG8_BAR;
      PG8_LDA(At, 0, 1); PG8_STAGE(PG8_SA(0, 0), a2, voffA);
      PG8_BAR; PG8_WAIT_L(0); PG8_MMA(1, 0, At, B0); PG8_BAR; PG8_SCHED;
      PG8_STAGE(PG8_SB(0, 1), b2 + hstep, voffB);
      PG8_WAIT_V(6); PG8_BAR; PG8_MMA(1, 1, At, B1); PG8_BAR;
      PG8_LDB(B0, 1, 0); PG8_SCHED; PG8_LDA(At, 1, 0); PG8_STAGE(PG8_SA(0, 1), a2 + hstep, voffA);
      PG8_WAIT_L(8); PG8_BAR; PG8_WAIT_L(0); PG8_MMA(0, 0, At, B0); PG8_BAR; PG8_SCHED;
      PG8_LDB(B1, 1, 1); PG8_STAGE(PG8_SB(1, 0), b3, voffB);
      PG8_BAR; PG8_WAIT_L(0); PG8_MMA(0, 1, At, B1); PG8_BAR;
      PG8_LDA(At, 1, 1); PG8_STAGE(PG8_SA(1, 0), a3, voffA);
      PG8_BAR; PG8_WAIT_L(0); PG8_MMA(1, 0, At, B0); PG8_BAR; PG8_SCHED;
      PG8_STAGE(PG8_SB(1, 1), b3 + hstep, voffB);
      PG8_WAIT_V(6); PG8_BAR; PG8_MMA(1, 1, At, B1); PG8_BAR;
    }
    if constexpr (!Epi::AFTER_DRAIN) { E(acc, cur, wr, wc, fr, fq); S.done(cur); }
    if (!has_next) break;
#pragma unroll
    for (int a = 0; a < 2; ++a)
#pragma unroll
      for (int b = 0; b < 2; ++b)
#pragma unroll
        for (int m = 0; m < 4; ++m)
#pragma unroll
          for (int n = 0; n < 2; ++n) acc[a][b][m][n] = (f32x4){0.f, 0.f, 0.f, 0.f};
    cur = nxt; cA = nA; cB = nB; ++ui;
  }
  PG8_WAIT_V(0);
  if (wr == 0) PG8_BAR;
  PG8_BAR;
  if constexpr (Epi::AFTER_DRAIN) { E.fused(acc, cur, wr, wc, fr, fq, (char*)lds); S.done(cur); }
#undef PG8_SA
#undef PG8_SB
#undef PG8_STAGE
#undef PG8_LDA
#undef PG8_LDB
#undef PG8_MMA
#undef PG8_WAIT_V
#undef PG8_WAIT_L
#undef PG8_BAR
#undef PG8_SCHED
}
struct EpiBf16S {
  static constexpr bool PERM = true, AFTER_DRAIN = false;
  bf16_t* d0; int ld0; int c0; bf16_t* d1; int ld1; int c1; bf16_t* d2; int ld2;
  __device__ __forceinline__ void operator()(const f32x4 (&acc)[2][2][4][2], const Unit& u, int wr, int wc, int fr, int fq) const {
    const int colt = u.pn * BM;
    bf16_t* base; int ld;
    if (colt < c0) { base = d0 + colt; ld = ld0; } else if (colt < c1) { base = d1 + (colt - c0); ld = ld1; } else { base = d2 + (colt - c1); ld = ld2; }
    const int L = fq * 16 + fr;
    const int srcl = ((L & 3) * 16 + (L >> 2)) * 4;
    const int row0 = u.pm * BM + wr * 64 + (L >> 2), col0 = wc * 32 + 8 * (L & 3);
#pragma unroll
    for (int ai = 0; ai < 2; ++ai)
#pragma unroll
      for (int m = 0; m < 4; ++m) {
        bf16_t* rowp = base + (size_t)(row0 + ai * HALF + m * 16) * ld + col0;
#pragma unroll
        for (int bj = 0; bj < 2; ++bj) {
          const f32x4 v0 = acc[ai][bj][m][0], v1 = acc[ai][bj][m][1];
          u32x4 w; w[0] = pk_bf16(v0[0], v0[1]); w[1] = pk_bf16(v0[2], v0[3]); w[2] = pk_bf16(v1[0], v1[1]); w[3] = pk_bf16(v1[2], v1[3]);
          u32x4 x;
#pragma unroll
          for (int k = 0; k < 4; ++k) x[k] = (unsigned)__builtin_amdgcn_ds_bpermute(srcl, (int)w[k]);
          *(u32x4*)(rowp + bj * HALF) = x;
        }
      }
  }
};
struct EpiOutRes {
  static constexpr bool PERM = true, AFTER_DRAIN = false;
  bf16_t* pre; const bf16_t* h0;
  __device__ __forceinline__ void operator()(const f32x4 (&acc)[2][2][4][2], const Unit& u, int wr, int wc, int fr, int fq) const {
    const int row0 = u.pm * BM + wr * 64 + fr, col0 = u.pn * BM + wc * 32 + 8 * fq;
#pragma unroll
    for (int ai = 0; ai < 2; ++ai)
#pragma unroll
      for (int m = 0; m < 4; ++m) {
        const size_t off = (size_t)(row0 + ai * HALF + m * 16) * 1024 + col0;
#pragma unroll
        for (int bj = 0; bj < 2; ++bj) {
          const size_t o = off + bj * HALF;
          const u32x4 h = *(const u32x4*)(h0 + o);
          const f32x4 v0 = acc[ai][bj][m][0], v1 = acc[ai][bj][m][1];
          u32x4 w;
          w[0] = pk_bf16(v0[0] + ALPHA * bflo(h[0]), v0[1] + ALPHA * bfhi(h[0]));
          w[1] = pk_bf16(v0[2] + ALPHA * bflo(h[1]), v0[3] + ALPHA * bfhi(h[1]));
          w[2] = pk_bf16(v1[0] + ALPHA * bflo(h[2]), v1[1] + ALPHA * bfhi(h[2]));
          w[3] = pk_bf16(v1[2] + ALPHA * bflo(h[3]), v1[3] + ALPHA * bfhi(h[3]));
          *(u32x4*)(pre + o) = w;
        }
      }
  }
};
struct OneUnit {
  Unit u;
  __device__ bool next(int i, Unit& o) const { if (i) return false; o = u; return true; }
  __device__ __forceinline__ void a_ready(const Unit&) const {}
  __device__ __forceinline__ void done(const Unit&) const {}
};
struct EpiPeerScore {
  static constexpr bool PERM = false, AFTER_DRAIN = true;
  unsigned short* experts; float* gates;
  static constexpr int LDC = 260;
  __device__ void fused(const f32x4 (&acc)[2][2][4][2], const Unit& u, int wr, int wc, int fr, int fq, char* smem) const {
    float* Ct = (float*)smem;
    unsigned char* ibase = (unsigned char*)smem + 128 * LDC * 4;
    const int tid = phase_tid();
    const int row = tid >> 2, j = (tid >> 1) & 1, half = tid & 1;
#pragma unroll
    for (int ai = 0; ai < 2; ++ai) {
#pragma unroll
      for (int bj = 0; bj < 2; ++bj)
#pragma unroll
        for (int m = 0; m < 4; ++m)
#pragma unroll
          for (int n = 0; n < 2; ++n)
            *(f32x4*)(Ct + (wr * 64 + m * 16 + fr) * LDC + bj * 128 + wc * 32 + n * 16 + 4 * fq) = acc[ai][bj][m][n];
      lds_barrier();
      unsigned v[16];
      const float* rowp = Ct + row * LDC + j * 128 + half * 64;
#pragma unroll
      for (int grp = 0; grp < 4; ++grp) {
        unsigned o[16];
#pragma unroll
        for (int c4 = 0; c4 < 4; ++c4) {
          f32x4 sv = *(const f32x4*)(rowp + grp * 16 + c4 * 4);
#pragma unroll
          for (int k = 0; k < 4; ++k) o[c4 * 4 + k] = (fkey(sv[k]) & ~127u) | (unsigned)(127 - (half * 64 + grp * 16 + c4 * 4 + k));
        }
        sort16_desc(o);
        if (grp == 0) {
#pragma unroll
          for (int k = 0; k < 16; ++k) v[k] = o[k];
        } else merge16_desc(v, o);
      }
      {
        unsigned o[16];
#pragma unroll
        for (int k = 0; k < 16; ++k) o[k] = __shfl_xor(v[k], 1);
        merge16_desc(v, o);
      }
      unsigned w[16];
#pragma unroll
      for (int k = 0; k < 16; ++k) w[k] = __shfl_xor(v[k], 2);
      unsigned v0[16], v1[16];
#pragma unroll
      for (int k = 0; k < 16; ++k) { unsigned a0 = v[k], b0 = w[k]; asm volatile("" : "+v"(a0), "+v"(b0)); v0[k] = j ? b0 : a0; v1[k] = j ? a0 : b0; }
      unsigned char* ib = ibase + row * 32;
      if ((tid & 3) == 0) {
#pragma unroll
        for (int q4 = 0; q4 < 4; ++q4) {
          unsigned x0 = 0u, x1 = 0u;
#pragma unroll
          for (int k = 0; k < 4; ++k) { x0 |= (127u - (v0[q4 * 4 + k] & 127u)) << (8 * k); x1 |= (127u - (v1[q4 * 4 + k] & 127u)) << (8 * k); }
          ((unsigned*)ib)[q4] = x0; ((unsigned*)ib)[4 + q4] = x1;
        }
      }
      float f1[16], f2[16];
#pragma unroll
      for (int k = 0; k < 16; ++k) { f1[k] = keyf(v0[k] & ~127u); f2[k] = keyf(v1[k] & ~127u); }
      unsigned c[16];
#pragma unroll
      for (int k = 0; k < 16; ++k) c[k] = 0u;
#pragma unroll
      for (int a = 0; a < 16; ++a)
#pragma unroll
        for (int b = 0; b < 16; ++b)
          if ((a + 1) * (b + 1) <= 16) {
            unsigned x = (fkey(f1[a] + f2[b]) & ~255u) | (unsigned)(255 - (a * 16 + b));
            TOPK_INSERT_FROM(c, x, (a + 1) * (b + 1) - 1);
          }
      float e[16];
      const float mx = keyf(c[0] & ~255u);
      float sum = 0.f;
#pragma unroll
      for (int k = 0; k < 16; ++k) { e[k] = __expf(keyf(c[k] & ~255u) - mx); sum += e[k]; }
      const float inv = 1.f / sum;
      asm volatile("s_waitcnt lgkmcnt(0)" ::: "memory");
      const int qd = tid & 3;
      const size_t idx = ((size_t)(u.pm * BM + ai * HALF + row) * 8 + u.pn) * 16 + qd * 4;
      unsigned ew[2]; float gt[4];
#pragma unroll
      for (int k = 0; k < 4; ++k) {
        unsigned k0 = c[k], k1 = c[4 + k], k2 = c[8 + k], k3 = c[12 + k]; float e0 = e[k], e1 = e[4 + k], e2 = e[8 + k], e3 = e[12 + k];
        asm volatile("" : "+v"(k0), "+v"(k1), "+v"(k2), "+v"(k3), "+v"(e0), "+v"(e1), "+v"(e2), "+v"(e3));
        const unsigned key = qd == 0 ? k0 : qd == 1 ? k1 : qd == 2 ? k2 : k3;
        const float ev = qd == 0 ? e0 : qd == 1 ? e1 : qd == 2 ? e2 : e3;
        const unsigned ab = 255u - (key & 255u);
        const unsigned ex = (unsigned)ib[ab >> 4] * 128u + (unsigned)ib[16 + (ab & 15)];
        if (k & 1) ew[k >> 1] |= ex << 16; else ew[k >> 1] = ex;
        gt[k] = ev * inv;
      }
      *(u32x2*)(experts + idx) = (u32x2){ew[0], ew[1]};
      *(f32x4*)(gates + idx) = (f32x4){gt[0], gt[1], gt[2], gt[3]};
      lds_barrier();
    }
  }
};
template <class Epi>
__device__ __forceinline__ void run_drained(char* smem, const bf16_t* A, const bf16_t* Bt, int M, int N, int K, const Epi& E) {
  StaticOrder S; S.init(M, N, gridDim.x, blockIdx.x);
  for (int i = 0;; ++i) {
    Unit u; if (!S.next(i, u)) break;
    gemm_phase((LAS unsigned char*)smem, Gemm{A, Bt, M, N, K}, OneUnit{u}, E);
  }
}
template <class Epi>
__device__ __forceinline__ void run(char* smem, const bf16_t* A, const bf16_t* Bt, int M, int N, int K, const Epi& E) {
  StaticOrder S; S.init(M, N, gridDim.x, blockIdx.x);
  gemm_phase((LAS unsigned char*)smem, Gemm{A, Bt, M, N, K}, S, E);
}
}

__device__ void conv_phase(const Params& p, char* smem) {
  bf16_t* raw = (bf16_t*)smem;
  const int tid = phase_tid();
  u32x4 rr_[3];
  auto gload = [&](int item) {
    const int cb = item % 24, c = (item / 24) % NCH, seq = item / (24 * NCH);
#pragma unroll
    for (int j = 0; j < 3; ++j) {
      const int i = tid + j * NTHREADS;
      const int rr = i >> 3, k8 = i & 7;
      const int pos = c * 128 - 2 + rr - MPAD;
      u32x4 v = {0u, 0u, 0u, 0u};
      if (i < 132 * 8 && pos >= 0 && pos < LSEQ) v = *(const u32x4*)(p.xbc_raw + (size_t)row_of(seq, pos) * 1536 + cb * 64 + k8 * 8);
      rr_[j] = v;
    }
  };
  if ((int)blockIdx.x < NSEQ * NCH * 24) gload(blockIdx.x);
  for (int item = blockIdx.x; item < NSEQ * NCH * 24; item += gridDim.x) {
    const int cb = item % 24, c = (item / 24) % NCH, seq = item / (24 * NCH);
    __syncthreads();
#pragma unroll
    for (int j = 0; j < 3; ++j) {
      const int i = tid + j * NTHREADS;
      if (i < 132 * 8) *(u32x4*)(raw + (i >> 3) * 64 + (i & 7) * 8) = rr_[j];
    }
    __syncthreads();
    if (item + (int)gridDim.x < NSEQ * NCH * 24) gload(item + gridDim.x);
    const int ch = tid & 63, l0 = (tid >> 6) * 16;
    const int gch = cb * 64 + ch;
    float w[5];
#pragma unroll
    for (int k = 0; k < 5; ++k) w[k] = p.conv_w[k * 1536 + gch];
    const float bias = p.conv_b[gch];
    float win[20];
#pragma unroll
    for (int i = 0; i < 20; ++i) win[i] = bf2f(raw[(l0 + i) * 64 + ch]);
    float o[16];
#pragma unroll
    for (int i = 0; i < 16; ++i) {
      float a = bias;
#pragma unroll
      for (int k = 0; k < 5; ++k) a += w[k] * win[i + k];
      int pos = c * 128 + l0 + i - MPAD;
      o[i] = (pos >= 0 && pos < LSEQ) ? silu_f(a) : 0.f;
    }
    u32x4 lo, hi;
    lo[0] = pk_bf16(o[0], o[1]); lo[1] = pk_bf16(o[2], o[3]); lo[2] = pk_bf16(o[4], o[5]); lo[3] = pk_bf16(o[6], o[7]);
    hi[0] = pk_bf16(o[8], o[9]); hi[1] = pk_bf16(o[10], o[11]); hi[2] = pk_bf16(o[12], o[13]); hi[3] = pk_bf16(o[14], o[15]);
    if (cb < 16) {
      bf16_t* d = p.XT + ((((size_t)seq * NCH + c) * 16 + cb) * 64 + ch) * 128 + l0;
      *(u32x4*)d = lo; *(u32x4*)(d + 8) = hi;
    } else if (cb < 20) {
      const int g = (cb - 16) >> 1, n = ((cb - 16) & 1) * 64 + ch;
      bf16_t* d = p.BmT + ((((size_t)seq * NCH + c) * 2 + g) * 128 + n) * 128 + l0;
      *(u32x4*)d = lo; *(u32x4*)(d + 8) = hi;
      bf16_t* d2 = p.Bm + ((size_t)seq * LP + c * 128 + l0) * 256 + g * 128 + n;
#pragma unroll
      for (int i = 0; i < 16; ++i) d2[(size_t)i * 256] = f2bf(o[i]);
    } else {
      const int g = (cb - 20) >> 1, n = ((cb - 20) & 1) * 64 + ch;
      bf16_t* d2 = p.Cm + ((size_t)seq * LP + c * 128 + l0) * 256 + g * 128 + n;
#pragma unroll
      for (int i = 0; i < 16; ++i) d2[(size_t)i * 256] = f2bf(o[i]);
    }
  }
}

__device__ void token_phase(const Params& p) {
  const int lane = phase_tid() & 63, wid = phase_tid() >> 6;
  for (int row = blockIdx.x * 8 + wid; row < TP; row += gridDim.x * 8) {
    if (row >= TM) {
      unsigned* dq = (unsigned*)(p.cqn + (size_t)row * 384) + lane * 3;
      dq[0] = 0u; dq[1] = 0u; dq[2] = 0u;
      *(u32x2*)(p.ckvn + (size_t)row * 256 + lane * 4) = (u32x2){0u, 0u};
      continue;
    }
    const bf16_t* src = p.rest + (size_t)row * 768;
    {
      const unsigned* s = (const unsigned*)(src + 32) + lane * 3;
      unsigned a0 = s[0], a1 = s[1], a2 = s[2];
      float v[6] = {bflo(a0), bfhi(a0), bflo(a1), bfhi(a1), bflo(a2), bfhi(a2)};
      float ss = 0.f;
#pragma unroll
      for (int j = 0; j < 6; ++j) ss += v[j] * v[j];
      const float r = rsqrtf(wave_sum(ss) * (1.f / 384.f) + EPS);
      const float* g = p.q_norm_g + lane * 6;
      unsigned* d = (unsigned*)(p.cqn + (size_t)row * 384) + lane * 3;
      d[0] = pk_bf16(v[0] * r * g[0], v[1] * r * g[1]);
      d[1] = pk_bf16(v[2] * r * g[2], v[3] * r * g[3]);
      d[2] = pk_bf16(v[4] * r * g[4], v[5] * r * g[5]);
    }
    {
      u32x2 a = *(const u32x2*)(src + 416 + lane * 4);
      float v[4] = {bflo(a[0]), bfhi(a[0]), bflo(a[1]), bfhi(a[1])};
      float ss = v[0] * v[0] + v[1] * v[1] + v[2] * v[2] + v[3] * v[3];
      const float r = rsqrtf(wave_sum(ss) * (1.f / 256.f) + EPS);
      const float* g = p.kv_norm_g + lane * 4;
      u32x2 w;
      w[0] = pk_bf16(v[0] * r * g[0], v[1] * r * g[1]); w[1] = pk_bf16(v[2] * r * g[2], v[3] * r * g[3]);
      *(u32x2*)(p.ckvn + (size_t)row * 256 + lane * 4) = w;
    }
    if (lane < 16) {
      const float pos = (float)(row < TX ? NMETA + (row & (SEQ - 1)) : row - TX);
      const float inv = exp2f(-(float)lane * (13.287712379549449f / 16.f));
      const float ang = pos * inv;
      float sn, cs; sincosf(ang, &sn, &cs);
      const float x1 = bf2f(src[672 + lane]), x2 = bf2f(src[688 + lane]);
      p.kr[(size_t)row * 32 + lane] = f2bf(x1 * cs - x2 * sn);
      p.kr[(size_t)row * 32 + 16 + lane] = f2bf(x1 * sn + x2 * cs);
    }
  }
}

__device__ void dt_phase(const Params& p) {
  const int lane = phase_tid() & 63, wid = phase_tid() >> 6;
  for (int item = blockIdx.x * 8 + wid; item < NSEQ * 2 * NCH; item += gridDim.x * 8) {
    const int c = item % NCH, dir = (item / NCH) & 1, seq = item / (NCH * 2);
    u32x4 raw[2][2];
#pragma unroll
    for (int j = 0; j < 2; ++j) {
      const int pos = c * 128 + lane * 2 + j - MPAD;
      raw[j][0] = (u32x4){0u, 0u, 0u, 0u}; raw[j][1] = raw[j][0];
      if (pos >= 0) {
        const bf16_t* src = p.rest + (size_t)row_of(seq, pos) * 768 + dir * 16;
        raw[j][0] = *(const u32x4*)src; raw[j][1] = *(const u32x4*)(src + 8);
      }
    }
    const float* biasp = dir ? p.dt_bias_b : p.dt_bias_f;
    const float* alogp = dir ? p.a_log_b : p.a_log_f;
#pragma unroll
    for (int h = 0; h < 16; ++h) {
      const float bias = biasp[h];
      const float a = -__expf(alogp[h]);
      float dt[2], da[2];
#pragma unroll
      for (int j = 0; j < 2; ++j) {
        const int pos = c * 128 + lane * 2 + j - MPAD;
        const unsigned w = raw[j][h >> 3][(h >> 1) & 3];
        const float x = ((h & 1) ? bfhi(w) : bflo(w)) + bias;
        const float v = pos >= 0 ? (x > 20.f ? x : log1pf(__expf(x))) : 0.f;
        dt[j] = v; da[j] = v * a;
      }
      const float s2 = da[0] + da[1];
      float incl = s2;
#pragma unroll
      for (int o = 1; o < 64; o <<= 1) { float t = __shfl_up(incl, o); if (lane >= o) incl += t; }
      const float excl = incl - s2;
      const float tot = __shfl(incl, 63);
      const size_t base = ((size_t)(seq * 2 + dir) * 16 + h) * LP + c * 128 + lane * 2;
      float P0, P1;
      if (dir == 0) { P0 = excl + da[0]; P1 = incl; } else { P0 = -excl; P1 = -(excl + da[0]); }
      *(float2*)(p.dtv + base) = make_float2(dt[0], dt[1]);
      *(float2*)(p.Pv + base) = make_float2(P0, P1);
      if (lane == 0) p.Atot[((size_t)(seq * 2 + dir) * 16 + h) * NCH + c] = tot;
    }
  }
}

__device__ __forceinline__ void xcd_group_map(int b, int& gg, int& j) { const int r = b & 7, k = b >> 3; j = k & 7; gg = (k >> 3) * 8 + r; }
constexpr int KS_STRIDE = 208, VS_STRIDE = 136;
constexpr int ATT_STAGE = 64 * KS_STRIDE + 64 * VS_STRIDE;
constexpr int ATT_QOFF = 2 * ATT_STAGE;
static_assert(ATT_QOFF + 512 * KS_STRIDE <= 160 * 1024 - 64, "attn lds");
__device__ void attn_phase(const Params& p, char* smem) {
  const int tid = phase_tid(), lane = tid & 63, wid = tid >> 6;
  const int r32 = lane & 31, hh = lane >> 5;
  for (int item0 = blockIdx.x; item0 < NSEQ * 8 * 4; item0 += gridDim.x) {
    int item = item0;
    if (gridDim.x == 256) { int gg, j; xcd_group_map(blockIdx.x, gg, j); item = ((item0 >> 8) * 64 + gg * 2 + (j >> 2)) * 4 + (j & 3); }
    const int qb = item & 3, h = (item >> 2) & 7, seq = item >> 5;
    const float qscale = 0.10206207261596575f * 1.4426950408889634f;
    lds_barrier();
    {
      const int qi = qb * 512 + tid;
      const bf16_t* qp = p.q + ((size_t)seq * SEQ + qi) * 768 + h * 96;
      char* dst = smem + ATT_QOFF + tid * KS_STRIDE;
      const float pos = (float)(NMETA + qi);
      u32x4 v[12];
#pragma unroll
      for (int i = 0; i < 12; ++i) v[i] = *(const u32x4*)(qp + i * 8);
#pragma unroll
      for (int i = 0; i < 8; ++i) {
        u32x4 w;
#pragma unroll
        for (int j = 0; j < 4; ++j) w[j] = pk_bf16(bflo(v[i][j]) * qscale, bfhi(v[i][j]) * qscale);
        *(u32x4*)(dst + i * 16) = w;
      }
#pragma unroll
      for (int i = 0; i < 2; ++i) {
        u32x4 w1, w2;
#pragma unroll
        for (int j = 0; j < 4; ++j) {
          float o1[2], o2[2];
#pragma unroll
          for (int e = 0; e < 2; ++e) {
            const int k = 8 * i + 2 * j + e;
            const float x1 = e ? bfhi(v[8 + i][j]) : bflo(v[8 + i][j]), x2 = e ? bfhi(v[10 + i][j]) : bflo(v[10 + i][j]);
            const float inv = exp2f(-(float)k * (13.287712379549449f / 16.f));
            float sn, cs; sincosf(pos * inv, &sn, &cs);
            o1[e] = (x1 * cs - x2 * sn) * qscale; o2[e] = (x1 * sn + x2 * cs) * qscale;
          }
          w1[j] = pk_bf16(o1[0], o1[1]); w2[j] = pk_bf16(o2[0], o2[1]);
        }
        *(u32x4*)(dst + 128 + i * 16) = w1; *(u32x4*)(dst + 160 + i * 16) = w2;
      }
    }
    f32x16 oacc[2][2];
#pragma unroll
    for (int i = 0; i < 16; ++i) { oacc[0][0][i] = 0.f; oacc[0][1][i] = 0.f; oacc[1][0][i] = 0.f; oacc[1][1][i] = 0.f; }
    float m_run[2] = {-1e30f, -1e30f}, l_run[2] = {0.f, 0.f};

    u32x4 rk, rkr, rv;
    const bf16_t* vTb = p.vT + (size_t)(h * 64) * TP;
    auto gload = [&](int kt) {
      const u32x4 zero = {0u, 0u, 0u, 0u};
      if (kt < 32) {
        { int key = tid >> 3, ch = tid & 7;
          rk = *(const u32x4*)(p.Kb + ((size_t)seq * SEQ + kt * 64 + key) * 512 + h * 64 + ch * 8); }
        if (tid < 256) { int key = tid >> 2, ch = tid & 3;
          rkr = *(const u32x4*)(p.kr + ((size_t)seq * SEQ + kt * 64 + key) * 32 + ch * 8); }
        { int dv = tid >> 3, ch = tid & 7;
          rv = *(const u32x4*)(vTb + (size_t)dv * TP + seq * SEQ + kt * 64 + ch * 8); }
      } else {
        { int key = tid >> 3, ch = tid & 7;
          rk = key < 16 ? *(const u32x4*)(p.Kb + (size_t)(TX + key) * 512 + h * 64 + ch * 8) : zero; }
        if (tid < 256) { int key = tid >> 2, ch = tid & 3;
          rkr = key < 16 ? *(const u32x4*)(p.kr + (size_t)(TX + key) * 32 + ch * 8) : zero; }
        { int dv = tid >> 3, ch = tid & 7;
          rv = ch < 2 ? *(const u32x4*)(vTb + (size_t)dv * TP + TX + ch * 8) : zero; }
      }
    };
    auto sstore = [&](int st) {
      char* ks = smem + st * ATT_STAGE; char* vs = ks + 64 * KS_STRIDE;
      { int key = tid >> 3, ch = tid & 7; *(u32x4*)(ks + key * KS_STRIDE + ch * 16) = rk; }
      if (tid < 256) { int key = tid >> 2, ch = tid & 3; *(u32x4*)(ks + key * KS_STRIDE + 128 + ch * 16) = rkr; }
      { int dv = tid >> 3, ch = tid & 7; char* d = vs + dv * VS_STRIDE + ch * 16;
        *(u32x2*)d = (u32x2){rv[0], rv[1]}; *(u32x2*)(d + 8) = (u32x2){rv[2], rv[3]}; }
    };
    gload(0); sstore(0);
    lds_barrier();
    const char* qrow = smem + ATT_QOFF + (wid * 64 + r32) * KS_STRIDE + hh * 16;
    for (int kt = 0; kt < 33; ++kt) {
      const int cur = kt & 1;
      if (kt + 1 < 33) gload(kt + 1);
      const char* ks_ = smem + cur * ATT_STAGE; const char* vs_ = ks_ + 64 * KS_STRIDE;
      f32x16 sacc[2][2];
#pragma unroll
      for (int t2 = 0; t2 < 2; ++t2)
#pragma unroll
        for (int i = 0; i < 16; ++i) { sacc[0][t2][i] = 0.f; sacc[1][t2][i] = 0.f; }
#pragma unroll
      for (int ks = 0; ks < 6; ++ks) {
        const bf16x8 q0 = *(const bf16x8*)(qrow + ks * 32);
        const bf16x8 q1 = *(const bf16x8*)(qrow + 32 * KS_STRIDE + ks * 32);
#pragma unroll
        for (int t2 = 0; t2 < 2; ++t2) {
          const bf16x8 kf = *(const bf16x8*)(ks_ + (t2 * 32 + r32) * KS_STRIDE + ks * 32 + hh * 16);
          sacc[0][t2] = __builtin_amdgcn_mfma_f32_32x32x16_bf16(kf, q0, sacc[0][t2], 0, 0, 0);
          sacc[1][t2] = __builtin_amdgcn_mfma_f32_32x32x16_bf16(kf, q1, sacc[1][t2], 0, 0, 0);
        }
      }
      if (kt == 32) {
#pragma unroll
        for (int g = 0; g < 2; ++g)
#pragma unroll
          for (int t2 = 0; t2 < 2; ++t2)
#pragma unroll
            for (int i = 0; i < 16; ++i) {
              int kk = t2 * 32 + (i & 3) + 8 * (i >> 2) + 4 * hh;
              if (kk >= 16) sacc[g][t2][i] = -1e30f;
            }
      }
#pragma unroll
      for (int g = 0; g < 2; ++g) {
        float mx = sacc[g][0][0];
#pragma unroll
        for (int t2 = 0; t2 < 2; ++t2)
#pragma unroll
          for (int i = 0; i < 16; ++i) mx = fmaxf(mx, sacc[g][t2][i]);
        mx = fmaxf(mx, __shfl_xor(mx, 32));
        const float m_new = fmaxf(m_run[g], mx);
        const float alpha = __builtin_amdgcn_exp2f(m_run[g] - m_new);
        m_run[g] = m_new;
        float ps = 0.f;
#pragma unroll
        for (int t2 = 0; t2 < 2; ++t2)
#pragma unroll
          for (int i = 0; i < 16; ++i) { float e = __builtin_amdgcn_exp2f(sacc[g][t2][i] - m_new); sacc[g][t2][i] = e; ps += e; }
        l_run[g] = l_run[g] * alpha + ps;
        if (__any(alpha != 1.f)) {
#pragma unroll
          for (int i = 0; i < 16; ++i) { oacc[g][0][i] *= alpha; oacc[g][1][i] *= alpha; }
        }
      }
#pragma unroll
      for (int t2 = 0; t2 < 2; ++t2)
#pragma unroll
        for (int s2 = 0; s2 < 2; ++s2) {
          bf16x8 pf[2];
#pragma unroll
          for (int g = 0; g < 2; ++g) {
            u32x4 pw;
#pragma unroll
            for (int j = 0; j < 4; ++j) pw[j] = pk_bf16(sacc[g][t2][s2 * 8 + 2 * j], sacc[g][t2][s2 * 8 + 2 * j + 1]);
            pf[g] = as_bf16x8(pw);
          }
          const int kbase = t2 * 32 + s2 * 16 + 4 * hh;
#pragma unroll
          for (int dvt = 0; dvt < 2; ++dvt) {
            const char* vp = vs_ + (dvt * 32 + r32) * VS_STRIDE + kbase * 2;
            u32x2 a2 = *(const u32x2*)vp, b2 = *(const u32x2*)(vp + 16);
            bf16x8 vf = as_bf16x8((u32x4){a2[0], a2[1], b2[0], b2[1]});
            oacc[0][dvt] = __builtin_amdgcn_mfma_f32_32x32x16_bf16(vf, pf[0], oacc[0][dvt], 0, 0, 0);
            oacc[1][dvt] = __builtin_amdgcn_mfma_f32_32x32x16_bf16(vf, pf[1], oacc[1][dvt], 0, 0, 0);
          }
        }
      if (kt + 1 < 33) sstore(cur ^ 1);
      lds_barrier();
    }
#pragma unroll
    for (int g = 0; g < 2; ++g) {
      const float l_tot = l_run[g] + __shfl_xor(l_run[g], 32);
      const float inv = __builtin_amdgcn_rcpf(l_tot);
      const int qi = qb * 512 + wid * 64 + g * 32 + r32;
      bf16_t* op = p.o + ((size_t)seq * SEQ + qi) * 512 + h * 64;
#pragma unroll
      for (int dvt = 0; dvt < 2; ++dvt)
#pragma unroll
        for (int g4 = 0; g4 < 4; ++g4) {
          u32x2 w;
          w[0] = pk_bf16(oacc[g][dvt][g4 * 4 + 0] * inv, oacc[g][dvt][g4 * 4 + 1] * inv);
          w[1] = pk_bf16(oacc[g][dvt][g4 * 4 + 2] * inv, oacc[g][dvt][g4 * 4 + 3] * inv);
          *(u32x2*)(op + dvt * 32 + g4 * 8 + hh * 4) = w;
        }
    }
  }
  lds_barrier();
}

constexpr int SS_ROW = 272;
constexpr int SS_XT = 264;

constexpr int DG_CC = 0, DG_BC = 128 * SS_ROW, DG_XT = 2 * 128 * SS_ROW, DG_AR = DG_XT + 2 * 64 * SS_XT, DG_BW = DG_AR + 2 * 2048, DG_LDS = DG_BW + 8 * 512;
static_assert(DG_LDS <= 150 * 1024, "diag lds");
__device__ void ssd_diag_phase(const Params& p, char* smem) {
  const int tid = phase_tid(), lane = tid & 63, wid = tid >> 6;
  const int r32 = lane & 31, hh = lane >> 5;
  const int pt = wid & 1, lt = wid >> 1;
  const int l = lt * 32 + r32;
  for (int item = blockIdx.x; item < NSEQ * 16 * 2; item += gridDim.x) {
    const int g = item & 1, c = 1 + ((item >> 1) & 15), seq = item >> 5;
    u32x4 rx[2]; float ra = 0.f;
    auto gload_head = [&](int h) {
      const bf16_t* xt = p.XT + (((size_t)seq * NCH + c) * 16 + h) * 64 * 128;
#pragma unroll
      for (int i = 0; i < 2; ++i) { int id = tid + i * 512; int r = id >> 4, k = id & 15;
        rx[i] = *(const u32x4*)(xt + (size_t)r * 128 + k * 8); }
      const int arr = tid >> 7, idx = tid & 127, dir = arr & 1;
      const float* src = (arr < 2 ? p.Pv : p.dtv) + ((size_t)(seq * 2 + dir) * 16 + h) * LP + c * 128 + idx;
      ra = *src;
    };
    auto sstore_head = [&](int buf) {
#pragma unroll
      for (int i = 0; i < 2; ++i) { int id = tid + i * 512; int r = id >> 4, k = id & 15;
        char* d = smem + DG_XT + buf * 64 * SS_XT + r * SS_XT + k * 16;
        *(u32x2*)d = (u32x2){rx[i][0], rx[i][1]}; *(u32x2*)(d + 8) = (u32x2){rx[i][2], rx[i][3]}; }
      ((float*)(smem + DG_AR + buf * 2048))[tid] = ra;
    };
    lds_barrier();
    {
      const bf16_t* cm = p.Cm + ((size_t)seq * LP + c * 128) * 256 + g * 128;
      const bf16_t* bm = p.Bm + ((size_t)seq * LP + c * 128) * 256 + g * 128;
      u32x4 rc[4], rb[4];
#pragma unroll
      for (int i = 0; i < 4; ++i) { int id = tid + i * 512; int r = id >> 4, k = id & 15;
        rc[i] = *(const u32x4*)(cm + (size_t)r * 256 + k * 8); rb[i] = *(const u32x4*)(bm + (size_t)r * 256 + k * 8); }
      gload_head(g * 8);
#pragma unroll
      for (int i = 0; i < 4; ++i) { int id = tid + i * 512; int r = id >> 4, k = id & 15;
        *(u32x4*)(smem + DG_CC + r * SS_ROW + k * 16) = rc[i]; *(u32x4*)(smem + DG_BC + r * SS_ROW + k * 16) = rb[i]; }
      sstore_head(0);
    }
    lds_barrier();
    f32x16 xacc[4];
#pragma unroll
    for (int st = 0; st < 4; ++st) {
#pragma unroll
      for (int i = 0; i < 16; ++i) xacc[st][i] = 0.f;
#pragma unroll
      for (int ks = 0; ks < 8; ++ks) {
        bf16x8 bfg = *(const bf16x8*)(smem + DG_BC + (st * 32 + r32) * SS_ROW + ks * 32 + hh * 16);
        bf16x8 cfk = *(const bf16x8*)(smem + DG_CC + l * SS_ROW + ks * 32 + hh * 16);
        xacc[st] = __builtin_amdgcn_mfma_f32_32x32x16_bf16(bfg, cfk, xacc[st], 0, 0, 0);
      }
    }
    for (int h8 = 0; h8 < 8; ++h8) {
      const int h = g * 8 + h8, buf = h8 & 1;
      if (h8 + 1 < 8) gload_head(h + 1);
      const char* xtb = smem + DG_XT + buf * 64 * SS_XT;
      const float* Pf = (const float*)(smem + DG_AR + buf * 2048);
      const float* Pb = Pf + 128; const float* Df = Pf + 256; const float* Db = Pf + 384;
      const float Pfl = Pf[l], Pbl = Pb[l];
      float* bw = (float*)(smem + DG_BW + wid * 512);
      const float PrefF = Pf[lt * 32], PrefB = Pb[lt * 32 + 31];
      const float af = __expf(Pfl - PrefF), ab = __expf(Pbl - PrefB);
#pragma unroll
      for (int r = 0; r < 2; ++r) {
        const int sx = lane + 64 * r;
        float bv = 0.f;
        if (sx < lt * 32) bv = Df[sx] * __expf(PrefF - Pf[sx]);
        else if (sx >= (lt + 1) * 32) bv = Db[sx] * __expf(PrefB - Pb[sx]);
        bw[sx] = bv;
      }
      asm volatile("s_waitcnt lgkmcnt(0)" ::: "memory");
      f32x16 yacc;
#pragma unroll
      for (int i = 0; i < 16; ++i) yacc[i] = 0.f;
#pragma unroll
      for (int st = 0; st < 4; ++st) {
        float m[16];
        if (st != lt) {
          const float a = st < lt ? af : ab;
#pragma unroll
          for (int i = 0; i < 16; ++i) { const int sx = st * 32 + (i & 3) + 8 * (i >> 2) + 4 * hh;
            m[i] = xacc[st][i] * (a * bw[sx]); }
        } else {
#pragma unroll
          for (int i = 0; i < 16; ++i) { const int sx = st * 32 + (i & 3) + 8 * (i >> 2) + 4 * hh;
            const float wf = Df[sx] * __expf(Pfl - Pf[sx]), wb = Db[sx] * __expf(Pbl - Pb[sx]);
            m[i] = xacc[st][i] * ((sx <= l ? wf : 0.f) + (sx >= l ? wb : 0.f)); }
        }
#pragma unroll
        for (int s2 = 0; s2 < 2; ++s2) {
          u32x4 pw;
#pragma unroll
          for (int j = 0; j < 4; ++j) pw[j] = pk_bf16(m[s2 * 8 + 2 * j], m[s2 * 8 + 2 * j + 1]);
          const char* xp = xtb + (pt * 32 + r32) * SS_XT + (st * 32 + s2 * 16 + 4 * hh) * 2;
          u32x2 a = *(const u32x2*)xp, b2 = *(const u32x2*)(xp + 16);
          bf16x8 xf = as_bf16x8((u32x4){a[0], a[1], b2[0], b2[1]});
          yacc = __builtin_amdgcn_mfma_f32_32x32x16_bf16(xf, as_bf16x8(pw), yacc, 0, 0, 0);
        }
      }
      const float dskip = p.d_skip[h];
      bf16_t* yp = p.Y + ((size_t)seq * SEQ + (c - 1) * 128 + l) * 1024 + h * 64 + pt * 32 + 4 * hh;
#pragma unroll
      for (int g4 = 0; g4 < 4; ++g4) {
        float v[4];
#pragma unroll
        for (int j = 0; j < 4; ++j) {
          const int pp = pt * 32 + g4 * 8 + 4 * hh + j;
          v[j] = yacc[g4 * 4 + j] + dskip * bf2f(*(const bf16_t*)(xtb + pp * SS_XT + l * 2));
        }
        u32x2 w; w[0] = pk_bf16(v[0], v[1]); w[1] = pk_bf16(v[2], v[3]);
        *(u32x2*)(yp + g4 * 8) = w;
      }
      if (h8 + 1 < 8) sstore_head(buf ^ 1);
      lds_barrier();
    }
  }
  lds_barrier();
}

constexpr int OFF_CC = 0, OFF_BT = 128 * SS_ROW, OFF_XT = 2 * 128 * SS_ROW;
constexpr int OFF_XW = OFF_XT + 64 * SS_XT, OFF_SB = OFF_XW + 64 * SS_ROW, OFF_P = OFF_SB + 64 * SS_ROW, OFF_DT = OFF_P + 512;
constexpr int OFF_AT = OFF_DT + 512;
constexpr int OFF_WS = OFF_AT + 128;
constexpr int OFF_YT = OFF_WS + 512;
constexpr int SSD_LDS = OFF_YT + 128 * 272;
static_assert(SSD_LDS <= 160 * 1024 - 64, "ssd lds");
__device__ void ssd_phase(const Params& p, char* smem) {
  const int tid = phase_tid(), lane = tid & 63, wid = tid >> 6;
  const int r32 = lane & 31, hh = lane >> 5;
  const int pt = wid & 1, lt = wid >> 1;
  float* Ps = (float*)(smem + OFF_P);
  float* Ds = (float*)(smem + OFF_DT);
  const int NI = NSEQ * 16, G = gridDim.x;
  const bool split = G >= 256 && G < NI;
  for (int u = 0;; ++u) {
    int item, dir0, dir1; bool to_yb2 = false;
    if (!split) { item = blockIdx.x + u * G; if (item >= NI) break; dir0 = 0; dir1 = 2; }
    else if (G == 256) {
      int gg, j; xcd_group_map(blockIdx.x, gg, j);
      if (u == 0) { item = gg * 8 + j; dir0 = 0; dir1 = 2; }
      else if (u == 1) { item = G + (gg >> 1) * 8 + j; dir0 = gg & 1; dir1 = dir0 + 1; to_yb2 = true; }
      else break;
    }
    else if (u == 0) { item = blockIdx.x; dir0 = 0; dir1 = 2; }
    else { const int hidx = blockIdx.x + (u - 1) * G; if (hidx >= 2 * (NI - G)) break; item = G + (hidx >> 1); dir0 = hidx & 1; dir1 = dir0 + 1; to_yb2 = true; }
    const int h = item & 15, seq = item >> 4, g = h >> 3;
    for (int dir = dir0; dir < dir1; ++dir) {
      const bool yb2 = (dir == 1) && to_yb2;
      f32x16 sacc;
#pragma unroll
      for (int i = 0; i < 16; ++i) sacc[i] = 0.f;
      const float* dtp = p.dtv + ((size_t)(seq * 2 + dir) * 16 + h) * LP;
      const float* Pp = p.Pv + ((size_t)(seq * 2 + dir) * 16 + h) * LP;
      const float* Ap = p.Atot + ((size_t)(seq * 2 + dir) * 16 + h) * NCH;
      u32x4 rc[4], rbt[4], rx[2];
      float rp = 0.f, rd = 0.f;
      auto gload = [&](int c) {
        const bf16_t* cm = p.Cm + ((size_t)seq * LP + c * 128) * 256 + g * 128;
        const bf16_t* bt = p.BmT + (((size_t)seq * NCH + c) * 2 + g) * 128 * 128;
        const bf16_t* xt = p.XT + (((size_t)seq * NCH + c) * 16 + h) * 64 * 128;
#pragma unroll
        for (int i = 0; i < 4; ++i) { int id = tid + i * 512; int r = id >> 4, k = id & 15;
          rc[i] = *(const u32x4*)(cm + (size_t)r * 256 + k * 8);
          rbt[i] = *(const u32x4*)(bt + (size_t)r * 128 + k * 8); }
#pragma unroll
        for (int i = 0; i < 2; ++i) { int id = tid + i * 512; int r = id >> 4, k = id & 15;
          rx[i] = *(const u32x4*)(xt + (size_t)r * 128 + k * 8); }
        if (tid < 128) { rp = Pp[c * 128 + tid]; rd = dtp[c * 128 + tid]; }
      };
      auto sstore = [&](int cs) {
#pragma unroll
        for (int i = 0; i < 4; ++i) { int id = tid + i * 512; int r = id >> 4, k = id & 15;
          *(u32x4*)(smem + OFF_CC + r * SS_ROW + k * 16) = rc[i];
          *(u32x4*)(smem + OFF_BT + r * SS_ROW + k * 16) = rbt[i]; }
#pragma unroll
        for (int i = 0; i < 2; ++i) { int id = tid + i * 512; int r = id >> 4, k = id & 15;
          char* d = smem + OFF_XT + r * SS_XT + k * 16;
          *(u32x2*)d = (u32x2){rx[i][0], rx[i][1]}; *(u32x2*)(d + 8) = (u32x2){rx[i][2], rx[i][3]}; }
        if (tid < 128) {
          Ps[tid] = rp; Ds[tid] = rd;
          ((float*)(smem + OFF_WS))[tid] = rd * (dir == 0 ? __expf(Ap[cs] - rp) : __expf(-rp));
        }
      };
      const int c_first = dir == 0 ? 0 : NCH - 1, c_last = dir == 0 ? NCH - 1 : 1, c_step = dir == 0 ? 1 : -1;
      lds_barrier();
      gload(c_first);
      if (tid < NCH) ((float*)(smem + OFF_AT))[tid] = Ap[tid];
      for (int i = tid; i < 64 * SS_ROW / 4; i += NTHREADS) ((unsigned*)(smem + OFF_SB))[i] = 0u;
      sstore(c_first);
      lds_barrier();
      for (int c = c_first;; c += c_step) {
        const bool last = (c == c_last);
        const bool first = (c == c_first);
        const float atot = ((const float*)(smem + OFF_AT))[c];
        const int l = lt * 32 + r32;
        const bool emit = (c >= 1) && !first;
        const int yrow = tid >> 2, yseg = tid & 3;
        bf16_t* yp = yb2 ? p.Yb2 + ((size_t)(item - G) * SEQ + (c - 1) * 128 + yrow) * 64 + yseg * 16
                         : p.Y + ((size_t)seq * SEQ + (c - 1) * 128 + yrow) * 1024 + h * 64 + yseg * 16;
        u32x4 yold[2] = {{0u, 0u, 0u, 0u}, {0u, 0u, 0u, 0u}};
        if (emit && !yb2) {
          yold[0] = *(const u32x4*)yp; yold[1] = *(const u32x4*)(yp + 8);
        }
        if (!last) gload(c + c_step);
        if (!last) {
          const int pp = tid >> 3, l0 = (tid & 7) * 16;
          const char* srow = smem + OFF_XT + pp * SS_XT + l0 * 2;
          char* drow = smem + OFF_XW + pp * SS_ROW + l0 * 2;
#pragma unroll
          for (int q4 = 0; q4 < 4; ++q4) {
            u32x2 v = *(const u32x2*)(srow + q4 * 8);
            const f32x4 w = *(const f32x4*)(smem + OFF_WS + (l0 + q4 * 4) * 4);
            u32x2 o;
            o[0] = pk_bf16(bflo(v[0]) * w[0], bfhi(v[0]) * w[1]);
            o[1] = pk_bf16(bflo(v[1]) * w[2], bfhi(v[1]) * w[3]);
            *(u32x2*)(drow + q4 * 8) = o;
          }
        }
        if (emit) {
          const float Pl = Ps[l];
          f32x16 yacc;
#pragma unroll
          for (int i = 0; i < 16; ++i) yacc[i] = 0.f;
#pragma unroll
          for (int ks = 0; ks < 8; ++ks) {
            bf16x8 sf = *(const bf16x8*)(smem + OFF_SB + (pt * 32 + r32) * SS_ROW + ks * 32 + hh * 16);
            bf16x8 cfk = *(const bf16x8*)(smem + OFF_CC + l * SS_ROW + ks * 32 + hh * 16);
            yacc = __builtin_amdgcn_mfma_f32_32x32x16_bf16(sf, cfk, yacc, 0, 0, 0);
          }
          const float ysc = dir == 0 ? __expf(Pl) : __expf(Pl + atot);
#pragma unroll
          for (int g4 = 0; g4 < 4; ++g4)
            *(f32x4*)(smem + OFF_YT + l * 272 + (pt * 32 + g4 * 8 + 4 * hh) * 4) =
                (f32x4){yacc[g4 * 4] * ysc, yacc[g4 * 4 + 1] * ysc, yacc[g4 * 4 + 2] * ysc, yacc[g4 * 4 + 3] * ysc};
        }
        lds_barrier();
        if (emit || (yb2 && c >= 1)) {
          float v[16];
#pragma unroll
          for (int q4 = 0; q4 < 4; ++q4) {
            const f32x4 t4 = emit ? *(const f32x4*)(smem + OFF_YT + yrow * 272 + yseg * 64 + q4 * 16) : (f32x4){0.f, 0.f, 0.f, 0.f};
            v[q4 * 4] = t4[0]; v[q4 * 4 + 1] = t4[1]; v[q4 * 4 + 2] = t4[2]; v[q4 * 4 + 3] = t4[3];
          }
          u32x4 w0, w1;
#pragma unroll
          for (int j = 0; j < 4; ++j) {
            w0[j] = pk_bf16(v[2 * j] + bflo(yold[0][j]), v[2 * j + 1] + bfhi(yold[0][j]));
            w1[j] = pk_bf16(v[8 + 2 * j] + bflo(yold[1][j]), v[8 + 2 * j + 1] + bfhi(yold[1][j]));
          }
          *(u32x4*)yp = w0; *(u32x4*)(yp + 8) = w1;
        }
        if (!last) {
          const float dec = __expf(atot);
#pragma unroll
          for (int i = 0; i < 16; ++i) sacc[i] *= dec;
#pragma unroll
          for (int ks = 0; ks < 8; ++ks) {
            bf16x8 xf = *(const bf16x8*)(smem + OFF_XW + (pt * 32 + r32) * SS_ROW + ks * 32 + hh * 16);
            bf16x8 bfg = *(const bf16x8*)(smem + OFF_BT + (lt * 32 + r32) * SS_ROW + ks * 32 + hh * 16);
            sacc = __builtin_amdgcn_mfma_f32_32x32x16_bf16(bfg, xf, sacc, 0, 0, 0);
          }
#pragma unroll
          for (int g4 = 0; g4 < 4; ++g4)
            *(u32x2*)(smem + OFF_SB + (pt * 32 + r32) * SS_ROW + (lt * 32 + g4 * 8 + 4 * hh) * 2) =
                (u32x2){pk_bf16(sacc[g4 * 4], sacc[g4 * 4 + 1]), pk_bf16(sacc[g4 * 4 + 2], sacc[g4 * 4 + 3])};
        }
        lds_barrier();
        if (last) break;
        sstore(c + c_step);
        lds_barrier();
      }
    }
  }
  lds_barrier();
}

__device__ void gate_phase(const Params& p) {
  const int lane = phase_tid() & 63, wid = phase_tid() >> 6;
  const int G = gridDim.x;
  const bool split = G >= 256 && G < NSEQ * 16;
  struct In { u32x4 y[2], z[2], y2[2], o; };
  auto load = [&](In& d, int row) {
#pragma unroll
    for (int c = 0; c < 2; ++c) {
      d.y[c] = *(const u32x4*)(p.Y + (size_t)row * 1024 + c * 512 + lane * 8);
      d.z[c] = *(const u32x4*)(p.z + (size_t)row * 1024 + c * 512 + lane * 8);
      const int item = (row >> 11) * 16 + c * 8 + (lane >> 3);
      d.y2[c] = (u32x4){0u, 0u, 0u, 0u};
      if (split && item >= G) d.y2[c] = *(const u32x4*)(p.Yb2 + ((size_t)(item - G) * SEQ + (row & (SEQ - 1))) * 64 + (lane & 7) * 8);
    }
    d.o = *(const u32x4*)(p.o + (size_t)row * 512 + lane * 8);
  };
  const int stride = gridDim.x * 8;
  int row = blockIdx.x * 8 + wid;
  In cur, nxt;
  if (row < TX) load(cur, row);
  for (; row < TX; row += stride) {
    if (row + stride < TX) load(nxt, row + stride);
    float v[16];
    float ss = 0.f;
#pragma unroll
    for (int c = 0; c < 2; ++c) {
#pragma unroll
      for (int j = 0; j < 4; ++j) {
        float a = (bflo(cur.y[c][j]) + bflo(cur.y2[c][j])) * silu_f(bflo(cur.z[c][j])), b2 = (bfhi(cur.y[c][j]) + bfhi(cur.y2[c][j])) * silu_f(bfhi(cur.z[c][j]));
        v[c * 8 + 2 * j] = a; v[c * 8 + 2 * j + 1] = b2; ss += a * a + b2 * b2;
      }
    }
    const float r = rsqrtf(wave_sum(ss) * (1.f / 1024.f) + EPS);
#pragma unroll
    for (int c = 0; c < 2; ++c) {
      const float* g = p.ssm_norm_g + c * 512 + lane * 8;
      u32x4 w;
#pragma unroll
      for (int j = 0; j < 4; ++j) w[j] = pk_bf16(v[c * 8 + 2 * j] * r * g[2 * j], v[c * 8 + 2 * j + 1] * r * g[2 * j + 1]);
      *(u32x4*)(p.ycat + (size_t)row * 1536 + c * 512 + lane * 8) = w;
    }
    {
      const u32x4 o = cur.o;
      float f[8] = {bflo(o[0]), bfhi(o[0]), bflo(o[1]), bfhi(o[1]), bflo(o[2]), bfhi(o[2]), bflo(o[3]), bfhi(o[3])};
      float s2 = 0.f;
#pragma unroll
      for (int j = 0; j < 8; ++j) s2 += f[j] * f[j];
      const float r2 = rsqrtf(wave_sum(s2) * (1.f / 512.f) + EPS);
      const float* g = p.attn_norm_g + lane * 8;
      u32x4 w;
#pragma unroll
      for (int j = 0; j < 4; ++j) w[j] = pk_bf16(f[2 * j] * r2 * g[2 * j], f[2 * j + 1] * r2 * g[2 * j + 1]);
      *(u32x4*)(p.ycat + (size_t)row * 1536 + 1024 + lane * 8) = w;
    }
    cur = nxt;
  }
}

__device__ void ln1_phase(const Params& p) {
  const int lane = phase_tid() & 63, wid = phase_tid() >> 6;
  const int stride = gridDim.x * 8;
  int row = blockIdx.x * 8 + wid;
  u32x4 nx[2];
  if (row < TX) { nx[0] = *(const u32x4*)(p.pre + (size_t)row * DM + lane * 8); nx[1] = *(const u32x4*)(p.pre + (size_t)row * DM + 512 + lane * 8); }
  for (; row < TX; row += stride) {
    const u32x4 cu[2] = {nx[0], nx[1]};
    if (row + stride < TX) { nx[0] = *(const u32x4*)(p.pre + (size_t)(row + stride) * DM + lane * 8); nx[1] = *(const u32x4*)(p.pre + (size_t)(row + stride) * DM + 512 + lane * 8); }
    float v[16];
#pragma unroll
    for (int c = 0; c < 2; ++c) {
#pragma unroll
      for (int j = 0; j < 4; ++j) { v[c * 8 + 2 * j] = bflo(cu[c][j]); v[c * 8 + 2 * j + 1] = bfhi(cu[c][j]); }
    }
    float s = 0.f;
#pragma unroll
    for (int j = 0; j < 16; ++j) s += v[j];
    const float mu = wave_sum(s) * (1.f / DM);
    float s2 = 0.f;
#pragma unroll
    for (int j = 0; j < 16; ++j) { float d = v[j] - mu; s2 += d * d; }
    const float rstd = rsqrtf(wave_sum(s2) * (1.f / DM) + EPS);
#pragma unroll
    for (int c = 0; c < 2; ++c) {
      const float* g = p.ln1_g + c * 512 + lane * 8; const float* b = p.ln1_b + c * 512 + lane * 8;
      float o[8];
#pragma unroll
      for (int j = 0; j < 8; ++j) o[j] = (v[c * 8 + j] - mu) * rstd * g[j] + b[j];
      *(u32x4*)(p.h1 + (size_t)row * DM + c * 512 + lane * 8) = pack8(o);
      float am = 0.f;
#pragma unroll
      for (int j = 0; j < 8; ++j) am = fmaxf(am, fabsf(o[j]));
      am = fmaxf(am, __builtin_bit_cast(float, __builtin_amdgcn_update_dpp(0, __builtin_bit_cast(int, am), 0x128, 0xf, 0xf, true)));
      am = fmaxf(am, __builtin_bit_cast(float, __builtin_amdgcn_update_dpp(0, __builtin_bit_cast(int, am), 0x124, 0xf, 0xf, true)));
      am = fmaxf(am, __builtin_bit_cast(float, __builtin_amdgcn_update_dpp(0, __builtin_bit_cast(int, am), 0x122, 0xf, 0xf, true)));
      am = fmaxf(am, __builtin_bit_cast(float, __builtin_amdgcn_update_dpp(0, __builtin_bit_cast(int, am), 0x121, 0xf, 0xf, true)));
      const float sc = am > 0.f ? am * (1.f / 127.f) : 1.f;
      const float inv = 1.f / sc;
      unsigned w0 = 0u, w1 = 0u;
#pragma unroll
      for (int j = 0; j < 4; ++j) {
        w0 |= ((unsigned)__float2int_rn(o[j] * inv) & 255u) << (8 * j);
        w1 |= ((unsigned)__float2int_rn(o[4 + j] * inv) & 255u) << (8 * j);
      }
      *(u32x2*)(p.h1q + (size_t)row * DM + c * 512 + lane * 8) = (u32x2){w0, w1};
      if ((lane & 15) == 0) p.sx[(size_t)row * 8 + c * 4 + (lane >> 4)] = sc;
    }
  }
}

template <bool INT8>
__device__ void quant_rows(const float* __restrict__ src, unsigned char* __restrict__ dstq, float* __restrict__ scl) {
  const int lane = phase_tid() & 63, wid = phase_tid() >> 6;
  for (int e = blockIdx.x * 8 + wid; e < 16384; e += gridDim.x * 8) {
    const float* r = src + (size_t)e * 1024 + lane * 4;
    f32x4 a[4];
#pragma unroll
    for (int j = 0; j < 4; ++j) a[j] = *(const f32x4*)(r + j * 256);
    float m = 0.f;
#pragma unroll
    for (int j = 0; j < 4; ++j)
#pragma unroll
      for (int k = 0; k < 4; ++k) m = fmaxf(m, fabsf(a[j][k]));
#pragma unroll
    for (int o = 32; o >= 1; o >>= 1) m = fmaxf(m, __shfl_xor(m, o));
    const float sc = m > 0.f ? m * (INT8 ? (1.f / 127.f) : (1.f / 240.f)) : 1.f;
    const float inv = 1.f / sc;
#pragma unroll
    for (int j = 0; j < 4; ++j) {
      unsigned w;
      if (INT8) {
        w = 0u;
#pragma unroll
        for (int k = 0; k < 4; ++k) w |= ((unsigned)__float2int_rn(a[j][k] * inv) & 255u) << (8 * k);
      } else {
        int t = __builtin_amdgcn_cvt_pk_fp8_f32(a[j][0] * inv, a[j][1] * inv, 0, false);
        t = __builtin_amdgcn_cvt_pk_fp8_f32(a[j][2] * inv, a[j][3] * inv, t, true);
        w = (unsigned)t;
      }
      *(unsigned*)(dstq + ((size_t)(j * 2 + (lane >> 5)) * 16384 + e) * 128 + (lane & 31) * 4) = w;
    }
    if (lane == 0) scl[e] = sc;
  }
}

__device__ __forceinline__ float dpp_add8(float v) {
  v += __builtin_bit_cast(float, __builtin_amdgcn_update_dpp(0, __builtin_bit_cast(int, v), 0xB1, 0xf, 0xf, true));
  v += __builtin_bit_cast(float, __builtin_amdgcn_update_dpp(0, __builtin_bit_cast(int, v), 0x4E, 0xf, 0xf, true));
  v += __builtin_bit_cast(float, __builtin_amdgcn_update_dpp(0, __builtin_bit_cast(int, v), 0x141, 0xf, 0xf, true));
  return v;
}
__device__ __forceinline__ void fp8x16_to_f32(u32x4 w, float (&f)[16]) {
#pragma unroll
  for (int j = 0; j < 4; ++j) {
    f32x2_t lo = __builtin_amdgcn_cvt_pk_f32_fp8((int)w[j], false);
    f32x2_t hi = __builtin_amdgcn_cvt_pk_f32_fp8((int)w[j], true);
    f[4 * j] = lo[0]; f[4 * j + 1] = lo[1]; f[4 * j + 2] = hi[0]; f[4 * j + 3] = hi[1];
  }
}

__device__ void peer_u_phase(const Params& p, char* smem) {
  const int lane = phase_tid() & 63, wid = phase_tid() >> 6;
  const int sg = lane >> 3, q = lane & 7;
  const int nr = gridDim.x >> 3;
  if ((int)blockIdx.x >= nr * 8) return;
  const volatile LAS unsigned* st = (const volatile LAS unsigned*)(smem + LDS_BYTES - 32);
  const bool xok = st[4] != 0u;
  const int slice = xok ? (int)st[2] : (int)(blockIdx.x & 7), rank = xok ? (int)st[3] : (int)(blockIdx.x >> 3);
  const unsigned char* Us = p.Uq + (size_t)slice * 16384 * 128 + q * 16;
  const int stride = nr * 8;
  int t = rank * 8 + wid;
  if (t >= TX) return;
  struct Ids { u32x4 e[2]; u32x4 xq; float sx; };
  auto load_ids = [&](Ids& d, int tt) {
    tt = tt < TX ? tt : TX - 1;
    const unsigned short* ep = p.experts + (size_t)tt * 128 + sg * 16;
    d.e[0] = *(const u32x4*)ep; d.e[1] = *(const u32x4*)(ep + 8);
    d.xq = *(const u32x4*)(p.h1q + (size_t)tt * DM + slice * 128 + q * 16);
    d.sx = p.sx[(size_t)tt * 8 + slice];
  };
  auto issue = [&](u32x4 (&uq)[8], const u32x4& ew) {
#pragma unroll
    for (int j = 0; j < 4; ++j) {
      uq[2 * j] = *(const u32x4*)(Us + (size_t)(ew[j] & 0xffffu) * 128);
      uq[2 * j + 1] = *(const u32x4*)(Us + (size_t)(ew[j] >> 16) * 128);
    }
  };
  auto compute = [&](const u32x4 (&uq)[8], const u32x4& xq, float sxv, float (&pdv)[8]) {
#pragma unroll
    for (int i = 0; i < 8; ++i) {
      int d = 0;
#pragma unroll
      for (int j = 0; j < 4; ++j) d = __builtin_amdgcn_sdot4((int)uq[i][j], (int)xq[j], d, false);
      d += __builtin_amdgcn_update_dpp(0, d, 0xB1, 0xf, 0xf, true);
      d += __builtin_amdgcn_update_dpp(0, d, 0x4E, 0xf, 0xf, true);
      d += __builtin_amdgcn_update_dpp(0, d, 0x141, 0xf, 0xf, true);
      pdv[i] = (float)d * sxv;
    }
  };
  auto step = [&](Ids& cur, Ids& nxt, Ids& nn, u32x4 (&P)[8], u32x4 (&Q)[8], u32x4 (&R)[8]) -> bool {
    const bool has1 = t + stride < TX;
    issue(R, nxt.e[0]);
    load_ids(nn, t + 2 * stride);
    float pa[8], pb[8];
    compute(P, cur.xq, cur.sx, pa);
    issue(P, nxt.e[1]);
    compute(Q, cur.xq, cur.sx, pb);
    if (q == 0) {
      bf16_t* dst = p.pd + ((size_t)slice * TX + t) * 128 + sg * 16;
      *(u32x4*)dst = (u32x4){pk_bf16(pa[0], pa[1]), pk_bf16(pa[2], pa[3]), pk_bf16(pa[4], pa[5]), pk_bf16(pa[6], pa[7])};
      *(u32x4*)(dst + 8) = (u32x4){pk_bf16(pb[0], pb[1]), pk_bf16(pb[2], pb[3]), pk_bf16(pb[4], pb[5]), pk_bf16(pb[6], pb[7])};
    }
    return has1;
  };
  Ids A, B, C;
  u32x4 X[8], Y[8], Z[8];
  load_ids(A, t);
  load_ids(B, t + stride);
  issue(X, A.e[0]);
  issue(Y, A.e[1]);
  for (;;) {
    if (!step(A, B, C, X, Y, Z)) break;
    t += stride;
    if (!step(B, C, A, Z, X, Y)) break;
    t += stride;
    if (!step(C, A, B, Y, Z, X)) break;
    t += stride;
  }
}

__device__ void peer_c_phase(const Params& p) {
  const size_t n4 = (size_t)TX * 128 / 4;
  const int tid = phase_tid();
  for (size_t i0 = (size_t)blockIdx.x * NTHREADS; i0 < n4; i0 += (size_t)gridDim.x * NTHREADS) {
    const size_t i = i0 + tid;
    f32x4 s = {0.f, 0.f, 0.f, 0.f};
#pragma unroll
    for (int sl = 0; sl < 8; ++sl) {
      const u32x2 w = *(const u32x2*)(p.pd + (size_t)sl * TX * 128 + i * 4);
      s[0] += bflo(w[0]); s[1] += bfhi(w[0]); s[2] += bflo(w[1]); s[3] += bfhi(w[1]);
    }
    const f32x4 g = *(const f32x4*)(p.gates + i * 4);
    const u32x2 ew = *(const u32x2*)(p.experts + i * 4);
    const int ev[4] = {(int)(ew[0] & 0xffffu), (int)(ew[0] >> 16), (int)(ew[1] & 0xffffu), (int)(ew[1] >> 16)};
    float c[4];
    float am = 0.f;
#pragma unroll
    for (int j = 0; j < 4; ++j) {
      const float d = s[j] * p.su[ev[j]];
      c[j] = g[j] * 0.5f * d * (1.f + erff(d * 0.70710678118654752f)) * p.sv[ev[j]];
      am = fmaxf(am, fabsf(c[j]));
    }
#pragma unroll
    for (int o = 16; o >= 1; o >>= 1) am = fmaxf(am, __shfl_xor(am, o));
    const float sc = am > 0.f ? am * (1.f / 240.f) : 1.f;
    const float inv = 1.f / sc;
    int w = __builtin_amdgcn_cvt_pk_fp8_f32(c[0] * inv, c[1] * inv, 0, false);
    w = __builtin_amdgcn_cvt_pk_fp8_f32(c[2] * inv, c[3] * inv, w, true);
    const size_t t = i >> 5; const int gq = (int)(i & 31);
    const int c4 = gq & 3, sgq = gq >> 2, a4 = sgq >> 2, r4 = sgq & 3;
    unsigned outw = 0u;
#pragma unroll
    for (int m = 0; m < 4; ++m) {
      const int srcl = (tid & 32) + (4 * a4 + m) * 4 + c4;
      const unsigned vm = (unsigned)__builtin_amdgcn_ds_bpermute(srcl * 4, w);
      outw |= ((vm >> (8 * r4)) & 255u) << (8 * m);
    }
    ((unsigned*)(p.cq + t * 128))[(4 * c4 + r4) * 2 + a4] = outw;
    if (gq == 0) p.csc[t] = sc;
  }
}

typedef int v2i_t __attribute__((ext_vector_type(2)));
constexpr int PV_BLK = 1024 + 32;
constexpr int PV_WAVE_LDS = 16 * PV_BLK + 512;
static_assert(8 * PV_WAVE_LDS <= 160 * 1024 - 64, "peer v lds");
__device__ void peer_v_phase(const Params& p, char* smem) {
  const int lane = phase_tid() & 63, wid = __builtin_amdgcn_readfirstlane(phase_tid() >> 6);
  const int sg = (lane >> 2) & 7, q = (lane >> 5) * 4 + (lane & 3);
  const int kg = lane >> 4;
  const int nr = gridDim.x >> 3;
  if ((int)blockIdx.x >= nr * 8) return;
  const volatile LAS unsigned* st = (const volatile LAS unsigned*)(smem + LDS_BYTES - 32);
  const bool xok = st[4] != 0u;
  const int slice = xok ? (int)st[2] : (int)(blockIdx.x & 7), rank = xok ? (int)st[3] : (int)(blockIdx.x >> 3);
  const unsigned char* Vs = p.Vq + (size_t)slice * 16384 * 128 + q * 16;
  LAS char* wb = (LAS char*)smem + wid * PV_WAVE_LDS;
  const int stride = nr * 8;
  int t = rank * 8 + wid;
  if (t >= TX) return;
  struct Ids { u32x4 e[2]; u32x2 a[4]; float sc; u32x4 xa, xb; };
  auto ldg16 = [&](u32x4& d, const void* ptr) { asm volatile("global_load_dwordx4 %0, %1, off" : "=v"(d) : "v"(ptr) : "memory"); };
  auto ldg8 = [&](u32x2& d, const void* ptr) { asm volatile("global_load_dwordx2 %0, %1, off" : "=v"(d) : "v"(ptr) : "memory"); };
  auto ldg4 = [&](float& d, const void* ptr) { asm volatile("global_load_dword %0, %1, off" : "=v"(d) : "v"(ptr) : "memory"); };
  auto load_ids = [&](Ids& d, int tt) {
    tt = tt < TX ? tt : TX - 1;
    const bf16_t* xp = p.h1 + (size_t)tt * DM + slice * 128 + (lane & 7) * 16;
    ldg16(d.xa, xp); ldg16(d.xb, xp + 8);
    const unsigned short* ep = p.experts + (size_t)tt * 128 + sg * 16;
    ldg16(d.e[0], ep); ldg16(d.e[1], ep + 8);
    const unsigned char* cp = p.cq + (size_t)tt * 128 + kg * 8;
#pragma unroll
    for (int ks = 0; ks < 4; ++ks) ldg8(d.a[ks], cp + ks * 32);
    ldg4(d.sc, p.csc + tt);
  };
  auto pin = [&](Ids& d) {
    asm volatile("" : "+v"(d.xa), "+v"(d.xb), "+v"(d.e[0]), "+v"(d.e[1]), "+v"(d.a[0]), "+v"(d.a[1]), "+v"(d.a[2]), "+v"(d.a[3]), "+v"(d.sc));
  };
  const unsigned wb_lds = (unsigned)__builtin_amdgcn_readfirstlane((int)(unsigned)(unsigned long long)wb);
  auto dma = [&](const unsigned char* gsrc, unsigned lds_dst) {
    unsigned keep;
    asm volatile("s_mov_b32 %0, m0\n\ts_mov_b32 m0, %2\n\ts_nop 0\n\tglobal_load_lds_dwordx4 %1, off\n\ts_mov_b32 m0, %0"
                 : "=&s"(keep) : "v"(gsrc), "s"(lds_dst) : "memory");
  };
  auto issue = [&](int half, const u32x4& ew) {
    asm volatile("s_waitcnt lgkmcnt(0)" ::: "memory");
#pragma unroll
    for (int j = 0; j < 4; ++j) {
      dma(Vs + (size_t)(ew[j] & 0xffffu) * 128, wb_lds + (unsigned)((half * 8 + 2 * j) * PV_BLK));
      dma(Vs + (size_t)(ew[j] >> 16) * 128, wb_lds + (unsigned)((half * 8 + 2 * j + 1) * PV_BLK));
    }
  };
  f32x4 acc[8];
  const int troff = ((lane & 15) >> 1) * 64 + (lane & 1) * 8;
  auto consume = [&](int half, const Ids& d) {
#pragma unroll
    for (int k2 = 0; k2 < 2; ++k2) {
      const u32x2 av = d.a[half * 2 + k2];
      const long a = (long)(((unsigned long long)av[1] << 32) | (unsigned long long)av[0]);
      const LAS char* blk = wb + (half * 8 + k2 * 4 + kg) * PV_BLK + troff;
#pragma unroll
      for (int nt = 0; nt < 8; ++nt) {
        const v2i_t bv = __builtin_amdgcn_ds_read_tr8_b64_v2i32((LAS v2i_t*)(blk + (nt >> 2) * 512 + (nt & 3) * 16));
        const long bl = (long)(((unsigned long long)(unsigned)bv[1] << 32) | (unsigned long long)(unsigned)bv[0]);
        acc[nt] = __builtin_amdgcn_mfma_f32_16x16x32_fp8_fp8(a, bl, acc[nt], 0, 0, 0);
      }
    }
  };
  Ids A, B, C;
  asm volatile("s_waitcnt vmcnt(0)" ::: "memory");
  load_ids(A, t);
  load_ids(B, t + stride);
  asm volatile("s_waitcnt vmcnt(0)" ::: "memory");
  pin(A); pin(B);
  issue(0, A.e[0]);
  auto step = [&](Ids& cur, Ids& nxt, Ids& nn, bool first) -> bool {
    const bool has1 = t + stride < TX;
    load_ids(nn, t + 2 * stride);
    issue(1, cur.e[1]);
#pragma unroll
    for (int nt = 0; nt < 8; ++nt) acc[nt] = (f32x4){0.f, 0.f, 0.f, 0.f};
    if (first) asm volatile("s_waitcnt vmcnt(16)" ::: "memory"); else asm volatile("s_waitcnt vmcnt(18)" ::: "memory");
    consume(0, cur);
    issue(0, nxt.e[0]);
    asm volatile("s_waitcnt vmcnt(8)" ::: "memory");
    pin(nn);
    consume(1, cur);
    LAS float* yt = (LAS float*)(wb + 16 * PV_BLK);
    if (lane < 16) {
#pragma unroll
      for (int nt = 0; nt < 8; ++nt) yt[nt * 16 + lane] = acc[nt][0];
    }
    asm volatile("s_waitcnt lgkmcnt(0)" ::: "memory");
    if (lane < 8) {
      float v[16];
#pragma unroll
      for (int j = 0; j < 4; ++j) { const f32x4 f = *(const LAS f32x4*)(yt + lane * 16 + j * 4); v[4 * j] = f[0]; v[4 * j + 1] = f[1]; v[4 * j + 2] = f[2]; v[4 * j + 3] = f[3]; }
      float xs[16];
#pragma unroll
      for (int j = 0; j < 4; ++j) { xs[2 * j] = bflo(cur.xa[j]); xs[2 * j + 1] = bfhi(cur.xa[j]); xs[8 + 2 * j] = bflo(cur.xb[j]); xs[8 + 2 * j + 1] = bfhi(cur.xb[j]); }
      bf16_t* dst = p.pre2 + (size_t)t * DM + slice * 128 + lane * 16;
      u32x4 w0, w1;
#pragma unroll
      for (int j = 0; j < 4; ++j) {
        w0[j] = pk_bf16(ALPHA * xs[2 * j] + cur.sc * v[2 * j], ALPHA * xs[2 * j + 1] + cur.sc * v[2 * j + 1]);
        w1[j] = pk_bf16(ALPHA * xs[8 + 2 * j] + cur.sc * v[8 + 2 * j], ALPHA * xs[8 + 2 * j + 1] + cur.sc * v[8 + 2 * j + 1]);
      }
      *(u32x4*)dst = w0; *(u32x4*)(dst + 8) = w1;
    }
    return has1;
  };
  if (step(A, B, C, true)) {
    t += stride;
    for (;;) {
      if (!step(B, C, A, false)) break;
      t += stride;
      if (!step(C, A, B, false)) break;
      t += stride;
      if (!step(A, B, C, false)) break;
      t += stride;
    }
  }
  asm volatile("s_waitcnt vmcnt(0)" ::: "memory");
}

__device__ void ln2_phase(const Params& p) {
  const int lane = phase_tid() & 63, wid = phase_tid() >> 6;
  const int stride = gridDim.x * 8;
  int row = blockIdx.x * 8 + wid;
  u32x2 nx[4];
  if (row < TX) {
#pragma unroll
    for (int c = 0; c < 4; ++c) nx[c] = *(const u32x2*)(p.pre2 + (size_t)row * DM + c * 256 + lane * 4); }
  for (; row < TX; row += stride) {
    float* dst = p.out + (size_t)row * DM;
    float v[16];
#pragma unroll
    for (int c = 0; c < 4; ++c) { v[c * 4] = bflo(nx[c][0]); v[c * 4 + 1] = bfhi(nx[c][0]); v[c * 4 + 2] = bflo(nx[c][1]); v[c * 4 + 3] = bfhi(nx[c][1]); }
    if (row + stride < TX) {
#pragma unroll
      for (int c = 0; c < 4; ++c) nx[c] = *(const u32x2*)(p.pre2 + (size_t)(row + stride) * DM + c * 256 + lane * 4); }
    float s = 0.f;
#pragma unroll
    for (int j = 0; j < 16; ++j) s += v[j];
    const float mu = wave_sum(s) * (1.f / DM);
    float s2 = 0.f;
#pragma unroll
    for (int j = 0; j < 16; ++j) { float d = v[j] - mu; s2 += d * d; }
    const float rstd = rsqrtf(wave_sum(s2) * (1.f / DM) + EPS);
#pragma unroll
    for (int c = 0; c < 4; ++c) {
      const f32x4 g = *(const f32x4*)(p.ln2_g + c * 256 + lane * 4), bb = *(const f32x4*)(p.ln2_b + c * 256 + lane * 4);
      f32x4 o;
#pragma unroll
      for (int j = 0; j < 4; ++j) o[j] = (v[c * 4 + j] - mu) * rstd * g[j] + bb[j];
      *(f32x4*)(dst + c * 256 + lane * 4) = o;
    }
  }
}


#define XB_TMO      128
#define XB_XCNT(j)  (256  + 64 * (j))
#define XB_XSUB(j)  (1280 + 64 * (j))
#define XB_XGEN(j)  (2304 + 64 * (j))
#define XB_TOP      3328
#define XB_TOPGEN   3392
#define XCD_BAR_WORDS 3456
#define XB_SPIN_CAP (1u << 22)
__device__ __forceinline__ unsigned xb_ld(unsigned* p)              { return __hip_atomic_load(p, __ATOMIC_RELAXED, __HIP_MEMORY_SCOPE_AGENT); }
__device__ __forceinline__ unsigned xb_add(unsigned* p, unsigned v) { return __hip_atomic_fetch_add(p, v, __ATOMIC_RELAXED, __HIP_MEMORY_SCOPE_AGENT); }
__device__ __forceinline__ unsigned xb_xcc_id() { return (unsigned)__builtin_amdgcn_s_getreg((3 << 11) | 20) & 0xFu; }
#define XB_SPIN(cond, bar) do { unsigned _sp = 0; while (cond) { __builtin_amdgcn_s_sleep(1); \
    if ((++_sp & 255u) == 0u) { if (xb_ld(&(bar)[XB_TMO])) break; if (_sp > XB_SPIN_CAP) { atomicAdd(&(bar)[XB_TMO], 1u); break; } } } } while (0)
struct XcdBarrier { unsigned* bar; unsigned x; volatile LAS unsigned* st; };
__device__ __forceinline__ XcdBarrier xcd_barrier_post(unsigned* bar, volatile LAS unsigned* st) {
  XcdBarrier b; b.bar = bar; b.x = xb_xcc_id(); b.st = st;
  if (threadIdx.x == 0) (void)xb_add(&bar[XB_XCNT(b.x)], 1u);
  return b;
}
__device__ __forceinline__ void xcd_barrier_complete(unsigned* bar, unsigned x, unsigned& nloc, unsigned& nx) {
  const unsigned G = gridDim.x * gridDim.y * gridDim.z;
  unsigned sum, cnt, mine, sp = 0u;
  for (;;) {
    sum = 0u; cnt = 0u; mine = 0u;
#pragma unroll
    for (unsigned j = 0; j < 16; ++j) { const unsigned c = xb_ld(&bar[XB_XCNT(j)]); sum += c; cnt += (c > 0u) ? 1u : 0u; mine = (j == x) ? c : mine; }
    if (sum == G) break;
    __builtin_amdgcn_s_sleep(1);
    if ((++sp & 255u) == 0u) { if (xb_ld(&bar[XB_TMO])) break; if (sp > XB_SPIN_CAP) { atomicAdd(&bar[XB_TMO], 1u); break; } }
  }
  nloc = mine > 0u ? mine : 1u; nx = cnt > 0u ? cnt : 1u;
}
__device__ __forceinline__ void xcd_barrier(const XcdBarrier& b) {
  asm volatile("s_waitcnt vmcnt(0)" ::: "memory");
  __syncthreads();
  if (threadIdx.x == 0) {
    unsigned* bar = b.bar;
    __builtin_amdgcn_s_waitcnt(0);
    unsigned nloc = b.st[0], nx = b.st[1];
    if (nloc == 0u) { xcd_barrier_complete(bar, b.x, nloc, nx); b.st[0] = nloc; b.st[1] = nx; }
    const unsigned old = xb_add(&bar[XB_XSUB(b.x)], 1u);
    const unsigned gen = old / nloc;
    if (old + 1u == (gen + 1u) * nloc) {
      __builtin_amdgcn_fence(__ATOMIC_RELEASE, "agent");
      asm volatile("s_waitcnt vmcnt(0)" ::: "memory");
      const unsigned og = xb_add(&bar[XB_TOP], 1u);
      const unsigned tg = og / nx;
      if (og + 1u == (tg + 1u) * nx) xb_add(&bar[XB_TOPGEN], 1u);
      else XB_SPIN(xb_ld(&bar[XB_TOPGEN]) == tg, bar);
      __builtin_amdgcn_fence(__ATOMIC_ACQUIRE, "agent");
      xb_add(&bar[XB_XGEN(b.x)], 1u);
      asm volatile("s_waitcnt vmcnt(0)" ::: "memory");
    } else {
      XB_SPIN(xb_ld(&bar[XB_XGEN(b.x)]) == gen, bar);
      __builtin_amdgcn_fence(__ATOMIC_ACQUIRE, "agent");
      asm volatile("s_waitcnt vmcnt(0)" ::: "memory");
    }
  }
  __syncthreads();
}

template <int PH>
__device__ __forceinline__ void run_phase(const Params& p, char* smem) {
  if constexpr (PH == 0) {
    transpose_convert(p.w_in, p.WinT, 1024, 3264, DINP, smem);
    transpose_convert(p.w_uq, p.WuqT, 384, 768, 768, smem);
    for (int i = blockIdx.x * NTHREADS + threadIdx.x; i < 512 * 256; i += gridDim.x * NTHREADS) {
      const int j = i >> 8, k = i & 255;
      const float* src = p.w_ukv + (size_t)k * 1024 + (j >> 6) * 128 + (j & 63);
      p.WkT[i] = f2bf(src[0]); p.WvT[i] = f2bf(src[64]);
    }
    transpose_convert(p.w_out, p.WoutT, 1536, 1024, 1024, smem);
    fold_peer(p, smem);
    ln_in_phase(p);
  } else if constexpr (PH == 1) {
    pg8::run(smem, p.h0, p.WinT, TP, DINP, 1024, pg8::EpiBf16S{p.z, 1024, 1024, p.xbc_raw, 1536, 2560, p.rest, 768});
  } else if constexpr (PH == 2) {
    conv_phase(p, smem);
    token_phase(p);
    dt_phase(p);
  } else if constexpr (PH == 3) {
    pg8::run(smem, p.cqn, p.WuqT, TX, 768, 384, pg8::EpiBf16S{p.q, 768, 1 << 30, nullptr, 0, 1 << 30, nullptr, 0});
    pg8::run(smem, p.ckvn, p.WkT, TP, 512, 256, pg8::EpiBf16S{p.Kb, 512, 1 << 30, nullptr, 0, 1 << 30, nullptr, 0});
    pg8::run(smem, p.WvT, p.ckvn, 512, TP, 256, pg8::EpiBf16S{p.vT, TP, 1 << 30, nullptr, 0, 1 << 30, nullptr, 0});
  } else if constexpr (PH == 4) {
    attn_phase(p, smem);
  } else if constexpr (PH == 5) {
    ssd_phase(p, smem);
  } else if constexpr (PH == 6) {
    gate_phase(p);
  } else if constexpr (PH == 7) {
    pg8::run(smem, p.ycat, p.WoutT, TX, 1024, 1536, pg8::EpiOutRes{p.pre, p.h0});
  } else if constexpr (PH == 8) {
    ln1_phase(p);
    quant_rows<true>(p.peer_u, p.Uq, p.su);
    quant_rows<false>(p.peer_v, p.Vq, p.sv);
  } else if constexpr (PH == 9) {
    pg8::run_drained(smem, p.h1, p.WpT, TX, 2048, 1024, pg8::EpiPeerScore{p.experts, p.gates});
  } else if constexpr (PH == 11) {
    peer_u_phase(p, smem);
  } else if constexpr (PH == 12) {
    peer_c_phase(p);
  } else if constexpr (PH == 13) {
    peer_v_phase(p, smem);
  } else if constexpr (PH == 14) {
    ln2_phase(p);
  } else if constexpr (PH == 15) {
    ssd_diag_phase(p, smem);
  }
}

__global__ void __launch_bounds__(NTHREADS) mega_kernel(Params p) {
  extern __shared__ __attribute__((aligned(16))) char smem[];
  cg::grid_group grid = cg::this_grid();
  volatile LAS unsigned* st = (volatile LAS unsigned*)(smem + LDS_BYTES - 32);
  if (threadIdx.x == 0) {
    st[0] = 0u; st[1] = 0u;
    const unsigned xcc = xb_xcc_id();
    st[2] = xcc; st[3] = xb_add(&p.bar[xcc], 1u);
  }
  __syncthreads();
  XcdBarrier xb = xcd_barrier_post(p.bar, st);
  run_phase<0>(p, smem); grid.sync();
  if (threadIdx.x == 0) {
    unsigned ok = (gridDim.x & 7u) == 0u ? 1u : 0u;
    for (unsigned j = 0; j < 16; ++j) { const unsigned c = xb_ld(&p.bar[j]); if (c != (j < 8 ? gridDim.x >> 3 : 0u)) ok = 0u; }
    st[4] = ok;
  }
  __syncthreads();
  run_phase<1>(p, smem); xcd_barrier(xb);
  run_phase<2>(p, smem); xcd_barrier(xb);
  run_phase<15>(p, smem); xcd_barrier(xb);
  run_phase<5>(p, smem); xcd_barrier(xb);
  run_phase<3>(p, smem); xcd_barrier(xb);
  run_phase<4>(p, smem); xcd_barrier(xb);
  run_phase<6>(p, smem); xcd_barrier(xb);
  run_phase<7>(p, smem); xcd_barrier(xb);
  run_phase<8>(p, smem); xcd_barrier(xb);
  run_phase<9>(p, smem); xcd_barrier(xb);
  run_phase<11>(p, smem); xcd_barrier(xb);
  run_phase<12>(p, smem); xcd_barrier(xb);
  run_phase<13>(p, smem); xcd_barrier(xb);
  run_phase<14>(p, smem);
}

extern "C" void kernel_launch(void* const* d_in, const int* in_sizes, int n_in,
                              void* d_out, int out_size, void* d_ws, size_t ws_size,
                              hipStream_t stream) {
  Params p{};
  const float** in = (const float**)&p.x_prompt;
  for (int i = 0; i < 28; ++i) in[i] = (const float*)d_in[i];
  p.out = (float*)d_out;
  char* ws = (char*)d_ws;
  size_t off = 0;
  auto take = [&](size_t bytes) { char* r = ws + off; off += (bytes + 255) & ~(size_t)255; return r; };
  p.h0 = (bf16_t*)take((size_t)TP * 1024 * 2);
  p.WinT = (bf16_t*)take((size_t)DINP * 1024 * 2);
  p.WuqT = (bf16_t*)take((size_t)768 * 384 * 2);
  p.WkT = (bf16_t*)take((size_t)512 * 256 * 2);
  p.WvT = (bf16_t*)take((size_t)512 * 256 * 2);
  p.WoutT = (bf16_t*)take((size_t)1024 * 1536 * 2);
  p.WpT = (bf16_t*)take((size_t)2048 * 1024 * 2);
  char* zreg = take((size_t)TP * 1024 * 2);
  char* r1 = take((size_t)TP * 1536 * 2);
  char* r2 = take((size_t)TP * 768 * 2);
  p.cqn = (bf16_t*)take((size_t)TP * 384 * 2);
  p.ckvn = (bf16_t*)take((size_t)TP * 256 * 2);
  p.kr = (bf16_t*)take((size_t)TP * 32 * 2);
  p.dtv = (float*)take((size_t)NSEQ * 2 * 16 * LP * 4);
  p.Pv = (float*)take((size_t)NSEQ * 2 * 16 * LP * 4);
  p.Atot = (float*)take((size_t)NSEQ * 2 * 16 * NCH * 4);
  p.bar = (unsigned*)take((size_t)XCD_BAR_WORDS * 4);
  if (off > ws_size) { fprintf(stderr, "workspace too small: need %zu have %zu\n", off, ws_size); return; }
  p.z = (bf16_t*)zreg;
  p.xbc_raw = (bf16_t*)r1;
  p.rest = (bf16_t*)r2;
  char* dout = (char*)d_out;
  p.XT = (bf16_t*)dout;
  p.Cm = (bf16_t*)(dout + (size_t)NSEQ * NCH * 16 * 64 * 128 * 2);
  p.Bm = p.Cm + (size_t)NSEQ * LP * 256;
  p.BmT = p.Bm + (size_t)NSEQ * LP * 256;
  p.pre = (bf16_t*)d_out;
  p.Kb = (bf16_t*)dout;
  p.vT = p.Kb + (size_t)TP * 512;
  p.o = p.vT + (size_t)512 * TP;
  p.Y = (bf16_t*)r1;
  p.Yb2 = p.Y + (size_t)TX * 1024;
  p.q = (bf16_t*)r2;
  p.ycat = (bf16_t*)r2;
  p.h1 = p.h0;
  p.Uq = (unsigned char*)zreg;
  p.Vq = p.Uq + (size_t)8 * 16384 * 128;
  p.su = (float*)(p.Vq + (size_t)8 * 16384 * 128);
  p.sv = p.su + 16384;
  p.sx = p.sv + 16384;
  p.h1q = (unsigned char*)(p.sx + (size_t)TX * 8);
  p.pd = (bf16_t*)d_out;
  p.cq = (unsigned char*)r2;
  p.csc = (float*)(r2 + (size_t)8 * 1024 * 1024);
  p.pre2 = (bf16_t*)(r2 + (size_t)16 * 1024 * 1024);
  p.experts = (unsigned short*)(r1 + (size_t)TX * 256 * 4);
  p.gates = (float*)(r1 + (size_t)TX * 256 * 4 + (size_t)TX * 128 * 4);

  static int grid_blocks = 0;
  if (!grid_blocks) {
    int dev = 0, cus = 0, per_cu = 0;
    (void)hipGetDevice(&dev);
    (void)hipDeviceGetAttribute(&cus, hipDeviceAttributeMultiprocessorCount, dev);
    (void)hipFuncSetAttribute((const void*)mega_kernel, hipFuncAttributeMaxDynamicSharedMemorySize, (int)LDS_BYTES);
    (void)hipOccupancyMaxActiveBlocksPerMultiprocessor(&per_cu, mega_kernel, NTHREADS, LDS_BYTES);
    if (per_cu > 1) per_cu = 1;
    grid_blocks = cus * per_cu;
  }
  (void)hipMemsetAsync(p.bar, 0, (size_t)XCD_BAR_WORDS * 4, stream);
  void* args[] = {&p};
  hipError_t e = hipLaunchCooperativeKernel((void*)mega_kernel, dim3(grid_blocks), dim3(NTHREADS), args, LDS_BYTES, stream);
  if (e != hipSuccess) fprintf(stderr, "cooperative launch failed: %s (grid %d)\n", hipGetErrorString(e), grid_blocks);
}
```

```cpp
#include <hip/hip_runtime.h>
#include <hip/hip_cooperative_groups.h>
#include <cstdio>
#include <cstdint>
namespace cg = cooperative_groups;

typedef unsigned short bf16_t;
typedef short bf16x8 __attribute__((ext_vector_type(8)));
typedef float f32x4 __attribute__((ext_vector_type(4)));
typedef float f32x16 __attribute__((ext_vector_type(16)));
typedef unsigned u32x4 __attribute__((ext_vector_type(4)));
typedef unsigned u32x2 __attribute__((ext_vector_type(2)));

#define NTHREADS 512
#define LAS __attribute__((address_space(3)))
constexpr int DM = 1024;
constexpr int NSEQ = 24, SEQ = 2048, NMETA = 16, LSEQ = 2064;
constexpr int TX = NSEQ * SEQ;
constexpr int TM = TX + NMETA;
constexpr int TP = 49408;
constexpr int LP = 2176, NCH = 17, MPAD = 112;
constexpr int DINP = 3328;
constexpr float EPS = 1e-5f;
constexpr float ALPHA = 1.189207115002721f;
constexpr size_t LDS_BYTES = 160 * 1024;

struct Params {
  const float *x_prompt, *x_sample, *meta, *ln_in_g, *ln_in_b, *w_in, *conv_w, *conv_b,
      *dt_bias_f, *dt_bias_b, *a_log_f, *a_log_b, *d_skip, *ssm_norm_g, *q_norm_g, *w_uq, *kv_norm_g, *w_ukv,
      *attn_norm_g, *w_out, *ln1_g, *ln1_b, *peer_wq, *peer_sk, *peer_u, *peer_v, *ln2_g, *ln2_b;
  float* out;
  bf16_t *h0, *WinT, *WuqT, *WkT, *WvT, *WoutT, *WpT, *z, *xbc_raw, *rest, *cqn, *ckvn, *kr;
  float *dtv, *Pv, *Atot;
  bf16_t *XT, *Cm, *Bm, *BmT;
  bf16_t *q, *Kb, *vT, *o, *Y, *Yb2, *ycat, *h1;
  unsigned char *Uq, *Vq;
  unsigned char* h1q;
  float *su, *sv, *sx;
  bf16_t* pd;
  bf16_t* pre2;
  unsigned char* cq;
  float* csc;
  unsigned* bar;
  bf16_t* pre;
  unsigned short* experts;
  float* gates;
};

__device__ __forceinline__ int phase_tid() { int t = threadIdx.x; asm volatile("" : "+v"(t)); return t; }
__device__ __forceinline__ void lds_barrier() {
  asm volatile("s_waitcnt lgkmcnt(0)" ::: "memory");
  __builtin_amdgcn_s_barrier();
  asm volatile("" ::: "memory");
}
__device__ __forceinline__ float bf2f(bf16_t v) { return __uint_as_float(((unsigned)v) << 16); }
__device__ __forceinline__ float bflo(unsigned v) { return __uint_as_float(v << 16); }
__device__ __forceinline__ float bfhi(unsigned v) { return __uint_as_float(v & 0xffff0000u); }
typedef __bf16 bf16x2_t __attribute__((ext_vector_type(2)));
typedef float f32x2_t __attribute__((ext_vector_type(2)));
__device__ __forceinline__ unsigned pk_bf16(float lo, float hi) {
  f32x2_t f = {lo, hi};
  bf16x2_t b = __builtin_convertvector(f, bf16x2_t);
  return __builtin_bit_cast(unsigned, b);
}
__device__ __forceinline__ bf16_t f2bf(float f) { return (bf16_t)(pk_bf16(f, 0.f) & 0xffffu); }
__device__ __forceinline__ float wave_sum(float v) {
#pragma unroll
  for (int o = 32; o >= 1; o >>= 1) v += __shfl_xor(v, o);
  return v;
}
__device__ __forceinline__ void fast_sincos(float ang, float& sn, float& cs) {
  const float r = __builtin_amdgcn_fractf(ang * 0.15915494309189535f);
  sn = __builtin_amdgcn_sinf(r); cs = __builtin_amdgcn_cosf(r);
}
__device__ __forceinline__ float silu_f(float x) { return x * __builtin_amdgcn_rcpf(1.f + __expf(-x)); }
__device__ __forceinline__ int row_of(int seq, int pos) { return pos < NMETA ? TX + pos : seq * SEQ + pos - NMETA; }
__device__ __forceinline__ bf16x8 as_bf16x8(u32x4 v) { return __builtin_bit_cast(bf16x8, v); }

__device__ void transpose_convert(const float* in, bf16_t* out, int R, int C, int CP, char* smem) {
  float* tile = (float*)smem;
  const int tr = (R + 63) / 64, tc = (CP + 63) / 64;
  for (int t = blockIdx.x; t < tr * tc; t += gridDim.x) {
    const int r0 = (t / tc) * 64, c0 = (t % tc) * 64;
    __syncthreads();
    for (int i = phase_tid(); i < 4096; i += NTHREADS) {
      int r = i >> 6, c = i & 63;
      float v = 0.f;
      if (r0 + r < R && c0 + c < C) v = in[(size_t)(r0 + r) * C + c0 + c];
      tile[r * 65 + c] = v;
    }
    __syncthreads();
    for (int i = phase_tid(); i < 4096; i += NTHREADS) {
      int c = i >> 6, r = i & 63;
      if (r0 + r < R && c0 + c < CP) out[(size_t)(c0 + c) * R + r0 + r] = f2bf(tile[r * 65 + c]);
    }
  }
}

__device__ void fold_peer(const Params& p, char* smem) {
  float* wq_s = (float*)smem;
  float* sk_s = wq_s + 32 * 128;
  for (int item = blockIdx.x; item < 16 * 32; item += gridDim.x) {
    const int hj2 = item >> 5, k0 = (item & 31) * 32;
    const int h = hj2 >> 1, j = hj2 & 1;
    const float* skp = p.peer_sk + (size_t)(j * 8 + h) * 128 * 128;
    __syncthreads();
    for (int i = phase_tid(); i < 32 * 128; i += NTHREADS) {
      int k = i >> 7, d = i & 127;
      wq_s[i] = p.peer_wq[(size_t)(k0 + k) * 2048 + hj2 * 128 + d];
    }
    for (int i = phase_tid(); i < 128 * 128; i += NTHREADS) {
      int n = i >> 7, d = i & 127;
      sk_s[n * 129 + d] = skp[i];
    }
    __syncthreads();
    const int n = phase_tid() & 127, kq = phase_tid() >> 7;
    float acc[8];
#pragma unroll
    for (int i = 0; i < 8; ++i) acc[i] = 0.f;
    for (int d = 0; d < 128; ++d) {
      float s = sk_s[n * 129 + d];
#pragma unroll
      for (int i = 0; i < 8; ++i) acc[i] += wq_s[(kq * 8 + i) * 128 + d] * s;
    }
    u32x4 v;
    v[0] = pk_bf16(acc[0], acc[1]); v[1] = pk_bf16(acc[2], acc[3]);
    v[2] = pk_bf16(acc[4], acc[5]); v[3] = pk_bf16(acc[6], acc[7]);
    *(u32x4*)(p.WpT + (size_t)(hj2 * 128 + n) * 1024 + k0 + kq * 8) = v;
  }
}

__device__ void ln_in_phase(const Params& p) {
  const int lane = phase_tid() & 63, wid = phase_tid() >> 6;
  const int stride = gridDim.x * 8;
  auto src_of = [&](int row) -> const float* {
    return row < 8 * SEQ ? p.x_prompt + (size_t)row * DM : row < TX ? p.x_sample + (size_t)(row - 8 * SEQ) * DM : p.meta + (size_t)(row - TX) * DM;
  };
  int row = blockIdx.x * 8 + wid;
  f32x4 nx[4];
  if (row < TM) { const float* sp = src_of(row);
#pragma unroll
    for (int c = 0; c < 4; ++c) nx[c] = *(const f32x4*)(sp + c * 256 + lane * 4); }
  for (; row < TP; row += stride) {
    bf16_t* dst = p.h0 + (size_t)row * DM;
    if (row >= TM) {
      u32x4 zv = {0u, 0u, 0u, 0u};
      *(u32x4*)(dst + lane * 8) = zv; *(u32x4*)(dst + 512 + lane * 8) = zv;
      continue;
    }
    float v[16];
#pragma unroll
    for (int c = 0; c < 4; ++c)
#pragma unroll
      for (int j = 0; j < 4; ++j) v[c * 4 + j] = nx[c][j];
    if (row + stride < TM) { const float* sp = src_of(row + stride);
#pragma unroll
      for (int c = 0; c < 4; ++c) nx[c] = *(const f32x4*)(sp + c * 256 + lane * 4); }
    float s = 0.f;
#pragma unroll
    for (int j = 0; j < 16; ++j) s += v[j];
    const float mu = wave_sum(s) * (1.f / DM);
    float s2 = 0.f;
#pragma unroll
    for (int j = 0; j < 16; ++j) { float d = v[j] - mu; s2 += d * d; }
    const float rstd = rsqrtf(wave_sum(s2) * (1.f / DM) + EPS);
#pragma unroll
    for (int c = 0; c < 4; ++c) {
      const f32x4 g = *(const f32x4*)(p.ln_in_g + c * 256 + lane * 4), bb = *(const f32x4*)(p.ln_in_b + c * 256 + lane * 4);
      float o[4];
#pragma unroll
      for (int j = 0; j < 4; ++j) o[j] = (v[c * 4 + j] - mu) * rstd * g[j] + bb[j];
      *(u32x2*)(dst + c * 256 + lane * 4) = (u32x2){pk_bf16(o[0], o[1]), pk_bf16(o[2], o[3])};
    }
  }
}

__device__ __forceinline__ u32x4 pack8(const float (&v)[8]) {
  u32x4 w;
  w[0] = pk_bf16(v[0], v[1]); w[1] = pk_bf16(v[2], v[3]); w[2] = pk_bf16(v[4], v[5]); w[3] = pk_bf16(v[6], v[7]);
  return w;
}
__device__ __forceinline__ unsigned fkey(float f) {
  unsigned u = __float_as_uint(f);
  return u ^ (((unsigned)((int)u >> 31)) | 0x80000000u);
}
__device__ __forceinline__ float keyf(unsigned k) {
  unsigned u = (k & 0x80000000u) ? (k ^ 0x80000000u) : ~k;
  return __uint_as_float(u);
}
__device__ __forceinline__ void sort16_desc(unsigned (&v)[16]) {
  { unsigned _h = max(v[0], v[1]); v[1] = min(v[0], v[1]); v[0] = _h; }
  { unsigned _h = max(v[2], v[3]); v[2] = min(v[2], v[3]); v[3] = _h; }
  { unsigned _h = max(v[4], v[5]); v[5] = min(v[4], v[5]); v[4] = _h; }
  { unsigned _h = max(v[6], v[7]); v[6] = min(v[6], v[7]); v[7] = _h; }
  { unsigned _h = max(v[8], v[9]); v[9] = min(v[8], v[9]); v[8] = _h; }
  { unsigned _h = max(v[10], v[11]); v[10] = min(v[10], v[11]); v[11] = _h; }
  { unsigned _h = max(v[12], v[13]); v[13] = min(v[12], v[13]); v[12] = _h; }
  { unsigned _h = max(v[14], v[15]); v[14] = min(v[14], v[15]); v[15] = _h; }
  { unsigned _h = max(v[0], v[2]); v[2] = min(v[0], v[2]); v[0] = _h; }
  { unsigned _h = max(v[1], v[3]); v[3] = min(v[1], v[3]); v[1] = _h; }
  { unsigned _h = max(v[4], v[6]); v[4] = min(v[4], v[6]); v[6] = _h; }
  { unsigned _h = max(v[5], v[7]); v[5] = min(v[5], v[7]); v[7] = _h; }
  { unsigned _h = max(v[8], v[10]); v[10] = min(v[8], v[10]); v[8] = _h; }
  { unsigned _h = max(v[9], v[11]); v[11] = min(v[9], v[11]); v[9] = _h; }
  { unsigned _h = max(v[12], v[14]); v[12] = min(v[12], v[14]); v[14] = _h; }
  { unsigned _h = max(v[13], v[15]); v[13] = min(v[13], v[15]); v[15] = _h; }
  { unsigned _h = max(v[0], v[1]); v[1] = min(v[0], v[1]); v[0] = _h; }
  { unsigned _h = max(v[2], v[3]); v[3] = min(v[2], v[3]); v[2] = _h; }
  { unsigned _h = max(v[4], v[5]); v[4] = min(v[4], v[5]); v[5] = _h; }
  { unsigned _h = max(v[6], v[7]); v[6] = min(v[6], v[7]); v[7] = _h; }
  { unsigned _h = max(v[8], v[9]); v[9] = min(v[8], v[9]); v[8] = _h; }
  { unsigned _h = max(v[10], v[11]); v[11] = min(v[10], v[11]); v[10] = _h; }
  { unsigned _h = max(v[12], v[13]); v[12] = min(v[12], v[13]); v[13] = _h; }
  { unsigned _h = max(v[14], v[15]); v[14] = min(v[14], v[15]); v[15] = _h; }
  { unsigned _h = max(v[0], v[4]); v[4] = min(v[0], v[4]); v[0] = _h; }
  { unsigned _h = max(v[1], v[5]); v[5] = min(v[1], v[5]); v[1] = _h; }
  { unsigned _h = max(v[2], v[6]); v[6] = min(v[2], v[6]); v[2] = _h; }
  { unsigned _h = max(v[3], v[7]); v[7] = min(v[3], v[7]); v[3] = _h; }
  { unsigned _h = max(v[8], v[12]); v[8] = min(v[8], v[12]); v[12] = _h; }
  { unsigned _h = max(v[9], v[13]); v[9] = min(v[9], v[13]); v[13] = _h; }
  { unsigned _h = max(v[10], v[14]); v[10] = min(v[10], v[14]); v[14] = _h; }
  { unsigned _h = max(v[11], v[15]); v[11] = min(v[11], v[15]); v[15] = _h; }
  { unsigned _h = max(v[0], v[2]); v[2] = min(v[0], v[2]); v[0] = _h; }
  { unsigned _h = max(v[1], v[3]); v[3] = min(v[1], v[3]); v[1] = _h; }
  { unsigned _h = max(v[4], v[6]); v[6] = min(v[4], v[6]); v[4] = _h; }
  { unsigned _h = max(v[5], v[7]); v[7] = min(v[5], v[7]); v[5] = _h; }
  { unsigned _h = max(v[8], v[10]); v[8] = min(v[8], v[10]); v[10] = _h; }
  { unsigned _h = max(v[9], v[11]); v[9] = min(v[9], v[11]); v[11] = _h; }
  { unsigned _h = max(v[12], v[14]); v[12] = min(v[12], v[14]); v[14] = _h; }
  { unsigned _h = max(v[13], v[15]); v[13] = min(v[13], v[15]); v[15] = _h; }
  { unsigned _h = max(v[0], v[1]); v[1] = min(v[0], v[1]); v[0] = _h; }
  { unsigned _h = max(v[2], v[3]); v[3] = min(v[2], v[3]); v[2] = _h; }
  { unsigned _h = max(v[4], v[5]); v[5] = min(v[4], v[5]); v[4] = _h; }
  { unsigned _h = max(v[6], v[7]); v[7] = min(v[6], v[7]); v[6] = _h; }
  { unsigned _h = max(v[8], v[9]); v[8] = min(v[8], v[9]); v[9] = _h; }
  { unsigned _h = max(v[10], v[11]); v[10] = min(v[10], v[11]); v[11] = _h; }
  { unsigned _h = max(v[12], v[13]); v[12] = min(v[12], v[13]); v[13] = _h; }
  { unsigned _h = max(v[14], v[15]); v[14] = min(v[14], v[15]); v[15] = _h; }
  { unsigned _h = max(v[0], v[8]); v[8] = min(v[0], v[8]); v[0] = _h; }
  { unsigned _h = max(v[1], v[9]); v[9] = min(v[1], v[9]); v[1] = _h; }
  { unsigned _h = max(v[2], v[10]); v[10] = min(v[2], v[10]); v[2] = _h; }
  { unsigned _h = max(v[3], v[11]); v[11] = min(v[3], v[11]); v[3] = _h; }
  { unsigned _h = max(v[4], v[12]); v[12] = min(v[4], v[12]); v[4] = _h; }
  { unsigned _h = max(v[5], v[13]); v[13] = min(v[5], v[13]); v[5] = _h; }
  { unsigned _h = max(v[6], v[14]); v[14] = min(v[6], v[14]); v[6] = _h; }
  { unsigned _h = max(v[7], v[15]); v[15] = min(v[7], v[15]); v[7] = _h; }
  { unsigned _h = max(v[0], v[4]); v[4] = min(v[0], v[4]); v[0] = _h; }
  { unsigned _h = max(v[1], v[5]); v[5] = min(v[1], v[5]); v[1] = _h; }
  { unsigned _h = max(v[2], v[6]); v[6] = min(v[2], v[6]); v[2] = _h; }
  { unsigned _h = max(v[3], v[7]); v[7] = min(v[3], v[7]); v[3] = _h; }
  { unsigned _h = max(v[8], v[12]); v[12] = min(v[8], v[12]); v[8] = _h; }
  { unsigned _h = max(v[9], v[13]); v[13] = min(v[9], v[13]); v[9] = _h; }
  { unsigned _h = max(v[10], v[14]); v[14] = min(v[10], v[14]); v[10] = _h; }
  { unsigned _h = max(v[11], v[15]); v[15] = min(v[11], v[15]); v[11] = _h; }
  { unsigned _h = max(v[0], v[2]); v[2] = min(v[0], v[2]); v[0] = _h; }
  { unsigned _h = max(v[1], v[3]); v[3] = min(v[1], v[3]); v[1] = _h; }
  { unsigned _h = max(v[4], v[6]); v[6] = min(v[4], v[6]); v[4] = _h; }
  { unsigned _h = max(v[5], v[7]); v[7] = min(v[5], v[7]); v[5] = _h; }
  { unsigned _h = max(v[8], v[10]); v[10] = min(v[8], v[10]); v[8] = _h; }
  { unsigned _h = max(v[9], v[11]); v[11] = min(v[9], v[11]); v[9] = _h; }
  { unsigned _h = max(v[12], v[14]); v[14] = min(v[12], v[14]); v[12] = _h; }
  { unsigned _h = max(v[13], v[15]); v[15] = min(v[13], v[15]); v[13] = _h; }
  { unsigned _h = max(v[0], v[1]); v[1] = min(v[0], v[1]); v[0] = _h; }
  { unsigned _h = max(v[2], v[3]); v[3] = min(v[2], v[3]); v[2] = _h; }
  { unsigned _h = max(v[4], v[5]); v[5] = min(v[4], v[5]); v[4] = _h; }
  { unsigned _h = max(v[6], v[7]); v[7] = min(v[6], v[7]); v[6] = _h; }
  { unsigned _h = max(v[8], v[9]); v[9] = min(v[8], v[9]); v[8] = _h; }
  { unsigned _h = max(v[10], v[11]); v[11] = min(v[10], v[11]); v[10] = _h; }
  { unsigned _h = max(v[12], v[13]); v[13] = min(v[12], v[13]); v[12] = _h; }
  { unsigned _h = max(v[14], v[15]); v[15] = min(v[14], v[15]); v[14] = _h; }
}
__device__ __forceinline__ void merge16_desc(unsigned (&v)[16], const unsigned (&o)[16]) {
  v[0] = max(v[0], o[15]);
  v[1] = max(v[1], o[14]);
  v[2] = max(v[2], o[13]);
  v[3] = max(v[3], o[12]);
  v[4] = max(v[4], o[11]);
  v[5] = max(v[5], o[10]);
  v[6] = max(v[6], o[9]);
  v[7] = max(v[7], o[8]);
  v[8] = max(v[8], o[7]);
  v[9] = max(v[9], o[6]);
  v[10] = max(v[10], o[5]);
  v[11] = max(v[11], o[4]);
  v[12] = max(v[12], o[3]);
  v[13] = max(v[13], o[2]);
  v[14] = max(v[14], o[1]);
  v[15] = max(v[15], o[0]);
  { unsigned _h = max(v[0], v[8]); v[8] = min(v[0], v[8]); v[0] = _h; }
  { unsigned _h = max(v[1], v[9]); v[9] = min(v[1], v[9]); v[1] = _h; }
  { unsigned _h = max(v[2], v[10]); v[10] = min(v[2], v[10]); v[2] = _h; }
  { unsigned _h = max(v[3], v[11]); v[11] = min(v[3], v[11]); v[3] = _h; }
  { unsigned _h = max(v[4], v[12]); v[12] = min(v[4], v[12]); v[4] = _h; }
  { unsigned _h = max(v[5], v[13]); v[13] = min(v[5], v[13]); v[5] = _h; }
  { unsigned _h = max(v[6], v[14]); v[14] = min(v[6], v[14]); v[6] = _h; }
  { unsigned _h = max(v[7], v[15]); v[15] = min(v[7], v[15]); v[7] = _h; }
  { unsigned _h = max(v[0], v[4]); v[4] = min(v[0], v[4]); v[0] = _h; }
  { unsigned _h = max(v[1], v[5]); v[5] = min(v[1], v[5]); v[1] = _h; }
  { unsigned _h = max(v[2], v[6]); v[6] = min(v[2], v[6]); v[2] = _h; }
  { unsigned _h = max(v[3], v[7]); v[7] = min(v[3], v[7]); v[3] = _h; }
  { unsigned _h = max(v[8], v[12]); v[12] = min(v[8], v[12]); v[8] = _h; }
  { unsigned _h = max(v[9], v[13]); v[13] = min(v[9], v[13]); v[9] = _h; }
  { unsigned _h = max(v[10], v[14]); v[14] = min(v[10], v[14]); v[10] = _h; }
  { unsigned _h = max(v[11], v[15]); v[15] = min(v[11], v[15]); v[11] = _h; }
  { unsigned _h = max(v[0], v[2]); v[2] = min(v[0], v[2]); v[0] = _h; }
  { unsigned _h = max(v[1], v[3]); v[3] = min(v[1], v[3]); v[1] = _h; }
  { unsigned _h = max(v[4], v[6]); v[6] = min(v[4], v[6]); v[4] = _h; }
  { unsigned _h = max(v[5], v[7]); v[7] = min(v[5], v[7]); v[5] = _h; }
  { unsigned _h = max(v[8], v[10]); v[10] = min(v[8], v[10]); v[8] = _h; }
  { unsigned _h = max(v[9], v[11]); v[11] = min(v[9], v[11]); v[9] = _h; }
  { unsigned _h = max(v[12], v[14]); v[14] = min(v[12], v[14]); v[12] = _h; }
  { unsigned _h = max(v[13], v[15]); v[15] = min(v[13], v[15]); v[13] = _h; }
  { unsigned _h = max(v[0], v[1]); v[1] = min(v[0], v[1]); v[0] = _h; }
  { unsigned _h = max(v[2], v[3]); v[3] = min(v[2], v[3]); v[2] = _h; }
  { unsigned _h = max(v[4], v[5]); v[5] = min(v[4], v[5]); v[4] = _h; }
  { unsigned _h = max(v[6], v[7]); v[7] = min(v[6], v[7]); v[6] = _h; }
  { unsigned _h = max(v[8], v[9]); v[9] = min(v[8], v[9]); v[8] = _h; }
  { unsigned _h = max(v[10], v[11]); v[11] = min(v[10], v[11]); v[10] = _h; }
  { unsigned _h = max(v[12], v[13]); v[13] = min(v[12], v[13]); v[12] = _h; }
  { unsigned _h = max(v[14], v[15]); v[15] = min(v[14], v[15]); v[14] = _h; }
}
#define TOPK_INSERT_FROM(V, X, J0) { _Pragma("unroll") for (int _j = (J0); _j < 16; ++_j) { unsigned _hi = max(V[_j], X); X = min(V[_j], X); V[_j] = _hi; } }
#define TOPK_INSERT(V, X) { _Pragma("unroll") for (int _j = 0; _j < 16; ++_j) { unsigned _hi = max(V[_j], X); X = min(V[_j], X); V[_j] = _hi; } }

namespace pg8 {
constexpr int BM = 256, BK = 64, HALF = 128, HTB = HALF * BK * 2, STAGE_BYTES = 8 * HTB, NXCD = 8, WGM = 8;
__device__ __forceinline__ int lds_byte(int r, int c) { const int st = (r >> 4) * 2 + (c >> 5), rr = r & 15, cc = c & 31, ob = rr * 64 + cc * 2; return st * 1024 + (ob ^ (((ob >> 9) & 1) << 5)); }
__device__ __forceinline__ void stage_rc(int b, int& R, int& C) { const int st = b / 1024, sb = b % 1024, swz = sb ^ (((sb >> 9) & 1) << 5); R = (st >> 1) * 16 + swz / 64; C = (st & 1) * 32 + (swz % 64) / 2; }
__device__ __forceinline__ int perm32(int rho) { const int n = rho >> 4, i = rho & 15; return 8 * (i >> 2) + 4 * n + (i & 3); }
struct Unit { int pm, pn; };
struct Gemm { const bf16_t* A; const bf16_t* Bt; int M, N, K; };
struct StaticOrder {
  int nM, nN, nwg, G, c;
  __device__ void init(int M, int N, int G_, int c_) { nM = M / BM; nN = N / BM; nwg = nM * nN; G = G_; c = c_; }
  __device__ bool next(int i, Unit& u) const {
    const long L = (long)i * G + c; if (L >= nwg) return false;
    int wgid = (int)L; { const int q = nwg / NXCD, r = nwg % NXCD, xcd = wgid % NXCD, off = wgid / NXCD; wgid = (xcd < r ? xcd * (q + 1) : r * (q + 1) + (xcd - r) * q) + off; }
    const int nig = WGM * nN, gid = wgid / nig, fm = gid * WGM, gsz = (nM - fm) < WGM ? (nM - fm) : WGM;
    u.pm = fm + ((wgid % nig) % gsz); u.pn = (wgid % nig) / gsz; return true;
  }
  __device__ __forceinline__ void a_ready(const Unit&) const {}
  __device__ __forceinline__ void done(const Unit&) const {}
};
template <class Epi, class Sched>
__device__ __forceinline__ void gemm_phase(LAS unsigned char* lds, const Gemm g, const Sched& S, const Epi& E) {
  const int tid = phase_tid(), wid = __builtin_amdgcn_readfirstlane(tid >> 6), lane = tid & 63, wr = wid >> 2, wc = wid & 3, fr = lane & 15, fq = lane >> 4;
  const int K = g.K, nt = K / BK;
  unsigned voffA[2], voffB[2];
#pragma unroll
  for (int i = 0; i < 2; ++i) { int R, C; stage_rc(tid * 16 + i * 8192, R, C); const int Rb = Epi::PERM ? ((R & ~31) + perm32(R & 31)) : R;
    voffA[i] = (unsigned)(R * K + C) * 2u; voffB[i] = (unsigned)(Rb * K + C) * 2u; }
  const size_t kstep = (size_t)(BK * 2);
  const size_t hstep = (size_t)HALF * K * 2;
  const size_t tstep = 2 * hstep;
  const unsigned ldsw = (unsigned)wid * 1024u;
  const int aoff = lds_byte(wr * 64 + fr, fq * 8), boff = lds_byte(wc * 32 + fr, fq * 8);
#define PG8_SA(b, h) (((b) * 2 + (h)) * HTB)
#define PG8_SB(b, h) ((4 + (b) * 2 + (h)) * HTB)
#define PG8_STAGE(bufoff, gbase, voff) do { _Pragma("unroll") for (int _i = 0; _i < 2; ++_i) \
    __builtin_amdgcn_global_load_lds((const unsigned*)((const char*)(gbase) + (voff)[_i]), (LAS unsigned*)(lds + (bufoff) + ldsw + _i * 8192), 16, 0, 0); } while (0)
#define PG8_LDA(dst, b, h) do { _Pragma("unroll") for (int m = 0; m < 4; ++m) _Pragma("unroll") for (int k = 0; k < 2; ++k) dst[m][k] = *(const LAS bf16x8*)(lds + PG8_SA(b, h) + aoff + m * 2048 + k * 1024); } while (0)
#define PG8_LDB(dst, b, h) do { _Pragma("unroll") for (int n = 0; n < 2; ++n) _Pragma("unroll") for (int k = 0; k < 2; ++k) dst[n][k] = *(const LAS bf16x8*)(lds + PG8_SB(b, h) + boff + n * 2048 + k * 1024); } while (0)
#define PG8_MMA(ai, bj, At, Bt) do { __builtin_amdgcn_s_setprio(1); _Pragma("unroll") for (int m = 0; m < 4; ++m) _Pragma("unroll") for (int n = 0; n < 2; ++n) _Pragma("unroll") for (int k = 0; k < 2; ++k) \
    acc[ai][bj][m][n] = __builtin_amdgcn_mfma_f32_16x16x32_bf16(Bt[n][k], At[m][k], acc[ai][bj][m][n], 0, 0, 0); __builtin_amdgcn_s_setprio(0); } while (0)
#define PG8_WAIT_V(n) asm volatile("s_waitcnt vmcnt(" #n ")" ::: "memory")
#define PG8_WAIT_L(n) asm volatile("s_waitcnt lgkmcnt(" #n ")" ::: "memory")
#define PG8_BAR __builtin_amdgcn_s_barrier()
#define PG8_SCHED __builtin_amdgcn_sched_barrier(0)
  Unit cur, nxt; int ui = 0;
  if (!S.next(0, cur)) return;
  f32x4 acc[2][2][4][2];
#pragma unroll
  for (int a = 0; a < 2; ++a)
#pragma unroll
    for (int b = 0; b < 2; ++b)
#pragma unroll
      for (int m = 0; m < 4; ++m)
#pragma unroll
        for (int n = 0; n < 2; ++n) acc[a][b][m][n] = (f32x4){0.f, 0.f, 0.f, 0.f};
  bf16x8 At[4][2], B0[2][2], B1[2][2];
  const char* cA = (const char*)g.A + (size_t)cur.pm * tstep; const char* cB = (const char*)g.Bt + (size_t)cur.pn * tstep;
  S.a_ready(cur);
  PG8_STAGE(PG8_SB(0, 0), cB, voffB); PG8_STAGE(PG8_SA(0, 0), cA, voffA); PG8_STAGE(PG8_SB(0, 1), cB + hstep, voffB); PG8_STAGE(PG8_SA(0, 1), cA + hstep, voffA);
  if (wr == 1) PG8_BAR;
  PG8_WAIT_V(4); PG8_BAR;
  PG8_STAGE(PG8_SB(1, 0), cB + kstep, voffB); PG8_STAGE(PG8_SA(1, 0), cA + kstep, voffA); PG8_STAGE(PG8_SB(1, 1), cB + hstep + kstep, voffB);
  PG8_WAIT_V(6); PG8_BAR;
  for (;;) {
    const bool has_next = S.next(ui + 1, nxt);
    const char* nA = has_next ? (const char*)g.A + (size_t)nxt.pm * tstep : cA; const char* nB = has_next ? (const char*)g.Bt + (size_t)nxt.pn * tstep : cB;
    for (int t = 0; t < nt; t += 2) {
      const bool last = (t == nt - 2);
      const char* a1 = cA + (size_t)(t + 1) * kstep;
      const char* a2 = last ? nA : cA + (size_t)(t + 2) * kstep; const char* b2 = last ? nB : cB + (size_t)(t + 2) * kstep;
      const char* a3 = a2 + kstep; const char* b3 = b2 + kstep;
      if (last && has_next) S.a_ready(nxt);
      PG8_LDB(B0, 0, 0); PG8_SCHED; PG8_LDA(At, 0, 0); PG8_STAGE(PG8_SA(1, 1), a1 + hstep, voffA);
      PG8_WAIT_L(8); PG8_BAR; PG8_WAIT_L(0); PG8_MMA(0, 0, At, B0); PG8_BAR; PG8_SCHED;
      PG8_LDB(B1, 0, 1); PG8_STAGE(PG8_SB(0, 0), b2, voffB);
      PG8_BAR; PG8_WAIT_L(0); PG8_MMA(0, 1, At, B1); PG8_BAR;
      PG8_LDA(At, 0, 1); PG8_STAGE(PG8_SA(0, 0), a2, voffA);
      PG8_BAR; PG8_WAIT_L(0); PG8_MMA(1, 0, At, B0); PG8_BAR; PG8_SCHED;
      PG8_STAGE(PG8_SB(0, 1), b2 + hstep, voffB);
      PG8_WAIT_V(6); PG8_BAR; PG8_MMA(1, 1, At, B1); PG8_BAR;
      PG8_LDB(B0, 1, 0); PG8_SCHED; PG8_LDA(At, 1, 0); PG8_STAGE(PG8_SA(0, 1), a2 + hstep, voffA);
      PG8_WAIT_L(8); PG8_BAR; PG8_WAIT_L(0); PG8_MMA(0, 0, At, B0); PG8_BAR; PG8_SCHED;
      PG8_LDB(B1, 1, 1); PG8_STAGE(PG8_SB(1, 0), b3, voffB);
      PG8_BAR; PG8_WAIT_L(0); PG8_MMA(0, 1, At, B1); PG8_BAR;
      PG8_LDA(At, 1, 1); PG8_STAGE(PG8_SA(1, 0), a3, voffA);
      PG8_BAR; PG8_WAIT_L(0); PG8_MMA(1, 0, At, B0); PG8_BAR; PG8_SCHED;
      PG8_STAGE(PG8_SB(1, 1), b3 + hstep, voffB);
      PG8_WAIT_V(6); PG8_BAR; PG8_MMA(1, 1, At, B1); PG8_BAR;
    }
    if constexpr (!Epi::AFTER_DRAIN) { E(acc, cur, wr, wc, fr, fq); S.done(cur); }
    if (!has_next) break;
#pragma unroll
    for (int a = 0; a < 2; ++a)
#pragma unroll
      for (int b = 0; b < 2; ++b)
#pragma unroll
        for (int m = 0; m < 4; ++m)
#pragma unroll
          for (int n = 0; n < 2; ++n) acc[a][b][m][n] = (f32x4){0.f, 0.f, 0.f, 0.f};
    cur = nxt; cA = nA; cB = nB; ++ui;
  }
  PG8_WAIT_V(0);
  if (wr == 0) PG8_BAR;
  PG8_BAR;
  if constexpr (Epi::AFTER_DRAIN) { E.fused(acc, cur, wr, wc, fr, fq, (char*)lds); S.done(cur); }
#undef PG8_SA
#undef PG8_SB
#undef PG8_STAGE
#undef PG8_LDA
#undef PG8_LDB
#undef PG8_MMA
#undef PG8_WAIT_V
#undef PG8_WAIT_L
#undef PG8_BAR
#undef PG8_SCHED
}
struct EpiBf16S {
  static constexpr bool PERM = true, AFTER_DRAIN = false;
  bf16_t* d0; int ld0; int c0; bf16_t* d1; int ld1; int c1; bf16_t* d2; int ld2;
  __device__ __forceinline__ void operator()(const f32x4 (&acc)[2][2][4][2], const Unit& u, int wr, int wc, int fr, int fq) const {
    const int colt = u.pn * BM;
    bf16_t* base; int ld;
    if (colt < c0) { base = d0 + colt; ld = ld0; } else if (colt < c1) { base = d1 + (colt - c0); ld = ld1; } else { base = d2 + (colt - c1); ld = ld2; }
    const int L = fq * 16 + fr;
    const int srcl = ((L & 3) * 16 + (L >> 2)) * 4;
    const int row0 = u.pm * BM + wr * 64 + (L >> 2), col0 = wc * 32 + 8 * (L & 3);
#pragma unroll
    for (int ai = 0; ai < 2; ++ai)
#pragma unroll
      for (int m = 0; m < 4; ++m) {
        bf16_t* rowp = base + (size_t)(row0 + ai * HALF + m * 16) * ld + col0;
#pragma unroll
        for (int bj = 0; bj < 2; ++bj) {
          const f32x4 v0 = acc[ai][bj][m][0], v1 = acc[ai][bj][m][1];
          u32x4 w; w[0] = pk_bf16(v0[0], v0[1]); w[1] = pk_bf16(v0[2], v0[3]); w[2] = pk_bf16(v1[0], v1[1]); w[3] = pk_bf16(v1[2], v1[3]);
          u32x4 x;
#pragma unroll
          for (int k = 0; k < 4; ++k) x[k] = (unsigned)__builtin_amdgcn_ds_bpermute(srcl, (int)w[k]);
          *(u32x4*)(rowp + bj * HALF) = x;
        }
      }
  }
};
struct EpiOutRes {
  static constexpr bool PERM = true, AFTER_DRAIN = false;
  bf16_t* pre; const bf16_t* h0;
  __device__ __forceinline__ void operator()(const f32x4 (&acc)[2][2][4][2], const Unit& u, int wr, int wc, int fr, int fq) const {
    const int row0 = u.pm * BM + wr * 64 + fr, col0 = u.pn * BM + wc * 32 + 8 * fq;
#pragma unroll
    for (int ai = 0; ai < 2; ++ai)
#pragma unroll
      for (int m = 0; m < 4; ++m) {
        const size_t off = (size_t)(row0 + ai * HALF + m * 16) * 1024 + col0;
#pragma unroll
        for (int bj = 0; bj < 2; ++bj) {
          const size_t o = off + bj * HALF;
          const u32x4 h = *(const u32x4*)(h0 + o);
          const f32x4 v0 = acc[ai][bj][m][0], v1 = acc[ai][bj][m][1];
          u32x4 w;
          w[0] = pk_bf16(v0[0] + ALPHA * bflo(h[0]), v0[1] + ALPHA * bfhi(h[0]));
          w[1] = pk_bf16(v0[2] + ALPHA * bflo(h[1]), v0[3] + ALPHA * bfhi(h[1]));
          w[2] = pk_bf16(v1[0] + ALPHA * bflo(h[2]), v1[1] + ALPHA * bfhi(h[2]));
          w[3] = pk_bf16(v1[2] + ALPHA * bflo(h[3]), v1[3] + ALPHA * bfhi(h[3]));
          *(u32x4*)(pre + o) = w;
        }
      }
  }
};
struct OneUnit {
  Unit u;
  __device__ bool next(int i, Unit& o) const { if (i) return false; o = u; return true; }
  __device__ __forceinline__ void a_ready(const Unit&) const {}
  __device__ __forceinline__ void done(const Unit&) const {}
};
struct EpiPeerScore {
  static constexpr bool PERM = false, AFTER_DRAIN = true;
  unsigned short* experts; float* gates;
  static constexpr int LDC = 260;
  __device__ void fused(const f32x4 (&acc)[2][2][4][2], const Unit& u, int wr, int wc, int fr, int fq, char* smem) const {
    float* Ct = (float*)smem;
    unsigned char* ibase = (unsigned char*)smem + 128 * LDC * 4;
    const int tid = phase_tid();
    const int row = tid >> 2, j = (tid >> 1) & 1, half = tid & 1;
#pragma unroll
    for (int ai = 0; ai < 2; ++ai) {
#pragma unroll
      for (int bj = 0; bj < 2; ++bj)
#pragma unroll
        for (int m = 0; m < 4; ++m)
#pragma unroll
          for (int n = 0; n < 2; ++n)
            *(f32x4*)(Ct + (wr * 64 + m * 16 + fr) * LDC + bj * 128 + wc * 32 + n * 16 + 4 * fq) = acc[ai][bj][m][n];
      lds_barrier();
      unsigned v[16];
      const float* rowp = Ct + row * LDC + j * 128 + half * 64;
#pragma unroll
      for (int grp = 0; grp < 4; ++grp) {
        unsigned o[16];
#pragma unroll
        for (int c4 = 0; c4 < 4; ++c4) {
          f32x4 sv = *(const f32x4*)(rowp + grp * 16 + c4 * 4);
#pragma unroll
          for (int k = 0; k < 4; ++k) o[c4 * 4 + k] = (fkey(sv[k]) & ~127u) | (unsigned)(127 - (half * 64 + grp * 16 + c4 * 4 + k));
        }
        sort16_desc(o);
        if (grp == 0) {
#pragma unroll
          for (int k = 0; k < 16; ++k) v[k] = o[k];
        } else merge16_desc(v, o);
      }
      {
        unsigned o[16];
#pragma unroll
        for (int k = 0; k < 16; ++k) o[k] = __shfl_xor(v[k], 1);
        merge16_desc(v, o);
      }
      unsigned w[16];
#pragma unroll
      for (int k = 0; k < 16; ++k) w[k] = __shfl_xor(v[k], 2);
      unsigned v0[16], v1[16];
#pragma unroll
      for (int k = 0; k < 16; ++k) { unsigned a0 = v[k], b0 = w[k]; asm volatile("" : "+v"(a0), "+v"(b0)); v0[k] = j ? b0 : a0; v1[k] = j ? a0 : b0; }
      unsigned char* ib = ibase + row * 32;
      if ((tid & 3) == 0) {
#pragma unroll
        for (int q4 = 0; q4 < 4; ++q4) {
          unsigned x0 = 0u, x1 = 0u;
#pragma unroll
          for (int k = 0; k < 4; ++k) { x0 |= (127u - (v0[q4 * 4 + k] & 127u)) << (8 * k); x1 |= (127u - (v1[q4 * 4 + k] & 127u)) << (8 * k); }
          ((unsigned*)ib)[q4] = x0; ((unsigned*)ib)[4 + q4] = x1;
        }
      }
      float f1[16], f2[16];
#pragma unroll
      for (int k = 0; k < 16; ++k) { f1[k] = keyf(v0[k] & ~127u); f2[k] = keyf(v1[k] & ~127u); }
      unsigned c[16];
#pragma unroll
      for (int k = 0; k < 16; ++k) c[k] = 0u;
#pragma unroll
      for (int a = 0; a < 16; ++a)
#pragma unroll
        for (int b = 0; b < 16; ++b)
          if ((a + 1) * (b + 1) <= 16) {
            unsigned x = (fkey(f1[a] + f2[b]) & ~255u) | (unsigned)(255 - (a * 16 + b));
            TOPK_INSERT_FROM(c, x, (a + 1) * (b + 1) - 1);
          }
      float e[16];
      const float mx = keyf(c[0] & ~255u);
      float sum = 0.f;
#pragma unroll
      for (int k = 0; k < 16; ++k) { e[k] = __expf(keyf(c[k] & ~255u) - mx); sum += e[k]; }
      const float inv = 1.f / sum;
      asm volatile("s_waitcnt lgkmcnt(0)" ::: "memory");
      const int qd = tid & 3;
      const size_t idx = ((size_t)(u.pm * BM + ai * HALF + row) * 8 + u.pn) * 16 + qd * 4;
      unsigned ew[2]; float gt[4];
#pragma unroll
      for (int k = 0; k < 4; ++k) {
        unsigned k0 = c[k], k1 = c[4 + k], k2 = c[8 + k], k3 = c[12 + k]; float e0 = e[k], e1 = e[4 + k], e2 = e[8 + k], e3 = e[12 + k];
        asm volatile("" : "+v"(k0), "+v"(k1), "+v"(k2), "+v"(k3), "+v"(e0), "+v"(e1), "+v"(e2), "+v"(e3));
        const unsigned key = qd == 0 ? k0 : qd == 1 ? k1 : qd == 2 ? k2 : k3;
        const float ev = qd == 0 ? e0 : qd == 1 ? e1 : qd == 2 ? e2 : e3;
        const unsigned ab = 255u - (key & 255u);
        const unsigned ex = (unsigned)ib[ab >> 4] * 128u + (unsigned)ib[16 + (ab & 15)];
        if (k & 1) ew[k >> 1] |= ex << 16; else ew[k >> 1] = ex;
        gt[k] = ev * inv;
      }
      *(u32x2*)(experts + idx) = (u32x2){ew[0], ew[1]};
      *(f32x4*)(gates + idx) = (f32x4){gt[0], gt[1], gt[2], gt[3]};
      lds_barrier();
    }
  }
};
template <class Epi>
__device__ __forceinline__ void run_drained(char* smem, const bf16_t* A, const bf16_t* Bt, int M, int N, int K, const Epi& E) {
  StaticOrder S; S.init(M, N, gridDim.x, blockIdx.x);
  for (int i = 0;; ++i) {
    Unit u; if (!S.next(i, u)) break;
    gemm_phase((LAS unsigned char*)smem, Gemm{A, Bt, M, N, K}, OneUnit{u}, E);
  }
}
template <class Epi>
__device__ __forceinline__ void run(char* smem, const bf16_t* A, const bf16_t* Bt, int M, int N, int K, const Epi& E) {
  StaticOrder S; S.init(M, N, gridDim.x, blockIdx.x);
  gemm_phase((LAS unsigned char*)smem, Gemm{A, Bt, M, N, K}, S, E);
}
}

__device__ void conv_phase(const Params& p, char* smem) {
  bf16_t* raw = (bf16_t*)smem;
  const int tid = phase_tid();
  u32x4 rr_[3];
  auto gload = [&](int item) {
    const int cb = item % 24, c = (item / 24) % NCH, seq = item / (24 * NCH);
#pragma unroll
    for (int j = 0; j < 3; ++j) {
      const int i = tid + j * NTHREADS;
      const int rr = i >> 3, k8 = i & 7;
      const int pos = c * 128 - 2 + rr - MPAD;
      u32x4 v = {0u, 0u, 0u, 0u};
      if (i < 132 * 8 && pos >= 0 && pos < LSEQ) v = *(const u32x4*)(p.xbc_raw + (size_t)row_of(seq, pos) * 1536 + cb * 64 + k8 * 8);
      rr_[j] = v;
    }
  };
  if ((int)blockIdx.x < NSEQ * NCH * 24) gload(blockIdx.x);
  for (int item = blockIdx.x; item < NSEQ * NCH * 24; item += gridDim.x) {
    const int cb = item % 24, c = (item / 24) % NCH, seq = item / (24 * NCH);
    __syncthreads();
#pragma unroll
    for (int j = 0; j < 3; ++j) {
      const int i = tid + j * NTHREADS;
      if (i < 132 * 8) *(u32x4*)(raw + (i >> 3) * 64 + (i & 7) * 8) = rr_[j];
    }
    __syncthreads();
    if (item + (int)gridDim.x < NSEQ * NCH * 24) gload(item + gridDim.x);
    const int ch = tid & 63, l0 = (tid >> 6) * 16;
    const int gch = cb * 64 + ch;
    float w[5];
#pragma unroll
    for (int k = 0; k < 5; ++k) w[k] = p.conv_w[k * 1536 + gch];
    const float bias = p.conv_b[gch];
    float win[20];
#pragma unroll
    for (int i = 0; i < 20; ++i) win[i] = bf2f(raw[(l0 + i) * 64 + ch]);
    float o[16];
#pragma unroll
    for (int i = 0; i < 16; ++i) {
      float a = bias;
#pragma unroll
      for (int k = 0; k < 5; ++k) a += w[k] * win[i + k];
      int pos = c * 128 + l0 + i - MPAD;
      o[i] = (pos >= 0 && pos < LSEQ) ? silu_f(a) : 0.f;
    }
    u32x4 lo, hi;
    lo[0] = pk_bf16(o[0], o[1]); lo[1] = pk_bf16(o[2], o[3]); lo[2] = pk_bf16(o[4], o[5]); lo[3] = pk_bf16(o[6], o[7]);
    hi[0] = pk_bf16(o[8], o[9]); hi[1] = pk_bf16(o[10], o[11]); hi[2] = pk_bf16(o[12], o[13]); hi[3] = pk_bf16(o[14], o[15]);
    if (cb < 16) {
      bf16_t* d = p.XT + ((((size_t)seq * NCH + c) * 16 + cb) * 64 + ch) * 128 + l0;
      *(u32x4*)d = lo; *(u32x4*)(d + 8) = hi;
    } else if (cb < 20) {
      const int g = (cb - 16) >> 1, n = ((cb - 16) & 1) * 64 + ch;
      bf16_t* d = p.BmT + ((((size_t)seq * NCH + c) * 2 + g) * 128 + n) * 128 + l0;
      *(u32x4*)d = lo; *(u32x4*)(d + 8) = hi;
      bf16_t* d2 = p.Bm + ((size_t)seq * LP + c * 128 + l0) * 256 + g * 128 + n;
#pragma unroll
      for (int i = 0; i < 16; ++i) d2[(size_t)i * 256] = f2bf(o[i]);
    } else {
      const int g = (cb - 20) >> 1, n = ((cb - 20) & 1) * 64 + ch;
      bf16_t* d2 = p.Cm + ((size_t)seq * LP + c * 128 + l0) * 256 + g * 128 + n;
#pragma unroll
      for (int i = 0; i < 16; ++i) d2[(size_t)i * 256] = f2bf(o[i]);
    }
  }
}

__device__ void token_phase(const Params& p) {
  const int lane = phase_tid() & 63, wid = phase_tid() >> 6;
  for (int row = blockIdx.x * 8 + wid; row < TP; row += gridDim.x * 8) {
    if (row >= TM) {
      unsigned* dq = (unsigned*)(p.cqn + (size_t)row * 384) + lane * 3;
      dq[0] = 0u; dq[1] = 0u; dq[2] = 0u;
      *(u32x2*)(p.ckvn + (size_t)row * 256 + lane * 4) = (u32x2){0u, 0u};
      continue;
    }
    const bf16_t* src = p.rest + (size_t)row * 768;
    {
      const unsigned* s = (const unsigned*)(src + 32) + lane * 3;
      unsigned a0 = s[0], a1 = s[1], a2 = s[2];
      float v[6] = {bflo(a0), bfhi(a0), bflo(a1), bfhi(a1), bflo(a2), bfhi(a2)};
      float ss = 0.f;
#pragma unroll
      for (int j = 0; j < 6; ++j) ss += v[j] * v[j];
      const float r = rsqrtf(wave_sum(ss) * (1.f / 384.f) + EPS);
      const float* g = p.q_norm_g + lane * 6;
      unsigned* d = (unsigned*)(p.cqn + (size_t)row * 384) + lane * 3;
      d[0] = pk_bf16(v[0] * r * g[0], v[1] * r * g[1]);
      d[1] = pk_bf16(v[2] * r * g[2], v[3] * r * g[3]);
      d[2] = pk_bf16(v[4] * r * g[4], v[5] * r * g[5]);
    }
    {
      u32x2 a = *(const u32x2*)(src + 416 + lane * 4);
      float v[4] = {bflo(a[0]), bfhi(a[0]), bflo(a[1]), bfhi(a[1])};
      float ss = v[0] * v[0] + v[1] * v[1] + v[2] * v[2] + v[3] * v[3];
      const float r = rsqrtf(wave_sum(ss) * (1.f / 256.f) + EPS);
      const float* g = p.kv_norm_g + lane * 4;
      u32x2 w;
      w[0] = pk_bf16(v[0] * r * g[0], v[1] * r * g[1]); w[1] = pk_bf16(v[2] * r * g[2], v[3] * r * g[3]);
      *(u32x2*)(p.ckvn + (size_t)row * 256 + lane * 4) = w;
    }
    if (lane < 16) {
      const float pos = (float)(row < TX ? NMETA + (row & (SEQ - 1)) : row - TX);
      const float inv = exp2f(-(float)lane * (13.287712379549449f / 16.f));
      const float ang = pos * inv;
      float sn, cs; fast_sincos(ang, sn, cs);
      const float x1 = bf2f(src[672 + lane]), x2 = bf2f(src[688 + lane]);
      p.kr[(size_t)row * 32 + lane] = f2bf(x1 * cs - x2 * sn);
      p.kr[(size_t)row * 32 + 16 + lane] = f2bf(x1 * sn + x2 * cs);
    }
  }
}

__device__ void dt_phase(const Params& p) {
  const int lane = phase_tid() & 63, wid = phase_tid() >> 6;
  for (int item = blockIdx.x * 8 + wid; item < NSEQ * 2 * NCH; item += gridDim.x * 8) {
    const int c = item % NCH, dir = (item / NCH) & 1, seq = item / (NCH * 2);
    u32x4 raw[2][2];
#pragma unroll
    for (int j = 0; j < 2; ++j) {
      const int pos = c * 128 + lane * 2 + j - MPAD;
      raw[j][0] = (u32x4){0u, 0u, 0u, 0u}; raw[j][1] = raw[j][0];
      if (pos >= 0) {
        const bf16_t* src = p.rest + (size_t)row_of(seq, pos) * 768 + dir * 16;
        raw[j][0] = *(const u32x4*)src; raw[j][1] = *(const u32x4*)(src + 8);
      }
    }
    const float* biasp = dir ? p.dt_bias_b : p.dt_bias_f;
    const float* alogp = dir ? p.a_log_b : p.a_log_f;
#pragma unroll
    for (int h = 0; h < 16; ++h) {
      const float bias = biasp[h];
      const float a = -__expf(alogp[h]);
      float dt[2], da[2];
#pragma unroll
      for (int j = 0; j < 2; ++j) {
        const int pos = c * 128 + lane * 2 + j - MPAD;
        const unsigned w = raw[j][h >> 3][(h >> 1) & 3];
        const float x = ((h & 1) ? bfhi(w) : bflo(w)) + bias;
        const float v = pos >= 0 ? (x > 20.f ? x : log1pf(__expf(x))) : 0.f;
        dt[j] = v; da[j] = v * a;
      }
      const float s2 = da[0] + da[1];
      float incl = s2;
#pragma unroll
      for (int o = 1; o < 64; o <<= 1) { float t = __shfl_up(incl, o); if (lane >= o) incl += t; }
      const float excl = incl - s2;
      const float tot = __shfl(incl, 63);
      const size_t base = ((size_t)(seq * 2 + dir) * 16 + h) * LP + c * 128 + lane * 2;
      float P0, P1;
      if (dir == 0) { P0 = excl + da[0]; P1 = incl; } else { P0 = -excl; P1 = -(excl + da[0]); }
      *(float2*)(p.dtv + base) = make_float2(dt[0], dt[1]);
      *(float2*)(p.Pv + base) = make_float2(P0, P1);
      if (lane == 0) p.Atot[((size_t)(seq * 2 + dir) * 16 + h) * NCH + c] = tot;
    }
  }
}

__device__ __forceinline__ void xcd_group_map(int b, int& gg, int& j) { const int r = b & 7, k = b >> 3; j = k & 7; gg = (k >> 3) * 8 + r; }
constexpr int KS_STRIDE = 208, VS_STRIDE = 136;
constexpr int ATT_STAGE = 64 * KS_STRIDE + 64 * VS_STRIDE;
static_assert(2 * ATT_STAGE <= 160 * 1024 - 64, "attn lds");
__device__ void attn_phase(const Params& p, char* smem) {
  const int tid = phase_tid(), lane = tid & 63, wid = tid >> 6;
  const int r32 = lane & 31, hh = lane >> 5;
  for (int item0 = blockIdx.x; item0 < NSEQ * 8 * 8; item0 += gridDim.x) {
    int item = item0;
    if (gridDim.x == 256) { int gg, j; xcd_group_map(blockIdx.x, gg, j); item = ((item0 >> 8) * 32 + gg) * 8 + j; }
    const int qb = item & 7, h = (item >> 3) & 7, seq = item >> 6;
    const float qscale = 0.10206207261596575f * 1.4426950408889634f;
    bf16x8 qf[6];
    {
      const int qi = qb * 256 + wid * 32 + r32;
      const bf16_t* qp = p.q + ((size_t)seq * SEQ + qi) * 768 + h * 96 + hh * 8;
      const float pos = (float)(NMETA + qi);
      u32x4 v[6];
#pragma unroll
      for (int i = 0; i < 6; ++i) v[i] = *(const u32x4*)(qp + i * 16);
#pragma unroll
      for (int i = 0; i < 4; ++i) {
        u32x4 w;
#pragma unroll
        for (int j = 0; j < 4; ++j) w[j] = pk_bf16(bflo(v[i][j]) * qscale, bfhi(v[i][j]) * qscale);
        qf[i] = as_bf16x8(w);
      }
      u32x4 w1, w2;
#pragma unroll
      for (int j = 0; j < 4; ++j) {
        float o1[2], o2[2];
#pragma unroll
        for (int e = 0; e < 2; ++e) {
          const int k = 8 * hh + 2 * j + e;
          const float x1 = e ? bfhi(v[4][j]) : bflo(v[4][j]), x2 = e ? bfhi(v[5][j]) : bflo(v[5][j]);
          const float inv = exp2f(-(float)k * (13.287712379549449f / 16.f));
          float sn, cs; fast_sincos(pos * inv, sn, cs);
          o1[e] = (x1 * cs - x2 * sn) * qscale; o2[e] = (x1 * sn + x2 * cs) * qscale;
        }
        w1[j] = pk_bf16(o1[0], o1[1]); w2[j] = pk_bf16(o2[0], o2[1]);
      }
      qf[4] = as_bf16x8(w1); qf[5] = as_bf16x8(w2);
    }
    f32x16 oacc[2], negm;
#pragma unroll
    for (int i = 0; i < 16; ++i) { oacc[0][i] = 0.f; oacc[1][i] = 0.f; negm[i] = 0.f; }
    float l_run = 0.f;

    u32x4 rk, rkr, rv;
    const bf16_t* vTb = p.vT + (size_t)(h * 64) * TP;
    auto gload = [&](int kt) {
      const u32x4 zero = {0u, 0u, 0u, 0u};
      if (kt < 32) {
        { int key = tid >> 3, ch = tid & 7;
          rk = *(const u32x4*)(p.Kb + ((size_t)seq * SEQ + kt * 64 + key) * 512 + h * 64 + ch * 8); }
        if (tid < 256) { int key = tid >> 2, ch = tid & 3;
          rkr = *(const u32x4*)(p.kr + ((size_t)seq * SEQ + kt * 64 + key) * 32 + ch * 8); }
        { int dv = tid >> 3, ch = tid & 7;
          rv = *(const u32x4*)(vTb + (size_t)dv * TP + seq * SEQ + kt * 64 + ch * 8); }
      } else {
        { int key = tid >> 3, ch = tid & 7;
          rk = key < 16 ? *(const u32x4*)(p.Kb + (size_t)(TX + key) * 512 + h * 64 + ch * 8) : zero; }
        if (tid < 256) { int key = tid >> 2, ch = tid & 3;
          rkr = key < 16 ? *(const u32x4*)(p.kr + (size_t)(TX + key) * 32 + ch * 8) : zero; }
        { int dv = tid >> 3, ch = tid & 7;
          rv = ch < 2 ? *(const u32x4*)(vTb + (size_t)dv * TP + TX + ch * 8) : zero; }
      }
    };
    auto sstore = [&](int st) {
      char* ks = smem + st * ATT_STAGE; char* vs = ks + 64 * KS_STRIDE;
      { int key = tid >> 3, ch = tid & 7; *(u32x4*)(ks + key * KS_STRIDE + ch * 16) = rk; }
      if (tid < 256) { int key = tid >> 2, ch = tid & 3; *(u32x4*)(ks + key * KS_STRIDE + 128 + ch * 16) = rkr; }
      { int dv = tid >> 3, ch = tid & 7; char* d = vs + dv * VS_STRIDE + ch * 16;
        *(u32x2*)d = (u32x2){rv[0], rv[1]}; *(u32x2*)(d + 8) = (u32x2){rv[2], rv[3]}; }
    };
    lds_barrier();
    gload(0); sstore(0);
    lds_barrier();
    for (int kt = 0; kt < 33; ++kt) {
      const int cur = kt & 1;
      if (kt + 1 < 33) gload(kt + 1);
      const char* ks_ = smem + cur * ATT_STAGE; const char* vs_ = ks_ + 64 * KS_STRIDE;
      f32x16 sacc[2];
      bf16x8 kfr[6][2];
#pragma unroll
      for (int ks = 0; ks < 6; ++ks)
#pragma unroll
        for (int t2 = 0; t2 < 2; ++t2) kfr[ks][t2] = *(const bf16x8*)(ks_ + (t2 * 32 + r32) * KS_STRIDE + ks * 32 + hh * 16);
      __builtin_amdgcn_sched_barrier(0);
#pragma unroll
      for (int ks = 0; ks < 6; ++ks)
#pragma unroll
        for (int t2 = 0; t2 < 2; ++t2)
          sacc[t2] = __builtin_amdgcn_mfma_f32_32x32x16_bf16(kfr[ks][t2], qf[ks], ks == 0 ? negm : sacc[t2], 0, 0, 0);
      __builtin_amdgcn_sched_barrier(0);
      u32x2 vfa[2][2][2], vfb[2][2][2];
#pragma unroll
      for (int t2 = 0; t2 < 2; ++t2)
#pragma unroll
        for (int s2 = 0; s2 < 2; ++s2)
#pragma unroll
          for (int dvt = 0; dvt < 2; ++dvt) {
            const char* vp = vs_ + (dvt * 32 + r32) * VS_STRIDE + (t2 * 32 + s2 * 16 + 4 * hh) * 2;
            vfa[t2][s2][dvt] = *(const u32x2*)vp; vfb[t2][s2][dvt] = *(const u32x2*)(vp + 16);
          }
      __builtin_amdgcn_sched_barrier(0);
      if (kt == 32) {
#pragma unroll
        for (int t2 = 0; t2 < 2; ++t2)
#pragma unroll
          for (int i = 0; i < 16; ++i) {
            int kk = t2 * 32 + (i & 3) + 8 * (i >> 2) + 4 * hh;
            if (kk >= 16) sacc[t2][i] = -1e30f;
          }
      }
      {
        float mx = sacc[0][0];
#pragma unroll
        for (int t2 = 0; t2 < 2; ++t2)
#pragma unroll
          for (int i = 0; i < 16; ++i) mx = fmaxf(mx, sacc[t2][i]);
        mx = fmaxf(mx, __shfl_xor(mx, 32));
        if (kt == 0 || __any(mx > 8.f)) {
          const float d = kt == 0 ? mx : fmaxf(mx, 0.f);
          const float alpha = kt == 0 ? 1.f : __builtin_amdgcn_exp2f(-d);
#pragma unroll
          for (int i = 0; i < 16; ++i) {
            sacc[0][i] -= d; sacc[1][i] -= d; negm[i] -= d;
            oacc[0][i] *= alpha; oacc[1][i] *= alpha;
          }
          l_run *= alpha;
        }
        float ps = 0.f;
#pragma unroll
        for (int t2 = 0; t2 < 2; ++t2)
#pragma unroll
          for (int i = 0; i < 16; ++i) { float e = __builtin_amdgcn_exp2f(sacc[t2][i]); sacc[t2][i] = e; ps += e; }
        l_run += ps;
      }
#pragma unroll
      for (int t2 = 0; t2 < 2; ++t2)
#pragma unroll
        for (int s2 = 0; s2 < 2; ++s2) {
          u32x4 pw;
#pragma unroll
          for (int j = 0; j < 4; ++j) pw[j] = pk_bf16(sacc[t2][s2 * 8 + 2 * j], sacc[t2][s2 * 8 + 2 * j + 1]);
          const bf16x8 pf = as_bf16x8(pw);
#pragma unroll
          for (int dvt = 0; dvt < 2; ++dvt) {
            const u32x2 a2 = vfa[t2][s2][dvt], b2 = vfb[t2][s2][dvt];
            bf16x8 vf = as_bf16x8((u32x4){a2[0], a2[1], b2[0], b2[1]});
            oacc[dvt] = __builtin_amdgcn_mfma_f32_32x32x16_bf16(vf, pf, oacc[dvt], 0, 0, 0);
          }
        }
      if (kt + 1 < 33) sstore(cur ^ 1);
      lds_barrier();
    }
    {
      const float l_tot = l_run + __shfl_xor(l_run, 32);
      const float inv = __builtin_amdgcn_rcpf(l_tot);
      const int qi = qb * 256 + wid * 32 + r32;
      bf16_t* op = p.o + ((size_t)seq * SEQ + qi) * 512 + h * 64;
#pragma unroll
      for (int dvt = 0; dvt < 2; ++dvt)
#pragma unroll
        for (int g4 = 0; g4 < 4; ++g4) {
          u32x2 w;
          w[0] = pk_bf16(oacc[dvt][g4 * 4 + 0] * inv, oacc[dvt][g4 * 4 + 1] * inv);
          w[1] = pk_bf16(oacc[dvt][g4 * 4 + 2] * inv, oacc[dvt][g4 * 4 + 3] * inv);
          *(u32x2*)(op + dvt * 32 + g4 * 8 + hh * 4) = w;
        }
    }
  }
  lds_barrier();
}

constexpr int SS_ROW = 272;
constexpr int SS_XT = 264;

constexpr int DG_CC = 0, DG_BC = 128 * SS_ROW, DG_XT = 2 * 128 * SS_ROW, DG_AR = DG_XT + 2 * 64 * SS_XT, DG_BW = DG_AR + 2 * 2048, DG_LDS = DG_BW + 8 * 512;
static_assert(DG_LDS <= 150 * 1024, "diag lds");
__device__ void ssd_diag_phase(const Params& p, char* smem) {
  const int tid = phase_tid(), lane = tid & 63, wid = tid >> 6;
  const int r32 = lane & 31, hh = lane >> 5;
  const int pt = wid & 1, lt = wid >> 1;
  const int l = lt * 32 + r32;
  for (int item = blockIdx.x; item < NSEQ * 16 * 2; item += gridDim.x) {
    const int g = item & 1, c = 1 + ((item >> 1) & 15), seq = item >> 5;
    u32x4 rx[2]; float ra = 0.f;
    auto gload_head = [&](int h) {
      const bf16_t* xt = p.XT + (((size_t)seq * NCH + c) * 16 + h) * 64 * 128;
#pragma unroll
      for (int i = 0; i < 2; ++i) { int id = tid + i * 512; int r = id >> 4, k = id & 15;
        rx[i] = *(const u32x4*)(xt + (size_t)r * 128 + k * 8); }
      const int arr = tid >> 7, idx = tid & 127, dir = arr & 1;
      const float* src = (arr < 2 ? p.Pv : p.dtv) + ((size_t)(seq * 2 + dir) * 16 + h) * LP + c * 128 + idx;
      ra = *src;
    };
    auto sstore_head = [&](int buf) {
#pragma unroll
      for (int i = 0; i < 2; ++i) { int id = tid + i * 512; int r = id >> 4, k = id & 15;
        char* d = smem + DG_XT + buf * 64 * SS_XT + r * SS_XT + k * 16;
        *(u32x2*)d = (u32x2){rx[i][0], rx[i][1]}; *(u32x2*)(d + 8) = (u32x2){rx[i][2], rx[i][3]}; }
      ((float*)(smem + DG_AR + buf * 2048))[tid] = ra;
    };
    lds_barrier();
    {
      const bf16_t* cm = p.Cm + ((size_t)seq * LP + c * 128) * 256 + g * 128;
      const bf16_t* bm = p.Bm + ((size_t)seq * LP + c * 128) * 256 + g * 128;
      u32x4 rc[4], rb[4];
#pragma unroll
      for (int i = 0; i < 4; ++i) { int id = tid + i * 512; int r = id >> 4, k = id & 15;
        rc[i] = *(const u32x4*)(cm + (size_t)r * 256 + k * 8); rb[i] = *(const u32x4*)(bm + (size_t)r * 256 + k * 8); }
      gload_head(g * 8);
#pragma unroll
      for (int i = 0; i < 4; ++i) { int id = tid + i * 512; int r = id >> 4, k = id & 15;
        *(u32x4*)(smem + DG_CC + r * SS_ROW + k * 16) = rc[i]; *(u32x4*)(smem + DG_BC + r * SS_ROW + k * 16) = rb[i]; }
      sstore_head(0);
    }
    lds_barrier();
    f32x16 xacc[4];
#pragma unroll
    for (int st = 0; st < 4; ++st) {
#pragma unroll
      for (int i = 0; i < 16; ++i) xacc[st][i] = 0.f;
#pragma unroll
      for (int ks = 0; ks < 8; ++ks) {
        bf16x8 bfg = *(const bf16x8*)(smem + DG_BC + (st * 32 + r32) * SS_ROW + ks * 32 + hh * 16);
        bf16x8 cfk = *(const bf16x8*)(smem + DG_CC + l * SS_ROW + ks * 32 + hh * 16);
        xacc[st] = __builtin_amdgcn_mfma_f32_32x32x16_bf16(bfg, cfk, xacc[st], 0, 0, 0);
      }
    }
    for (int h8 = 0; h8 < 8; ++h8) {
      const int h = g * 8 + h8, buf = h8 & 1;
      if (h8 + 1 < 8) gload_head(h + 1);
      const char* xtb = smem + DG_XT + buf * 64 * SS_XT;
      const float* Pf = (const float*)(smem + DG_AR + buf * 2048);
      const float* Pb = Pf + 128; const float* Df = Pf + 256; const float* Db = Pf + 384;
      const float Pfl = Pf[l], Pbl = Pb[l];
      float* bw = (float*)(smem + DG_BW + wid * 512);
      const float PrefF = Pf[lt * 32], PrefB = Pb[lt * 32 + 31];
      const float af = __expf(Pfl - PrefF), ab = __expf(Pbl - PrefB);
#pragma unroll
      for (int r = 0; r < 2; ++r) {
        const int sx = lane + 64 * r;
        float bv = 0.f;
        if (sx < lt * 32) bv = Df[sx] * __expf(PrefF - Pf[sx]);
        else if (sx >= (lt + 1) * 32) bv = Db[sx] * __expf(PrefB - Pb[sx]);
        bw[sx] = bv;
      }
      asm volatile("s_waitcnt lgkmcnt(0)" ::: "memory");
      f32x16 yacc;
#pragma unroll
      for (int i = 0; i < 16; ++i) yacc[i] = 0.f;
#pragma unroll
      for (int st = 0; st < 4; ++st) {
        float m[16];
        if (st != lt) {
          const float a = st < lt ? af : ab;
#pragma unroll
          for (int i = 0; i < 16; ++i) { const int sx = st * 32 + (i & 3) + 8 * (i >> 2) + 4 * hh;
            m[i] = xacc[st][i] * (a * bw[sx]); }
        } else {
#pragma unroll
          for (int i = 0; i < 16; ++i) { const int sx = st * 32 + (i & 3) + 8 * (i >> 2) + 4 * hh;
            const float wf = Df[sx] * __expf(Pfl - Pf[sx]), wb = Db[sx] * __expf(Pbl - Pb[sx]);
            m[i] = xacc[st][i] * ((sx <= l ? wf : 0.f) + (sx >= l ? wb : 0.f)); }
        }
#pragma unroll
        for (int s2 = 0; s2 < 2; ++s2) {
          u32x4 pw;
#pragma unroll
          for (int j = 0; j < 4; ++j) pw[j] = pk_bf16(m[s2 * 8 + 2 * j], m[s2 * 8 + 2 * j + 1]);
          const char* xp = xtb + (pt * 32 + r32) * SS_XT + (st * 32 + s2 * 16 + 4 * hh) * 2;
          u32x2 a = *(const u32x2*)xp, b2 = *(const u32x2*)(xp + 16);
          bf16x8 xf = as_bf16x8((u32x4){a[0], a[1], b2[0], b2[1]});
          yacc = __builtin_amdgcn_mfma_f32_32x32x16_bf16(xf, as_bf16x8(pw), yacc, 0, 0, 0);
        }
      }
      const float dskip = p.d_skip[h];
      bf16_t* yp = p.Y + ((size_t)seq * SEQ + (c - 1) * 128 + l) * 1024 + h * 64 + pt * 32 + 4 * hh;
#pragma unroll
      for (int g4 = 0; g4 < 4; ++g4) {
        float v[4];
#pragma unroll
        for (int j = 0; j < 4; ++j) {
          const int pp = pt * 32 + g4 * 8 + 4 * hh + j;
          v[j] = yacc[g4 * 4 + j] + dskip * bf2f(*(const bf16_t*)(xtb + pp * SS_XT + l * 2));
        }
        u32x2 w; w[0] = pk_bf16(v[0], v[1]); w[1] = pk_bf16(v[2], v[3]);
        *(u32x2*)(yp + g4 * 8) = w;
      }
      if (h8 + 1 < 8) sstore_head(buf ^ 1);
      lds_barrier();
    }
  }
  lds_barrier();
}

constexpr int OFF_CC = 0, OFF_BT = 128 * SS_ROW, OFF_XT = 2 * 128 * SS_ROW;
constexpr int OFF_XW = OFF_XT + 64 * SS_XT, OFF_SB = OFF_XW + 64 * SS_ROW, OFF_P = OFF_SB + 64 * SS_ROW, OFF_DT = OFF_P + 512;
constexpr int OFF_AT = OFF_DT + 512;
constexpr int OFF_WS = OFF_AT + 128;
constexpr int OFF_YT = OFF_WS + 512;
constexpr int SSD_LDS = OFF_YT + 128 * 272;
static_assert(SSD_LDS <= 160 * 1024 - 64, "ssd lds");
__device__ void ssd_phase(const Params& p, char* smem) {
  const int tid = phase_tid(), lane = tid & 63, wid = tid >> 6;
  const int r32 = lane & 31, hh = lane >> 5;
  const int pt = wid & 1, lt = wid >> 1;
  float* Ps = (float*)(smem + OFF_P);
  float* Ds = (float*)(smem + OFF_DT);
  const int NI = NSEQ * 16, G = gridDim.x;
  const bool split = G >= 256 && G < NI;
  for (int u = 0;; ++u) {
    int item, dir0, dir1; bool to_yb2 = false;
    if (!split) { item = blockIdx.x + u * G; if (item >= NI) break; dir0 = 0; dir1 = 2; }
    else if (G == 256) {
      int gg, j; xcd_group_map(blockIdx.x, gg, j);
      if (u == 0) { item = gg * 8 + j; dir0 = 0; dir1 = 2; }
      else if (u == 1) { item = G + (gg >> 1) * 8 + j; dir0 = gg & 1; dir1 = dir0 + 1; to_yb2 = true; }
      else break;
    }
    else if (u == 0) { item = blockIdx.x; dir0 = 0; dir1 = 2; }
    else { const int hidx = blockIdx.x + (u - 1) * G; if (hidx >= 2 * (NI - G)) break; item = G + (hidx >> 1); dir0 = hidx & 1; dir1 = dir0 + 1; to_yb2 = true; }
    const int h = item & 15, seq = item >> 4, g = h >> 3;
    for (int dir = dir0; dir < dir1; ++dir) {
      const bool yb2 = (dir == 1) && to_yb2;
      f32x16 sacc;
#pragma unroll
      for (int i = 0; i < 16; ++i) sacc[i] = 0.f;
      const float* dtp = p.dtv + ((size_t)(seq * 2 + dir) * 16 + h) * LP;
      const float* Pp = p.Pv + ((size_t)(seq * 2 + dir) * 16 + h) * LP;
      const float* Ap = p.Atot + ((size_t)(seq * 2 + dir) * 16 + h) * NCH;
      u32x4 rc[4], rbt[4], rx[2];
      float rp = 0.f, rd = 0.f;
      auto gload = [&](int c) {
        const bf16_t* cm = p.Cm + ((size_t)seq * LP + c * 128) * 256 + g * 128;
        const bf16_t* bt = p.BmT + (((size_t)seq * NCH + c) * 2 + g) * 128 * 128;
        const bf16_t* xt = p.XT + (((size_t)seq * NCH + c) * 16 + h) * 64 * 128;
#pragma unroll
        for (int i = 0; i < 4; ++i) { int id = tid + i * 512; int r = id >> 4, k = id & 15;
          rc[i] = *(const u32x4*)(cm + (size_t)r * 256 + k * 8);
          rbt[i] = *(const u32x4*)(bt + (size_t)r * 128 + k * 8); }
#pragma unroll
        for (int i = 0; i < 2; ++i) { int id = tid + i * 512; int r = id >> 4, k = id & 15;
          rx[i] = *(const u32x4*)(xt + (size_t)r * 128 + k * 8); }
        if (tid < 128) { rp = Pp[c * 128 + tid]; rd = dtp[c * 128 + tid]; }
      };
      auto sstore = [&](int cs) {
#pragma unroll
        for (int i = 0; i < 4; ++i) { int id = tid + i * 512; int r = id >> 4, k = id & 15;
          *(u32x4*)(smem + OFF_CC + r * SS_ROW + k * 16) = rc[i];
          *(u32x4*)(smem + OFF_BT + r * SS_ROW + k * 16) = rbt[i]; }
#pragma unroll
        for (int i = 0; i < 2; ++i) { int id = tid + i * 512; int r = id >> 4, k = id & 15;
          char* d = smem + OFF_XT + r * SS_XT + k * 16;
          *(u32x2*)d = (u32x2){rx[i][0], rx[i][1]}; *(u32x2*)(d + 8) = (u32x2){rx[i][2], rx[i][3]}; }
        if (tid < 128) {
          Ps[tid] = rp; Ds[tid] = rd;
          ((float*)(smem + OFF_WS))[tid] = rd * (dir == 0 ? __expf(Ap[cs] - rp) : __expf(-rp));
        }
      };
      const int c_first = dir == 0 ? 0 : NCH - 1, c_last = dir == 0 ? NCH - 1 : 1, c_step = dir == 0 ? 1 : -1;
      lds_barrier();
      gload(c_first);
      if (tid < NCH) ((float*)(smem + OFF_AT))[tid] = Ap[tid];
      for (int i = tid; i < 64 * SS_ROW / 4; i += NTHREADS) ((unsigned*)(smem + OFF_SB))[i] = 0u;
      sstore(c_first);
      lds_barrier();
      for (int c = c_first;; c += c_step) {
        const bool last = (c == c_last);
        const bool first = (c == c_first);
        const float atot = ((const float*)(smem + OFF_AT))[c];
        const int l = lt * 32 + r32;
        const bool emit = (c >= 1) && !first;
        const int yrow = tid >> 2, yseg = tid & 3;
        bf16_t* yp = yb2 ? p.Yb2 + ((size_t)(item - G) * SEQ + (c - 1) * 128 + yrow) * 64 + yseg * 16
                         : p.Y + ((size_t)seq * SEQ + (c - 1) * 128 + yrow) * 1024 + h * 64 + yseg * 16;
        u32x4 yold[2] = {{0u, 0u, 0u, 0u}, {0u, 0u, 0u, 0u}};
        if (emit && !yb2) {
          yold[0] = *(const u32x4*)yp; yold[1] = *(const u32x4*)(yp + 8);
        }
        if (!last) gload(c + c_step);
        if (!last) {
          const int pp = tid >> 3, l0 = (tid & 7) * 16;
          const char* srow = smem + OFF_XT + pp * SS_XT + l0 * 2;
          char* drow = smem + OFF_XW + pp * SS_ROW + l0 * 2;
#pragma unroll
          for (int q4 = 0; q4 < 4; ++q4) {
            u32x2 v = *(const u32x2*)(srow + q4 * 8);
            const f32x4 w = *(const f32x4*)(smem + OFF_WS + (l0 + q4 * 4) * 4);
            u32x2 o;
            o[0] = pk_bf16(bflo(v[0]) * w[0], bfhi(v[0]) * w[1]);
            o[1] = pk_bf16(bflo(v[1]) * w[2], bfhi(v[1]) * w[3]);
            *(u32x2*)(drow + q4 * 8) = o;
          }
        }
        if (emit) {
          const float Pl = Ps[l];
          f32x16 yacc;
#pragma unroll
          for (int i = 0; i < 16; ++i) yacc[i] = 0.f;
#pragma unroll
          for (int ks = 0; ks < 8; ++ks) {
            bf16x8 sf = *(const bf16x8*)(smem + OFF_SB + (pt * 32 + r32) * SS_ROW + ks * 32 + hh * 16);
            bf16x8 cfk = *(const bf16x8*)(smem + OFF_CC + l * SS_ROW + ks * 32 + hh * 16);
            yacc = __builtin_amdgcn_mfma_f32_32x32x16_bf16(sf, cfk, yacc, 0, 0, 0);
          }
          const float ysc = dir == 0 ? __expf(Pl) : __expf(Pl + atot);
#pragma unroll
          for (int g4 = 0; g4 < 4; ++g4)
            *(f32x4*)(smem + OFF_YT + l * 272 + (pt * 32 + g4 * 8 + 4 * hh) * 4) =
                (f32x4){yacc[g4 * 4] * ysc, yacc[g4 * 4 + 1] * ysc, yacc[g4 * 4 + 2] * ysc, yacc[g4 * 4 + 3] * ysc};
        }
        lds_barrier();
        if (emit || (yb2 && c >= 1)) {
          float v[16];
#pragma unroll
          for (int q4 = 0; q4 < 4; ++q4) {
            const f32x4 t4 = emit ? *(const f32x4*)(smem + OFF_YT + yrow * 272 + yseg * 64 + q4 * 16) : (f32x4){0.f, 0.f, 0.f, 0.f};
            v[q4 * 4] = t4[0]; v[q4 * 4 + 1] = t4[1]; v[q4 * 4 + 2] = t4[2]; v[q4 * 4 + 3] = t4[3];
          }
          u32x4 w0, w1;
#pragma unroll
          for (int j = 0; j < 4; ++j) {
            w0[j] = pk_bf16(v[2 * j] + bflo(yold[0][j]), v[2 * j + 1] + bfhi(yold[0][j]));
            w1[j] = pk_bf16(v[8 + 2 * j] + bflo(yold[1][j]), v[8 + 2 * j + 1] + bfhi(yold[1][j]));
          }
          *(u32x4*)yp = w0; *(u32x4*)(yp + 8) = w1;
        }
        if (!last) {
          const float dec = __expf(atot);
#pragma unroll
          for (int i = 0; i < 16; ++i) sacc[i] *= dec;
#pragma unroll
          for (int ks = 0; ks < 8; ++ks) {
            bf16x8 xf = *(const bf16x8*)(smem + OFF_XW + (pt * 32 + r32) * SS_ROW + ks * 32 + hh * 16);
            bf16x8 bfg = *(const bf16x8*)(smem + OFF_BT + (lt * 32 + r32) * SS_ROW + ks * 32 + hh * 16);
            sacc = __builtin_amdgcn_mfma_f32_32x32x16_bf16(bfg, xf, sacc, 0, 0, 0);
          }
#pragma unroll
          for (int g4 = 0; g4 < 4; ++g4)
            *(u32x2*)(smem + OFF_SB + (pt * 32 + r32) * SS_ROW + (lt * 32 + g4 * 8 + 4 * hh) * 2) =
                (u32x2){pk_bf16(sacc[g4 * 4], sacc[g4 * 4 + 1]), pk_bf16(sacc[g4 * 4 + 2], sacc[g4 * 4 + 3])};
        }
        lds_barrier();
        if (last) break;
        sstore(c + c_step);
        lds_barrier();
      }
    }
  }
  lds_barrier();
}

__device__ void gate_phase(const Params& p) {
  const int lane = phase_tid() & 63, wid = phase_tid() >> 6;
  const int G = gridDim.x;
  const bool split = G >= 256 && G < NSEQ * 16;
  struct In { u32x4 y[2], z[2], y2[2], o; };
  auto load = [&](In& d, int row) {
#pragma unroll
    for (int c = 0; c < 2; ++c) {
      d.y[c] = *(const u32x4*)(p.Y + (size_t)row * 1024 + c * 512 + lane * 8);
      d.z[c] = *(const u32x4*)(p.z + (size_t)row * 1024 + c * 512 + lane * 8);
      const int item = (row >> 11) * 16 + c * 8 + (lane >> 3);
      d.y2[c] = (u32x4){0u, 0u, 0u, 0u};
      if (split && item >= G) d.y2[c] = *(const u32x4*)(p.Yb2 + ((size_t)(item - G) * SEQ + (row & (SEQ - 1))) * 64 + (lane & 7) * 8);
    }
    d.o = *(const u32x4*)(p.o + (size_t)row * 512 + lane * 8);
  };
  const int stride = gridDim.x * 8;
  int row = blockIdx.x * 8 + wid;
  In cur, nxt;
  if (row < TX) load(cur, row);
  for (; row < TX; row += stride) {
    if (row + stride < TX) load(nxt, row + stride);
    float v[16];
    float ss = 0.f;
#pragma unroll
    for (int c = 0; c < 2; ++c) {
#pragma unroll
      for (int j = 0; j < 4; ++j) {
        float a = (bflo(cur.y[c][j]) + bflo(cur.y2[c][j])) * silu_f(bflo(cur.z[c][j])), b2 = (bfhi(cur.y[c][j]) + bfhi(cur.y2[c][j])) * silu_f(bfhi(cur.z[c][j]));
        v[c * 8 + 2 * j] = a; v[c * 8 + 2 * j + 1] = b2; ss += a * a + b2 * b2;
      }
    }
    const float r = rsqrtf(wave_sum(ss) * (1.f / 1024.f) + EPS);
#pragma unroll
    for (int c = 0; c < 2; ++c) {
      const float* g = p.ssm_norm_g + c * 512 + lane * 8;
      u32x4 w;
#pragma unroll
      for (int j = 0; j < 4; ++j) w[j] = pk_bf16(v[c * 8 + 2 * j] * r * g[2 * j], v[c * 8 + 2 * j + 1] * r * g[2 * j + 1]);
      *(u32x4*)(p.ycat + (size_t)row * 1536 + c * 512 + lane * 8) = w;
    }
    {
      const u32x4 o = cur.o;
      float f[8] = {bflo(o[0]), bfhi(o[0]), bflo(o[1]), bfhi(o[1]), bflo(o[2]), bfhi(o[2]), bflo(o[3]), bfhi(o[3])};
      float s2 = 0.f;
#pragma unroll
      for (int j = 0; j < 8; ++j) s2 += f[j] * f[j];
      const float r2 = rsqrtf(wave_sum(s2) * (1.f / 512.f) + EPS);
      const float* g = p.attn_norm_g + lane * 8;
      u32x4 w;
#pragma unroll
      for (int j = 0; j < 4; ++j) w[j] = pk_bf16(f[2 * j] * r2 * g[2 * j], f[2 * j + 1] * r2 * g[2 * j + 1]);
      *(u32x4*)(p.ycat + (size_t)row * 1536 + 1024 + lane * 8) = w;
    }
    cur = nxt;
  }
}

__device__ void ln1_phase(const Params& p) {
  const int lane = phase_tid() & 63, wid = phase_tid() >> 6;
  const int stride = gridDim.x * 8;
  int row = blockIdx.x * 8 + wid;
  u32x4 nx[2];
  if (row < TX) { nx[0] = *(const u32x4*)(p.pre + (size_t)row * DM + lane * 8); nx[1] = *(const u32x4*)(p.pre + (size_t)row * DM + 512 + lane * 8); }
  for (; row < TX; row += stride) {
    const u32x4 cu[2] = {nx[0], nx[1]};
    if (row + stride < TX) { nx[0] = *(const u32x4*)(p.pre + (size_t)(row + stride) * DM + lane * 8); nx[1] = *(const u32x4*)(p.pre + (size_t)(row + stride) * DM + 512 + lane * 8); }
    float v[16];
#pragma unroll
    for (int c = 0; c < 2; ++c) {
#pragma unroll
      for (int j = 0; j < 4; ++j) { v[c * 8 + 2 * j] = bflo(cu[c][j]); v[c * 8 + 2 * j + 1] = bfhi(cu[c][j]); }
    }
    float s = 0.f;
#pragma unroll
    for (int j = 0; j < 16; ++j) s += v[j];
    const float mu = wave_sum(s) * (1.f / DM);
    float s2 = 0.f;
#pragma unroll
    for (int j = 0; j < 16; ++j) { float d = v[j] - mu; s2 += d * d; }
    const float rstd = rsqrtf(wave_sum(s2) * (1.f / DM) + EPS);
#pragma unroll
    for (int c = 0; c < 2; ++c) {
      const float* g = p.ln1_g + c * 512 + lane * 8; const float* b = p.ln1_b + c * 512 + lane * 8;
      float o[8];
#pragma unroll
      for (int j = 0; j < 8; ++j) o[j] = (v[c * 8 + j] - mu) * rstd * g[j] + b[j];
      *(u32x4*)(p.h1 + (size_t)row * DM + c * 512 + lane * 8) = pack8(o);
      float am = 0.f;
#pragma unroll
      for (int j = 0; j < 8; ++j) am = fmaxf(am, fabsf(o[j]));
      am = fmaxf(am, __builtin_bit_cast(float, __builtin_amdgcn_update_dpp(0, __builtin_bit_cast(int, am), 0x128, 0xf, 0xf, true)));
      am = fmaxf(am, __builtin_bit_cast(float, __builtin_amdgcn_update_dpp(0, __builtin_bit_cast(int, am), 0x124, 0xf, 0xf, true)));
      am = fmaxf(am, __builtin_bit_cast(float, __builtin_amdgcn_update_dpp(0, __builtin_bit_cast(int, am), 0x122, 0xf, 0xf, true)));
      am = fmaxf(am, __builtin_bit_cast(float, __builtin_amdgcn_update_dpp(0, __builtin_bit_cast(int, am), 0x121, 0xf, 0xf, true)));
      const float sc = am > 0.f ? am * (1.f / 127.f) : 1.f;
      const float inv = 1.f / sc;
      unsigned w0 = 0u, w1 = 0u;
#pragma unroll
      for (int j = 0; j < 4; ++j) {
        w0 |= ((unsigned)__float2int_rn(o[j] * inv) & 255u) << (8 * j);
        w1 |= ((unsigned)__float2int_rn(o[4 + j] * inv) & 255u) << (8 * j);
      }
      *(u32x2*)(p.h1q + (size_t)row * DM + c * 512 + lane * 8) = (u32x2){w0, w1};
      if ((lane & 15) == 0) p.sx[(size_t)row * 8 + c * 4 + (lane >> 4)] = sc;
    }
  }
}

template <bool INT8>
__device__ void quant_rows(const float* __restrict__ src, unsigned char* __restrict__ dstq, float* __restrict__ scl) {
  const int lane = phase_tid() & 63, wid = phase_tid() >> 6;
  for (int e = blockIdx.x * 8 + wid; e < 16384; e += gridDim.x * 8) {
    const float* r = src + (size_t)e * 1024 + lane * 4;
    f32x4 a[4];
#pragma unroll
    for (int j = 0; j < 4; ++j) a[j] = *(const f32x4*)(r + j * 256);
    float m = 0.f;
#pragma unroll
    for (int j = 0; j < 4; ++j)
#pragma unroll
      for (int k = 0; k < 4; ++k) m = fmaxf(m, fabsf(a[j][k]));
#pragma unroll
    for (int o = 32; o >= 1; o >>= 1) m = fmaxf(m, __shfl_xor(m, o));
    const float sc = m > 0.f ? m * (INT8 ? (1.f / 127.f) : (1.f / 240.f)) : 1.f;
    const float inv = 1.f / sc;
#pragma unroll
    for (int j = 0; j < 4; ++j) {
      unsigned w;
      if (INT8) {
        w = 0u;
#pragma unroll
        for (int k = 0; k < 4; ++k) w |= ((unsigned)__float2int_rn(a[j][k] * inv) & 255u) << (8 * k);
      } else {
        int t = __builtin_amdgcn_cvt_pk_fp8_f32(a[j][0] * inv, a[j][1] * inv, 0, false);
        t = __builtin_amdgcn_cvt_pk_fp8_f32(a[j][2] * inv, a[j][3] * inv, t, true);
        w = (unsigned)t;
      }
      *(unsigned*)(dstq + ((size_t)(j * 2 + (lane >> 5)) * 16384 + e) * 128 + (lane & 31) * 4) = w;
    }
    if (lane == 0) scl[e] = sc;
  }
}

__device__ __forceinline__ float dpp_add8(float v) {
  v += __builtin_bit_cast(float, __builtin_amdgcn_update_dpp(0, __builtin_bit_cast(int, v), 0xB1, 0xf, 0xf, true));
  v += __builtin_bit_cast(float, __builtin_amdgcn_update_dpp(0, __builtin_bit_cast(int, v), 0x4E, 0xf, 0xf, true));
  v += __builtin_bit_cast(float, __builtin_amdgcn_update_dpp(0, __builtin_bit_cast(int, v), 0x141, 0xf, 0xf, true));
  return v;
}
__device__ __forceinline__ void fp8x16_to_f32(u32x4 w, float (&f)[16]) {
#pragma unroll
  for (int j = 0; j < 4; ++j) {
    f32x2_t lo = __builtin_amdgcn_cvt_pk_f32_fp8((int)w[j], false);
    f32x2_t hi = __builtin_amdgcn_cvt_pk_f32_fp8((int)w[j], true);
    f[4 * j] = lo[0]; f[4 * j + 1] = lo[1]; f[4 * j + 2] = hi[0]; f[4 * j + 3] = hi[1];
  }
}

__device__ void peer_u_phase(const Params& p, char* smem) {
  const int lane = phase_tid() & 63, wid = phase_tid() >> 6;
  const int sg = lane >> 3, q = lane & 7;
  const int nr = gridDim.x >> 3;
  if ((int)blockIdx.x >= nr * 8) return;
  const volatile LAS unsigned* st = (const volatile LAS unsigned*)(smem + LDS_BYTES - 32);
  const bool xok = st[4] != 0u;
  const int slice = xok ? (int)st[2] : (int)(blockIdx.x & 7), rank = xok ? (int)st[3] : (int)(blockIdx.x >> 3);
  const unsigned char* Us = p.Uq + (size_t)slice * 16384 * 128 + q * 16;
  const int stride = nr * 8;
  int t = rank * 8 + wid;
  if (t >= TX) return;
  struct Ids { u32x4 e[2]; u32x4 xq; float sx; };
  auto load_ids = [&](Ids& d, int tt) {
    tt = tt < TX ? tt : TX - 1;
    const unsigned short* ep = p.experts + (size_t)tt * 128 + sg * 16;
    d.e[0] = *(const u32x4*)ep; d.e[1] = *(const u32x4*)(ep + 8);
    d.xq = *(const u32x4*)(p.h1q + (size_t)tt * DM + slice * 128 + q * 16);
    d.sx = p.sx[(size_t)tt * 8 + slice];
  };
  auto issue = [&](u32x4 (&uq)[8], const u32x4& ew) {
#pragma unroll
    for (int j = 0; j < 4; ++j) {
      uq[2 * j] = *(const u32x4*)(Us + (size_t)(ew[j] & 0xffffu) * 128);
      uq[2 * j + 1] = *(const u32x4*)(Us + (size_t)(ew[j] >> 16) * 128);
    }
  };
  auto compute = [&](const u32x4 (&uq)[8], const u32x4& xq, float sxv, float (&pdv)[8]) {
#pragma unroll
    for (int i = 0; i < 8; ++i) {
      int d = 0;
#pragma unroll
      for (int j = 0; j < 4; ++j) d = __builtin_amdgcn_sdot4((int)uq[i][j], (int)xq[j], d, false);
      d += __builtin_amdgcn_update_dpp(0, d, 0xB1, 0xf, 0xf, true);
      d += __builtin_amdgcn_update_dpp(0, d, 0x4E, 0xf, 0xf, true);
      d += __builtin_amdgcn_update_dpp(0, d, 0x141, 0xf, 0xf, true);
      pdv[i] = (float)d * sxv;
    }
  };
  auto step = [&](Ids& cur, Ids& nxt, Ids& nn, u32x4 (&P)[8], u32x4 (&Q)[8], u32x4 (&R)[8]) -> bool {
    const bool has1 = t + stride < TX;
    issue(R, nxt.e[0]);
    load_ids(nn, t + 2 * stride);
    float pa[8], pb[8];
    compute(P, cur.xq, cur.sx, pa);
    issue(P, nxt.e[1]);
    compute(Q, cur.xq, cur.sx, pb);
    if (q == 0) {
      bf16_t* dst = p.pd + ((size_t)slice * TX + t) * 128 + sg * 16;
      *(u32x4*)dst = (u32x4){pk_bf16(pa[0], pa[1]), pk_bf16(pa[2], pa[3]), pk_bf16(pa[4], pa[5]), pk_bf16(pa[6], pa[7])};
      *(u32x4*)(dst + 8) = (u32x4){pk_bf16(pb[0], pb[1]), pk_bf16(pb[2], pb[3]), pk_bf16(pb[4], pb[5]), pk_bf16(pb[6], pb[7])};
    }
    return has1;
  };
  Ids A, B, C;
  u32x4 X[8], Y[8], Z[8];
  load_ids(A, t);
  load_ids(B, t + stride);
  issue(X, A.e[0]);
  issue(Y, A.e[1]);
  for (;;) {
    if (!step(A, B, C, X, Y, Z)) break;
    t += stride;
    if (!step(B, C, A, Z, X, Y)) break;
    t += stride;
    if (!step(C, A, B, Y, Z, X)) break;
    t += stride;
  }
}

__device__ void peer_c_phase(const Params& p) {
  const size_t n4 = (size_t)TX * 128 / 4;
  const int tid = phase_tid();
  for (size_t i0 = (size_t)blockIdx.x * NTHREADS; i0 < n4; i0 += (size_t)gridDim.x * NTHREADS) {
    const size_t i = i0 + tid;
    f32x4 s = {0.f, 0.f, 0.f, 0.f};
#pragma unroll
    for (int sl = 0; sl < 8; ++sl) {
      const u32x2 w = *(const u32x2*)(p.pd + (size_t)sl * TX * 128 + i * 4);
      s[0] += bflo(w[0]); s[1] += bfhi(w[0]); s[2] += bflo(w[1]); s[3] += bfhi(w[1]);
    }
    const f32x4 g = *(const f32x4*)(p.gates + i * 4);
    const u32x2 ew = *(const u32x2*)(p.experts + i * 4);
    const int ev[4] = {(int)(ew[0] & 0xffffu), (int)(ew[0] >> 16), (int)(ew[1] & 0xffffu), (int)(ew[1] >> 16)};
    float c[4];
    float am = 0.f;
#pragma unroll
    for (int j = 0; j < 4; ++j) {
      const float d = s[j] * p.su[ev[j]];
      c[j] = g[j] * 0.5f * d * (1.f + erff(d * 0.70710678118654752f)) * p.sv[ev[j]];
      am = fmaxf(am, fabsf(c[j]));
    }
#pragma unroll
    for (int o = 16; o >= 1; o >>= 1) am = fmaxf(am, __shfl_xor(am, o));
    const float sc = am > 0.f ? am * (1.f / 240.f) : 1.f;
    const float inv = 1.f / sc;
    int w = __builtin_amdgcn_cvt_pk_fp8_f32(c[0] * inv, c[1] * inv, 0, false);
    w = __builtin_amdgcn_cvt_pk_fp8_f32(c[2] * inv, c[3] * inv, w, true);
    const size_t t = i >> 5; const int gq = (int)(i & 31);
    const int c4 = gq & 3, sgq = gq >> 2, a4 = sgq >> 2, r4 = sgq & 3;
    unsigned outw = 0u;
#pragma unroll
    for (int m = 0; m < 4; ++m) {
      const int srcl = (tid & 32) + (4 * a4 + m) * 4 + c4;
      const unsigned vm = (unsigned)__builtin_amdgcn_ds_bpermute(srcl * 4, w);
      outw |= ((vm >> (8 * r4)) & 255u) << (8 * m);
    }
    ((unsigned*)(p.cq + t * 128))[(4 * c4 + r4) * 2 + a4] = outw;
    if (gq == 0) p.csc[t] = sc;
  }
}

typedef int v2i_t __attribute__((ext_vector_type(2)));
constexpr int PV_BLK = 1024 + 32;
constexpr int PV_WAVE_LDS = 16 * PV_BLK + 512;
static_assert(8 * PV_WAVE_LDS <= 160 * 1024 - 64, "peer v lds");
__device__ void peer_v_phase(const Params& p, char* smem) {
  const int lane = phase_tid() & 63, wid = __builtin_amdgcn_readfirstlane(phase_tid() >> 6);
  const int sg = (lane >> 2) & 7, q = (lane >> 5) * 4 + (lane & 3);
  const int kg = lane >> 4;
  const int nr = gridDim.x >> 3;
  if ((int)blockIdx.x >= nr * 8) return;
  const volatile LAS unsigned* st = (const volatile LAS unsigned*)(smem + LDS_BYTES - 32);
  const bool xok = st[4] != 0u;
  const int slice = xok ? (int)st[2] : (int)(blockIdx.x & 7), rank = xok ? (int)st[3] : (int)(blockIdx.x >> 3);
  const unsigned char* Vs = p.Vq + (size_t)slice * 16384 * 128 + q * 16;
  LAS char* wb = (LAS char*)smem + wid * PV_WAVE_LDS;
  const int stride = nr * 8;
  int t = rank * 8 + wid;
  if (t >= TX) return;
  struct Ids { u32x4 e[2]; u32x2 a[4]; float sc; u32x4 xa, xb; };
  auto ldg16 = [&](u32x4& d, const void* ptr) { asm volatile("global_load_dwordx4 %0, %1, off" : "=v"(d) : "v"(ptr) : "memory"); };
  auto ldg8 = [&](u32x2& d, const void* ptr) { asm volatile("global_load_dwordx2 %0, %1, off" : "=v"(d) : "v"(ptr) : "memory"); };
  auto ldg4 = [&](float& d, const void* ptr) { asm volatile("global_load_dword %0, %1, off" : "=v"(d) : "v"(ptr) : "memory"); };
  auto load_ids = [&](Ids& d, int tt) {
    tt = tt < TX ? tt : TX - 1;
    const bf16_t* xp = p.h1 + (size_t)tt * DM + slice * 128 + (lane & 7) * 16;
    ldg16(d.xa, xp); ldg16(d.xb, xp + 8);
    const unsigned short* ep = p.experts + (size_t)tt * 128 + sg * 16;
    ldg16(d.e[0], ep); ldg16(d.e[1], ep + 8);
    const unsigned char* cp = p.cq + (size_t)tt * 128 + kg * 8;
#pragma unroll
    for (int ks = 0; ks < 4; ++ks) ldg8(d.a[ks], cp + ks * 32);
    ldg4(d.sc, p.csc + tt);
  };
  auto pin = [&](Ids& d) {
    asm volatile("" : "+v"(d.xa), "+v"(d.xb), "+v"(d.e[0]), "+v"(d.e[1]), "+v"(d.a[0]), "+v"(d.a[1]), "+v"(d.a[2]), "+v"(d.a[3]), "+v"(d.sc));
  };
  const unsigned wb_lds = (unsigned)__builtin_amdgcn_readfirstlane((int)(unsigned)(unsigned long long)wb);
  auto dma = [&](const unsigned char* gsrc, unsigned lds_dst) {
    unsigned keep;
    asm volatile("s_mov_b32 %0, m0\n\ts_mov_b32 m0, %2\n\ts_nop 0\n\tglobal_load_lds_dwordx4 %1, off\n\ts_mov_b32 m0, %0"
                 : "=&s"(keep) : "v"(gsrc), "s"(lds_dst) : "memory");
  };
  auto issue = [&](int half, const u32x4& ew) {
    asm volatile("s_waitcnt lgkmcnt(0)" ::: "memory");
#pragma unroll
    for (int j = 0; j < 4; ++j) {
      dma(Vs + (size_t)(ew[j] & 0xffffu) * 128, wb_lds + (unsigned)((half * 8 + 2 * j) * PV_BLK));
      dma(Vs + (size_t)(ew[j] >> 16) * 128, wb_lds + (unsigned)((half * 8 + 2 * j + 1) * PV_BLK));
    }
  };
  f32x4 acc[8];
  const int troff = ((lane & 15) >> 1) * 64 + (lane & 1) * 8;
  auto consume = [&](int half, const Ids& d) {
#pragma unroll
    for (int k2 = 0; k2 < 2; ++k2) {
      const u32x2 av = d.a[half * 2 + k2];
      const long a = (long)(((unsigned long long)av[1] << 32) | (unsigned long long)av[0]);
      const LAS char* blk = wb + (half * 8 + k2 * 4 + kg) * PV_BLK + troff;
#pragma unroll
      for (int nt = 0; nt < 8; ++nt) {
        const v2i_t bv = __builtin_amdgcn_ds_read_tr8_b64_v2i32((LAS v2i_t*)(blk + (nt >> 2) * 512 + (nt & 3) * 16));
        const long bl = (long)(((unsigned long long)(unsigned)bv[1] << 32) | (unsigned long long)(unsigned)bv[0]);
        acc[nt] = __builtin_amdgcn_mfma_f32_16x16x32_fp8_fp8(a, bl, acc[nt], 0, 0, 0);
      }
    }
  };
  Ids A, B, C;
  asm volatile("s_waitcnt vmcnt(0)" ::: "memory");
  load_ids(A, t);
  load_ids(B, t + stride);
  asm volatile("s_waitcnt vmcnt(0)" ::: "memory");
  pin(A); pin(B);
  issue(0, A.e[0]);
  auto step = [&](Ids& cur, Ids& nxt, Ids& nn, bool first) -> bool {
    const bool has1 = t + stride < TX;
    load_ids(nn, t + 2 * stride);
    issue(1, cur.e[1]);
#pragma unroll
    for (int nt = 0; nt < 8; ++nt) acc[nt] = (f32x4){0.f, 0.f, 0.f, 0.f};
    if (first) asm volatile("s_waitcnt vmcnt(16)" ::: "memory"); else asm volatile("s_waitcnt vmcnt(18)" ::: "memory");
    consume(0, cur);
    issue(0, nxt.e[0]);
    asm volatile("s_waitcnt vmcnt(8)" ::: "memory");
    pin(nn);
    consume(1, cur);
    LAS float* yt = (LAS float*)(wb + 16 * PV_BLK);
    if (lane < 16) {
#pragma unroll
      for (int nt = 0; nt < 8; ++nt) yt[nt * 16 + lane] = acc[nt][0];
    }
    asm volatile("s_waitcnt lgkmcnt(0)" ::: "memory");
    if (lane < 8) {
      float v[16];
#pragma unroll
      for (int j = 0; j < 4; ++j) { const f32x4 f = *(const LAS f32x4*)(yt + lane * 16 + j * 4); v[4 * j] = f[0]; v[4 * j + 1] = f[1]; v[4 * j + 2] = f[2]; v[4 * j + 3] = f[3]; }
      float xs[16];
#pragma unroll
      for (int j = 0; j < 4; ++j) { xs[2 * j] = bflo(cur.xa[j]); xs[2 * j + 1] = bfhi(cur.xa[j]); xs[8 + 2 * j] = bflo(cur.xb[j]); xs[8 + 2 * j + 1] = bfhi(cur.xb[j]); }
      bf16_t* dst = p.pre2 + (size_t)t * DM + slice * 128 + lane * 16;
      u32x4 w0, w1;
#pragma unroll
      for (int j = 0; j < 4; ++j) {
        w0[j] = pk_bf16(ALPHA * xs[2 * j] + cur.sc * v[2 * j], ALPHA * xs[2 * j + 1] + cur.sc * v[2 * j + 1]);
        w1[j] = pk_bf16(ALPHA * xs[8 + 2 * j] + cur.sc * v[8 + 2 * j], ALPHA * xs[8 + 2 * j + 1] + cur.sc * v[8 + 2 * j + 1]);
      }
      *(u32x4*)dst = w0; *(u32x4*)(dst + 8) = w1;
    }
    return has1;
  };
  if (step(A, B, C, true)) {
    t += stride;
    for (;;) {
      if (!step(B, C, A, false)) break;
      t += stride;
      if (!step(C, A, B, false)) break;
      t += stride;
      if (!step(A, B, C, false)) break;
      t += stride;
    }
  }
  asm volatile("s_waitcnt vmcnt(0)" ::: "memory");
}

__device__ void ln2_phase(const Params& p) {
  const int lane = phase_tid() & 63, wid = phase_tid() >> 6;
  const int stride = gridDim.x * 8;
  int row = blockIdx.x * 8 + wid;
  u32x2 nx[4];
  if (row < TX) {
#pragma unroll
    for (int c = 0; c < 4; ++c) nx[c] = *(const u32x2*)(p.pre2 + (size_t)row * DM + c * 256 + lane * 4); }
  for (; row < TX; row += stride) {
    float* dst = p.out + (size_t)row * DM;
    float v[16];
#pragma unroll
    for (int c = 0; c < 4; ++c) { v[c * 4] = bflo(nx[c][0]); v[c * 4 + 1] = bfhi(nx[c][0]); v[c * 4 + 2] = bflo(nx[c][1]); v[c * 4 + 3] = bfhi(nx[c][1]); }
    if (row + stride < TX) {
#pragma unroll
      for (int c = 0; c < 4; ++c) nx[c] = *(const u32x2*)(p.pre2 + (size_t)(row + stride) * DM + c * 256 + lane * 4); }
    float s = 0.f;
#pragma unroll
    for (int j = 0; j < 16; ++j) s += v[j];
    const float mu = wave_sum(s) * (1.f / DM);
    float s2 = 0.f;
#pragma unroll
    for (int j = 0; j < 16; ++j) { float d = v[j] - mu; s2 += d * d; }
    const float rstd = rsqrtf(wave_sum(s2) * (1.f / DM) + EPS);
#pragma unroll
    for (int c = 0; c < 4; ++c) {
      const f32x4 g = *(const f32x4*)(p.ln2_g + c * 256 + lane * 4), bb = *(const f32x4*)(p.ln2_b + c * 256 + lane * 4);
      f32x4 o;
#pragma unroll
      for (int j = 0; j < 4; ++j) o[j] = (v[c * 4 + j] - mu) * rstd * g[j] + bb[j];
      *(f32x4*)(dst + c * 256 + lane * 4) = o;
    }
  }
}


#define XB_TMO      128
#define XB_XCNT(j)  (256  + 64 * (j))
#define XB_XSUB(j)  (1280 + 64 * (j))
#define XB_XGEN(j)  (2304 + 64 * (j))
#define XB_TOP      3328
#define XB_TOPGEN   3392
#define XCD_BAR_WORDS 3456
#define XB_SPIN_CAP (1u << 22)
__device__ __forceinline__ unsigned xb_ld(unsigned* p)              { return __hip_atomic_load(p, __ATOMIC_RELAXED, __HIP_MEMORY_SCOPE_AGENT); }
__device__ __forceinline__ unsigned xb_add(unsigned* p, unsigned v) { return __hip_atomic_fetch_add(p, v, __ATOMIC_RELAXED, __HIP_MEMORY_SCOPE_AGENT); }
__device__ __forceinline__ unsigned xb_xcc_id() { return (unsigned)__builtin_amdgcn_s_getreg((3 << 11) | 20) & 0xFu; }
#define XB_SPIN(cond, bar) do { unsigned _sp = 0; while (cond) { __builtin_amdgcn_s_sleep(1); \
    if ((++_sp & 255u) == 0u) { if (xb_ld(&(bar)[XB_TMO])) break; if (_sp > XB_SPIN_CAP) { atomicAdd(&(bar)[XB_TMO], 1u); break; } } } } while (0)
struct XcdBarrier { unsigned* bar; unsigned x; volatile LAS unsigned* st; };
__device__ __forceinline__ XcdBarrier xcd_barrier_post(unsigned* bar, volatile LAS unsigned* st) {
  XcdBarrier b; b.bar = bar; b.x = xb_xcc_id(); b.st = st;
  if (threadIdx.x == 0) (void)xb_add(&bar[XB_XCNT(b.x)], 1u);
  return b;
}
__device__ __forceinline__ void xcd_barrier_complete(unsigned* bar, unsigned x, unsigned& nloc, unsigned& nx) {
  const unsigned G = gridDim.x * gridDim.y * gridDim.z;
  unsigned sum, cnt, mine, sp = 0u;
  for (;;) {
    sum = 0u; cnt = 0u; mine = 0u;
#pragma unroll
    for (unsigned j = 0; j < 16; ++j) { const unsigned c = xb_ld(&bar[XB_XCNT(j)]); sum += c; cnt += (c > 0u) ? 1u : 0u; mine = (j == x) ? c : mine; }
    if (sum == G) break;
    __builtin_amdgcn_s_sleep(1);
    if ((++sp & 255u) == 0u) { if (xb_ld(&bar[XB_TMO])) break; if (sp > XB_SPIN_CAP) { atomicAdd(&bar[XB_TMO], 1u); break; } }
  }
  nloc = mine > 0u ? mine : 1u; nx = cnt > 0u ? cnt : 1u;
}
__device__ __forceinline__ void xcd_barrier(const XcdBarrier& b) {
  asm volatile("s_waitcnt vmcnt(0)" ::: "memory");
  __syncthreads();
  if (threadIdx.x == 0) {
    unsigned* bar = b.bar;
    __builtin_amdgcn_s_waitcnt(0);
    unsigned nloc = b.st[0], nx = b.st[1];
    if (nloc == 0u) { xcd_barrier_complete(bar, b.x, nloc, nx); b.st[0] = nloc; b.st[1] = nx; }
    const unsigned old = xb_add(&bar[XB_XSUB(b.x)], 1u);
    const unsigned gen = old / nloc;
    if (old + 1u == (gen + 1u) * nloc) {
      __builtin_amdgcn_fence(__ATOMIC_RELEASE, "agent");
      asm volatile("s_waitcnt vmcnt(0)" ::: "memory");
      const unsigned og = xb_add(&bar[XB_TOP], 1u);
      const unsigned tg = og / nx;
      if (og + 1u == (tg + 1u) * nx) xb_add(&bar[XB_TOPGEN], 1u);
      else XB_SPIN(xb_ld(&bar[XB_TOPGEN]) == tg, bar);
      __builtin_amdgcn_fence(__ATOMIC_ACQUIRE, "agent");
      xb_add(&bar[XB_XGEN(b.x)], 1u);
      asm volatile("s_waitcnt vmcnt(0)" ::: "memory");
    } else {
      XB_SPIN(xb_ld(&bar[XB_XGEN(b.x)]) == gen, bar);
      __builtin_amdgcn_fence(__ATOMIC_ACQUIRE, "agent");
      asm volatile("s_waitcnt vmcnt(0)" ::: "memory");
    }
  }
  __syncthreads();
}

template <int PH>
__device__ __forceinline__ void run_phase(const Params& p, char* smem) {
  if constexpr (PH == 0) {
    transpose_convert(p.w_in, p.WinT, 1024, 3264, DINP, smem);
    transpose_convert(p.w_uq, p.WuqT, 384, 768, 768, smem);
    for (int i = blockIdx.x * NTHREADS + threadIdx.x; i < 512 * 256; i += gridDim.x * NTHREADS) {
      const int j = i >> 8, k = i & 255;
      const float* src = p.w_ukv + (size_t)k * 1024 + (j >> 6) * 128 + (j & 63);
      p.WkT[i] = f2bf(src[0]); p.WvT[i] = f2bf(src[64]);
    }
    transpose_convert(p.w_out, p.WoutT, 1536, 1024, 1024, smem);
    fold_peer(p, smem);
    ln_in_phase(p);
  } else if constexpr (PH == 1) {
    pg8::run(smem, p.h0, p.WinT, TP, DINP, 1024, pg8::EpiBf16S{p.z, 1024, 1024, p.xbc_raw, 1536, 2560, p.rest, 768});
  } else if constexpr (PH == 2) {
    conv_phase(p, smem);
    token_phase(p);
    dt_phase(p);
  } else if constexpr (PH == 3) {
    pg8::run(smem, p.cqn, p.WuqT, TX, 768, 384, pg8::EpiBf16S{p.q, 768, 1 << 30, nullptr, 0, 1 << 30, nullptr, 0});
    pg8::run(smem, p.ckvn, p.WkT, TP, 512, 256, pg8::EpiBf16S{p.Kb, 512, 1 << 30, nullptr, 0, 1 << 30, nullptr, 0});
    pg8::run(smem, p.WvT, p.ckvn, 512, TP, 256, pg8::EpiBf16S{p.vT, TP, 1 << 30, nullptr, 0, 1 << 30, nullptr, 0});
  } else if constexpr (PH == 4) {
    attn_phase(p, smem);
  } else if constexpr (PH == 5) {
    ssd_phase(p, smem);
  } else if constexpr (PH == 6) {
    gate_phase(p);
  } else if constexpr (PH == 7) {
    pg8::run(smem, p.ycat, p.WoutT, TX, 1024, 1536, pg8::EpiOutRes{p.pre, p.h0});
  } else if constexpr (PH == 8) {
    ln1_phase(p);
    quant_rows<true>(p.peer_u, p.Uq, p.su);
    quant_rows<false>(p.peer_v, p.Vq, p.sv);
  } else if constexpr (PH == 9) {
    pg8::run_drained(smem, p.h1, p.WpT, TX, 2048, 1024, pg8::EpiPeerScore{p.experts, p.gates});
  } else if constexpr (PH == 11) {
    peer_u_phase(p, smem);
  } else if constexpr (PH == 12) {
    peer_c_phase(p);
  } else if constexpr (PH == 13) {
    peer_v_phase(p, smem);
  } else if constexpr (PH == 14) {
    ln2_phase(p);
  } else if constexpr (PH == 15) {
    ssd_diag_phase(p, smem);
  }
}

__global__ void __launch_bounds__(NTHREADS) mega_kernel(Params p) {
  extern __shared__ __attribute__((aligned(16))) char smem[];
  cg::grid_group grid = cg::this_grid();
  volatile LAS unsigned* st = (volatile LAS unsigned*)(smem + LDS_BYTES - 32);
  if (threadIdx.x == 0) {
    st[0] = 0u; st[1] = 0u;
    const unsigned xcc = xb_xcc_id();
    st[2] = xcc; st[3] = xb_add(&p.bar[xcc], 1u);
  }
  __syncthreads();
  XcdBarrier xb = xcd_barrier_post(p.bar, st);
  run_phase<0>(p, smem); grid.sync();
  if (threadIdx.x == 0) {
    unsigned ok = (gridDim.x & 7u) == 0u ? 1u : 0u;
    for (unsigned j = 0; j < 16; ++j) { const unsigned c = xb_ld(&p.bar[j]); if (c != (j < 8 ? gridDim.x >> 3 : 0u)) ok = 0u; }
    st[4] = ok;
  }
  __syncthreads();
  run_phase<1>(p, smem); xcd_barrier(xb);
  run_phase<2>(p, smem); xcd_barrier(xb);
  run_phase<15>(p, smem); xcd_barrier(xb);
  run_phase<5>(p, smem); xcd_barrier(xb);
  run_phase<3>(p, smem); xcd_barrier(xb);
  run_phase<4>(p, smem); xcd_barrier(xb);
  run_phase<6>(p, smem); xcd_barrier(xb);
  run_phase<7>(p, smem); xcd_barrier(xb);
  run_phase<8>(p, smem); xcd_barrier(xb);
  run_phase<9>(p, smem); xcd_barrier(xb);
  run_phase<11>(p, smem); xcd_barrier(xb);
  run_phase<12>(p, smem); xcd_barrier(xb);
  run_phase<13>(p, smem); xcd_barrier(xb);
  run_phase<14>(p, smem);
}

extern "C" void kernel_launch(void* const* d_in, const int* in_sizes, int n_in,
                              void* d_out, int out_size, void* d_ws, size_t ws_size,
                              hipStream_t stream) {
  Params p{};
  const float** in = (const float**)&p.x_prompt;
  for (int i = 0; i < 28; ++i) in[i] = (const float*)d_in[i];
  p.out = (float*)d_out;
  char* ws = (char*)d_ws;
  size_t off = 0;
  auto take = [&](size_t bytes) { char* r = ws + off; off += (bytes + 255) & ~(size_t)255; return r; };
  p.h0 = (bf16_t*)take((size_t)TP * 1024 * 2);
  p.WinT = (bf16_t*)take((size_t)DINP * 1024 * 2);
  p.WuqT = (bf16_t*)take((size_t)768 * 384 * 2);
  p.WkT = (bf16_t*)take((size_t)512 * 256 * 2);
  p.WvT = (bf16_t*)take((size_t)512 * 256 * 2);
  p.WoutT = (bf16_t*)take((size_t)1024 * 1536 * 2);
  p.WpT = (bf16_t*)take((size_t)2048 * 1024 * 2);
  char* zreg = take((size_t)TP * 1024 * 2);
  char* r1 = take((size_t)TP * 1536 * 2);
  char* r2 = take((size_t)TP * 768 * 2);
  p.cqn = (bf16_t*)take((size_t)TP * 384 * 2);
  p.ckvn = (bf16_t*)take((size_t)TP * 256 * 2);
  p.kr = (bf16_t*)take((size_t)TP * 32 * 2);
  p.dtv = (float*)take((size_t)NSEQ * 2 * 16 * LP * 4);
  p.Pv = (float*)take((size_t)NSEQ * 2 * 16 * LP * 4);
  p.Atot = (float*)take((size_t)NSEQ * 2 * 16 * NCH * 4);
  p.bar = (unsigned*)take((size_t)XCD_BAR_WORDS * 4);
  if (off > ws_size) { fprintf(stderr, "workspace too small: need %zu have %zu\n", off, ws_size); return; }
  p.z = (bf16_t*)zreg;
  p.xbc_raw = (bf16_t*)r1;
  p.rest = (bf16_t*)r2;
  char* dout = (char*)d_out;
  p.XT = (bf16_t*)dout;
  p.Cm = (bf16_t*)(dout + (size_t)NSEQ * NCH * 16 * 64 * 128 * 2);
  p.Bm = p.Cm + (size_t)NSEQ * LP * 256;
  p.BmT = p.Bm + (size_t)NSEQ * LP * 256;
  p.pre = (bf16_t*)d_out;
  p.Kb = (bf16_t*)dout;
  p.vT = p.Kb + (size_t)TP * 512;
  p.o = p.vT + (size_t)512 * TP;
  p.Y = (bf16_t*)r1;
  p.Yb2 = p.Y + (size_t)TX * 1024;
  p.q = (bf16_t*)r2;
  p.ycat = (bf16_t*)r2;
  p.h1 = p.h0;
  p.Uq = (unsigned char*)zreg;
  p.Vq = p.Uq + (size_t)8 * 16384 * 128;
  p.su = (float*)(p.Vq + (size_t)8 * 16384 * 128);
  p.sv = p.su + 16384;
  p.sx = p.sv + 16384;
  p.h1q = (unsigned char*)(p.sx + (size_t)TX * 8);
  p.pd = (bf16_t*)d_out;
  p.cq = (unsigned char*)r2;
  p.csc = (float*)(r2 + (size_t)8 * 1024 * 1024);
  p.pre2 = (bf16_t*)(r2 + (size_t)16 * 1024 * 1024);
  p.experts = (unsigned short*)(r1 + (size_t)TX * 256 * 4);
  p.gates = (float*)(r1 + (size_t)TX * 256 * 4 + (size_t)TX * 128 * 4);

  static int grid_blocks = 0;
  if (!grid_blocks) {
    int dev = 0, cus = 0, per_cu = 0;
    (void)hipGetDevice(&dev);
    (void)hipDeviceGetAttribute(&cus, hipDeviceAttributeMultiprocessorCount, dev);
    (void)hipFuncSetAttribute((const void*)mega_kernel, hipFuncAttributeMaxDynamicSharedMemorySize, (int)LDS_BYTES);
    (void)hipOccupancyMaxActiveBlocksPerMultiprocessor(&per_cu, mega_kernel, NTHREADS, LDS_BYTES);
    if (per_cu > 1) per_cu = 1;
    grid_blocks = cus * per_cu;
  }
  (void)hipMemsetAsync(p.bar, 0, (size_t)XCD_BAR_WORDS * 4, stream);
  void* args[] = {&p};
  hipError_t e = hipLaunchCooperativeKernel((void*)mega_kernel, dim3(grid_blocks), dim3(NTHREADS), args, LDS_BYTES, stream);
  if (e != hipSuccess) fprintf(stderr, "cooperative launch failed: %s (grid %d)\n", hipGetErrorString(e), grid_blocks);
}
```

```cpp
#include <hip/hip_runtime.h>
#include <hip/hip_cooperative_groups.h>
#include <cstdio>
#include <cstdint>
namespace cg = cooperative_groups;

typedef unsigned short bf16_t;
typedef short bf16x8 __attribute__((ext_vector_type(8)));
typedef float f32x4 __attribute__((ext_vector_type(4)));
typedef float f32x16 __attribute__((ext_vector_type(16)));
typedef unsigned u32x4 __attribute__((ext_vector_type(4)));
typedef unsigned u32x2 __attribute__((ext_vector_type(2)));

#define NTHREADS 512
#define LAS __attribute__((address_space(3)))
constexpr int DM = 1024;
constexpr int NSEQ = 24, SEQ = 2048, NMETA = 16, LSEQ = 2064;
constexpr int TX = NSEQ * SEQ;
constexpr int TM = TX + NMETA;
constexpr int TP = 49408;
constexpr int LP = 2176, NCH = 17, MPAD = 112;
constexpr int DINP = 3328;
constexpr float EPS = 1e-5f;
constexpr float ALPHA = 1.189207115002721f;
constexpr size_t LDS_BYTES = 160 * 1024;

struct Params {
  const float *x_prompt, *x_sample, *meta, *ln_in_g, *ln_in_b, *w_in, *conv_w, *conv_b,
      *dt_bias_f, *dt_bias_b, *a_log_f, *a_log_b, *d_skip, *ssm_norm_g, *q_norm_g, *w_uq, *kv_norm_g, *w_ukv,
      *attn_norm_g, *w_out, *ln1_g, *ln1_b, *peer_wq, *peer_sk, *peer_u, *peer_v, *ln2_g, *ln2_b;
  float* out;
  bf16_t *h0, *WinT, *WuqT, *WkT, *WvT, *WoutT, *WpT, *z, *xbc_raw, *rest, *cqn, *ckvn, *kr;
  float *dtv, *Pv, *Atot;
  bf16_t *XT, *Cm, *Bm, *BmT;
  bf16_t *q, *Kb, *vT, *o, *Y, *Yb2, *ycat, *h1;
  unsigned char *Uq, *Vq;
  unsigned char* h1q;
  float *su, *sv, *sx;
  bf16_t* pd;
  bf16_t* pre2;
  unsigned char* cq;
  float* csc;
  unsigned* bar;
  bf16_t* pre;
  unsigned short* experts;
  float* gates;
};

__device__ __forceinline__ int phase_tid() { int t = threadIdx.x; asm volatile("" : "+v"(t)); return t; }
__device__ __forceinline__ void lds_barrier() {
  asm volatile("s_waitcnt lgkmcnt(0)" ::: "memory");
  __builtin_amdgcn_s_barrier();
  asm volatile("" ::: "memory");
}
__device__ __forceinline__ float bf2f(bf16_t v) { return __uint_as_float(((unsigned)v) << 16); }
__device__ __forceinline__ float bflo(unsigned v) { return __uint_as_float(v << 16); }
__device__ __forceinline__ float bfhi(unsigned v) { return __uint_as_float(v & 0xffff0000u); }
typedef __bf16 bf16x2_t __attribute__((ext_vector_type(2)));
typedef float f32x2_t __attribute__((ext_vector_type(2)));
__device__ __forceinline__ unsigned pk_bf16(float lo, float hi) {
  f32x2_t f = {lo, hi};
  bf16x2_t b = __builtin_convertvector(f, bf16x2_t);
  return __builtin_bit_cast(unsigned, b);
}
__device__ __forceinline__ bf16_t f2bf(float f) { return (bf16_t)(pk_bf16(f, 0.f) & 0xffffu); }
__device__ __forceinline__ float wave_sum(float v) {
#pragma unroll
  for (int o = 32; o >= 1; o >>= 1) v += __shfl_xor(v, o);
  return v;
}
__device__ __forceinline__ void fast_sincos(float ang, float& sn, float& cs) {
  const float r = __builtin_amdgcn_fractf(ang * 0.15915494309189535f);
  sn = __builtin_amdgcn_sinf(r); cs = __builtin_amdgcn_cosf(r);
}
__device__ __forceinline__ float silu_f(float x) { return x * __builtin_amdgcn_rcpf(1.f + __expf(-x)); }
__device__ __forceinline__ int row_of(int seq, int pos) { return pos < NMETA ? TX + pos : seq * SEQ + pos - NMETA; }
__device__ __forceinline__ bf16x8 as_bf16x8(u32x4 v) { return __builtin_bit_cast(bf16x8, v); }

__device__ void transpose_convert(const float* in, bf16_t* out, int R, int C, int CP, char* smem) {
  float* tile = (float*)smem;
  const int tr = (R + 63) / 64, tc = (CP + 63) / 64;
  for (int t = blockIdx.x; t < tr * tc; t += gridDim.x) {
    const int r0 = (t / tc) * 64, c0 = (t % tc) * 64;
    __syncthreads();
    for (int i = phase_tid(); i < 4096; i += NTHREADS) {
      int r = i >> 6, c = i & 63;
      float v = 0.f;
      if (r0 + r < R && c0 + c < C) v = in[(size_t)(r0 + r) * C + c0 + c];
      tile[r * 65 + c] = v;
    }
    __syncthreads();
    for (int i = phase_tid(); i < 4096; i += NTHREADS) {
      int c = i >> 6, r = i & 63;
      if (r0 + r < R && c0 + c < CP) out[(size_t)(c0 + c) * R + r0 + r] = f2bf(tile[r * 65 + c]);
    }
  }
}

__device__ void fold_peer(const Params& p, char* smem) {
  float* wq_s = (float*)smem;
  float* sk_s = wq_s + 32 * 128;
  for (int item = blockIdx.x; item < 16 * 32; item += gridDim.x) {
    const int hj2 = item >> 5, k0 = (item & 31) * 32;
    const int h = hj2 >> 1, j = hj2 & 1;
    const float* skp = p.peer_sk + (size_t)(j * 8 + h) * 128 * 128;
    __syncthreads();
    for (int i = phase_tid(); i < 32 * 128; i += NTHREADS) {
      int k = i >> 7, d = i & 127;
      wq_s[i] = p.peer_wq[(size_t)(k0 + k) * 2048 + hj2 * 128 + d];
    }
    for (int i = phase_tid(); i < 128 * 128; i += NTHREADS) {
      int n = i >> 7, d = i & 127;
      sk_s[n * 129 + d] = skp[i];
    }
    __syncthreads();
    const int n = phase_tid() & 127, kq = phase_tid() >> 7;
    float acc[8];
#pragma unroll
    for (int i = 0; i < 8; ++i) acc[i] = 0.f;
    for (int d = 0; d < 128; ++d) {
      float s = sk_s[n * 129 + d];
#pragma unroll
      for (int i = 0; i < 8; ++i) acc[i] += wq_s[(kq * 8 + i) * 128 + d] * s;
    }
    u32x4 v;
    v[0] = pk_bf16(acc[0], acc[1]); v[1] = pk_bf16(acc[2], acc[3]);
    v[2] = pk_bf16(acc[4], acc[5]); v[3] = pk_bf16(acc[6], acc[7]);
    *(u32x4*)(p.WpT + (size_t)(hj2 * 128 + n) * 1024 + k0 + kq * 8) = v;
  }
}

__device__ void ln_in_phase(const Params& p) {
  const int lane = phase_tid() & 63, wid = phase_tid() >> 6;
  const int stride = gridDim.x * 8;
  auto src_of = [&](int row) -> const float* {
    return row < 8 * SEQ ? p.x_prompt + (size_t)row * DM : row < TX ? p.x_sample + (size_t)(row - 8 * SEQ) * DM : p.meta + (size_t)(row - TX) * DM;
  };
  int row = blockIdx.x * 8 + wid;
  f32x4 nx[4];
  if (row < TM) { const float* sp = src_of(row);
#pragma unroll
    for (int c = 0; c < 4; ++c) nx[c] = *(const f32x4*)(sp + c * 256 + lane * 4); }
  for (; row < TP; row += stride) {
    bf16_t* dst = p.h0 + (size_t)row * DM;
    if (row >= TM) {
      u32x4 zv = {0u, 0u, 0u, 0u};
      *(u32x4*)(dst + lane * 8) = zv; *(u32x4*)(dst + 512 + lane * 8) = zv;
      continue;
    }
    float v[16];
#pragma unroll
    for (int c = 0; c < 4; ++c)
#pragma unroll
      for (int j = 0; j < 4; ++j) v[c * 4 + j] = nx[c][j];
    if (row + stride < TM) { const float* sp = src_of(row + stride);
#pragma unroll
      for (int c = 0; c < 4; ++c) nx[c] = *(const f32x4*)(sp + c * 256 + lane * 4); }
    float s = 0.f;
#pragma unroll
    for (int j = 0; j < 16; ++j) s += v[j];
    const float mu = wave_sum(s) * (1.f / DM);
    float s2 = 0.f;
#pragma unroll
    for (int j = 0; j < 16; ++j) { float d = v[j] - mu; s2 += d * d; }
    const float rstd = rsqrtf(wave_sum(s2) * (1.f / DM) + EPS);
#pragma unroll
    for (int c = 0; c < 4; ++c) {
      const f32x4 g = *(const f32x4*)(p.ln_in_g + c * 256 + lane * 4), bb = *(const f32x4*)(p.ln_in_b + c * 256 + lane * 4);
      float o[4];
#pragma unroll
      for (int j = 0; j < 4; ++j) o[j] = (v[c * 4 + j] - mu) * rstd * g[j] + bb[j];
      *(u32x2*)(dst + c * 256 + lane * 4) = (u32x2){pk_bf16(o[0], o[1]), pk_bf16(o[2], o[3])};
    }
  }
}

__device__ __forceinline__ u32x4 pack8(const float (&v)[8]) {
  u32x4 w;
  w[0] = pk_bf16(v[0], v[1]); w[1] = pk_bf16(v[2], v[3]); w[2] = pk_bf16(v[4], v[5]); w[3] = pk_bf16(v[6], v[7]);
  return w;
}
__device__ __forceinline__ unsigned fkey(float f) {
  unsigned u = __float_as_uint(f);
  return u ^ (((unsigned)((int)u >> 31)) | 0x80000000u);
}
__device__ __forceinline__ float keyf(unsigned k) {
  unsigned u = (k & 0x80000000u) ? (k ^ 0x80000000u) : ~k;
  return __uint_as_float(u);
}
__device__ __forceinline__ void sort16_desc(unsigned (&v)[16]) {
  { unsigned _h = max(v[0], v[13]); v[13] = min(v[0], v[13]); v[0] = _h; }
  { unsigned _h = max(v[1], v[12]); v[12] = min(v[1], v[12]); v[1] = _h; }
  { unsigned _h = max(v[2], v[15]); v[15] = min(v[2], v[15]); v[2] = _h; }
  { unsigned _h = max(v[3], v[14]); v[14] = min(v[3], v[14]); v[3] = _h; }
  { unsigned _h = max(v[4], v[8]); v[8] = min(v[4], v[8]); v[4] = _h; }
  { unsigned _h = max(v[5], v[6]); v[6] = min(v[5], v[6]); v[5] = _h; }
  { unsigned _h = max(v[7], v[11]); v[11] = min(v[7], v[11]); v[7] = _h; }
  { unsigned _h = max(v[9], v[10]); v[10] = min(v[9], v[10]); v[9] = _h; }
  { unsigned _h = max(v[0], v[5]); v[5] = min(v[0], v[5]); v[0] = _h; }
  { unsigned _h = max(v[1], v[7]); v[7] = min(v[1], v[7]); v[1] = _h; }
  { unsigned _h = max(v[2], v[9]); v[9] = min(v[2], v[9]); v[2] = _h; }
  { unsigned _h = max(v[3], v[4]); v[4] = min(v[3], v[4]); v[3] = _h; }
  { unsigned _h = max(v[6], v[13]); v[13] = min(v[6], v[13]); v[6] = _h; }
  { unsigned _h = max(v[8], v[14]); v[14] = min(v[8], v[14]); v[8] = _h; }
  { unsigned _h = max(v[10], v[15]); v[15] = min(v[10], v[15]); v[10] = _h; }
  { unsigned _h = max(v[11], v[12]); v[12] = min(v[11], v[12]); v[11] = _h; }
  { unsigned _h = max(v[0], v[1]); v[1] = min(v[0], v[1]); v[0] = _h; }
  { unsigned _h = max(v[2], v[3]); v[3] = min(v[2], v[3]); v[2] = _h; }
  { unsigned _h = max(v[4], v[5]); v[5] = min(v[4], v[5]); v[4] = _h; }
  { unsigned _h = max(v[6], v[8]); v[8] = min(v[6], v[8]); v[6] = _h; }
  { unsigned _h = max(v[7], v[9]); v[9] = min(v[7], v[9]); v[7] = _h; }
  { unsigned _h = max(v[10], v[11]); v[11] = min(v[10], v[11]); v[10] = _h; }
  { unsigned _h = max(v[12], v[13]); v[13] = min(v[12], v[13]); v[12] = _h; }
  { unsigned _h = max(v[14], v[15]); v[15] = min(v[14], v[15]); v[14] = _h; }
  { unsigned _h = max(v[0], v[2]); v[2] = min(v[0], v[2]); v[0] = _h; }
  { unsigned _h = max(v[1], v[3]); v[3] = min(v[1], v[3]); v[1] = _h; }
  { unsigned _h = max(v[4], v[10]); v[10] = min(v[4], v[10]); v[4] = _h; }
  { unsigned _h = max(v[5], v[11]); v[11] = min(v[5], v[11]); v[5] = _h; }
  { unsigned _h = max(v[6], v[7]); v[7] = min(v[6], v[7]); v[6] = _h; }
  { unsigned _h = max(v[8], v[9]); v[9] = min(v[8], v[9]); v[8] = _h; }
  { unsigned _h = max(v[12], v[14]); v[14] = min(v[12], v[14]); v[12] = _h; }
  { unsigned _h = max(v[13], v[15]); v[15] = min(v[13], v[15]); v[13] = _h; }
  { unsigned _h = max(v[1], v[2]); v[2] = min(v[1], v[2]); v[1] = _h; }
  { unsigned _h = max(v[3], v[12]); v[12] = min(v[3], v[12]); v[3] = _h; }
  { unsigned _h = max(v[4], v[6]); v[6] = min(v[4], v[6]); v[4] = _h; }
  { unsigned _h = max(v[5], v[7]); v[7] = min(v[5], v[7]); v[5] = _h; }
  { unsigned _h = max(v[8], v[10]); v[10] = min(v[8], v[10]); v[8] = _h; }
  { unsigned _h = max(v[9], v[11]); v[11] = min(v[9], v[11]); v[9] = _h; }
  { unsigned _h = max(v[13], v[14]); v[14] = min(v[13], v[14]); v[13] = _h; }
  { unsigned _h = max(v[1], v[4]); v[4] = min(v[1], v[4]); v[1] = _h; }
  { unsigned _h = max(v[2], v[6]); v[6] = min(v[2], v[6]); v[2] = _h; }
  { unsigned _h = max(v[5], v[8]); v[8] = min(v[5], v[8]); v[5] = _h; }
  { unsigned _h = max(v[7], v[10]); v[10] = min(v[7], v[10]); v[7] = _h; }
  { unsigned _h = max(v[9], v[13]); v[13] = min(v[9], v[13]); v[9] = _h; }
  { unsigned _h = max(v[11], v[14]); v[14] = min(v[11], v[14]); v[11] = _h; }
  { unsigned _h = max(v[2], v[4]); v[4] = min(v[2], v[4]); v[2] = _h; }
  { unsigned _h = max(v[3], v[6]); v[6] = min(v[3], v[6]); v[3] = _h; }
  { unsigned _h = max(v[9], v[12]); v[12] = min(v[9], v[12]); v[9] = _h; }
  { unsigned _h = max(v[11], v[13]); v[13] = min(v[11], v[13]); v[11] = _h; }
  { unsigned _h = max(v[3], v[5]); v[5] = min(v[3], v[5]); v[3] = _h; }
  { unsigned _h = max(v[6], v[8]); v[8] = min(v[6], v[8]); v[6] = _h; }
  { unsigned _h = max(v[7], v[9]); v[9] = min(v[7], v[9]); v[7] = _h; }
  { unsigned _h = max(v[10], v[12]); v[12] = min(v[10], v[12]); v[10] = _h; }
  { unsigned _h = max(v[3], v[4]); v[4] = min(v[3], v[4]); v[3] = _h; }
  { unsigned _h = max(v[5], v[6]); v[6] = min(v[5], v[6]); v[5] = _h; }
  { unsigned _h = max(v[7], v[8]); v[8] = min(v[7], v[8]); v[7] = _h; }
  { unsigned _h = max(v[9], v[10]); v[10] = min(v[9], v[10]); v[9] = _h; }
  { unsigned _h = max(v[11], v[12]); v[12] = min(v[11], v[12]); v[11] = _h; }
  { unsigned _h = max(v[6], v[7]); v[7] = min(v[6], v[7]); v[6] = _h; }
  { unsigned _h = max(v[8], v[9]); v[9] = min(v[8], v[9]); v[8] = _h; }
}
__device__ __forceinline__ void merge16_desc(unsigned (&v)[16], const unsigned (&o)[16]) {
  v[0] = max(v[0], o[15]);
  v[1] = max(v[1], o[14]);
  v[2] = max(v[2], o[13]);
  v[3] = max(v[3], o[12]);
  v[4] = max(v[4], o[11]);
  v[5] = max(v[5], o[10]);
  v[6] = max(v[6], o[9]);
  v[7] = max(v[7], o[8]);
  v[8] = max(v[8], o[7]);
  v[9] = max(v[9], o[6]);
  v[10] = max(v[10], o[5]);
  v[11] = max(v[11], o[4]);
  v[12] = max(v[12], o[3]);
  v[13] = max(v[13], o[2]);
  v[14] = max(v[14], o[1]);
  v[15] = max(v[15], o[0]);
  { unsigned _h = max(v[0], v[8]); v[8] = min(v[0], v[8]); v[0] = _h; }
  { unsigned _h = max(v[1], v[9]); v[9] = min(v[1], v[9]); v[1] = _h; }
  { unsigned _h = max(v[2], v[10]); v[10] = min(v[2], v[10]); v[2] = _h; }
  { unsigned _h = max(v[3], v[11]); v[11] = min(v[3], v[11]); v[3] = _h; }
  { unsigned _h = max(v[4], v[12]); v[12] = min(v[4], v[12]); v[4] = _h; }
  { unsigned _h = max(v[5], v[13]); v[13] = min(v[5], v[13]); v[5] = _h; }
  { unsigned _h = max(v[6], v[14]); v[14] = min(v[6], v[14]); v[6] = _h; }
  { unsigned _h = max(v[7], v[15]); v[15] = min(v[7], v[15]); v[7] = _h; }
  { unsigned _h = max(v[0], v[4]); v[4] = min(v[0], v[4]); v[0] = _h; }
  { unsigned _h = max(v[1], v[5]); v[5] = min(v[1], v[5]); v[1] = _h; }
  { unsigned _h = max(v[2], v[6]); v[6] = min(v[2], v[6]); v[2] = _h; }
  { unsigned _h = max(v[3], v[7]); v[7] = min(v[3], v[7]); v[3] = _h; }
  { unsigned _h = max(v[8], v[12]); v[12] = min(v[8], v[12]); v[8] = _h; }
  { unsigned _h = max(v[9], v[13]); v[13] = min(v[9], v[13]); v[9] = _h; }
  { unsigned _h = max(v[10], v[14]); v[14] = min(v[10], v[14]); v[10] = _h; }
  { unsigned _h = max(v[11], v[15]); v[15] = min(v[11], v[15]); v[11] = _h; }
  { unsigned _h = max(v[0], v[2]); v[2] = min(v[0], v[2]); v[0] = _h; }
  { unsigned _h = max(v[1], v[3]); v[3] = min(v[1], v[3]); v[1] = _h; }
  { unsigned _h = max(v[4], v[6]); v[6] = min(v[4], v[6]); v[4] = _h; }
  { unsigned _h = max(v[5], v[7]); v[7] = min(v[5], v[7]); v[5] = _h; }
  { unsigned _h = max(v[8], v[10]); v[10] = min(v[8], v[10]); v[8] = _h; }
  { unsigned _h = max(v[9], v[11]); v[11] = min(v[9], v[11]); v[9] = _h; }
  { unsigned _h = max(v[12], v[14]); v[14] = min(v[12], v[14]); v[12] = _h; }
  { unsigned _h = max(v[13], v[15]); v[15] = min(v[13], v[15]); v[13] = _h; }
  { unsigned _h = max(v[0], v[1]); v[1] = min(v[0], v[1]); v[0] = _h; }
  { unsigned _h = max(v[2], v[3]); v[3] = min(v[2], v[3]); v[2] = _h; }
  { unsigned _h = max(v[4], v[5]); v[5] = min(v[4], v[5]); v[4] = _h; }
  { unsigned _h = max(v[6], v[7]); v[7] = min(v[6], v[7]); v[6] = _h; }
  { unsigned _h = max(v[8], v[9]); v[9] = min(v[8], v[9]); v[8] = _h; }
  { unsigned _h = max(v[10], v[11]); v[11] = min(v[10], v[11]); v[10] = _h; }
  { unsigned _h = max(v[12], v[13]); v[13] = min(v[12], v[13]); v[12] = _h; }
  { unsigned _h = max(v[14], v[15]); v[15] = min(v[14], v[15]); v[14] = _h; }
}
#define TOPK_INSERT_FROM(V, X, J0) { _Pragma("unroll") for (int _j = (J0); _j < 16; ++_j) { unsigned _hi = max(V[_j], X); X = min(V[_j], X); V[_j] = _hi; } }
#define TOPK_INSERT(V, X) { _Pragma("unroll") for (int _j = 0; _j < 16; ++_j) { unsigned _hi = max(V[_j], X); X = min(V[_j], X); V[_j] = _hi; } }

namespace pg8 {
constexpr int BM = 256, BK = 64, HALF = 128, HTB = HALF * BK * 2, STAGE_BYTES = 8 * HTB, NXCD = 8, WGM = 8;
__device__ __forceinline__ int lds_byte(int r, int c) { const int st = (r >> 4) * 2 + (c >> 5), rr = r & 15, cc = c & 31, ob = rr * 64 + cc * 2; return st * 1024 + (ob ^ (((ob >> 9) & 1) << 5)); }
__device__ __forceinline__ void stage_rc(int b, int& R, int& C) { const int st = b / 1024, sb = b % 1024, swz = sb ^ (((sb >> 9) & 1) << 5); R = (st >> 1) * 16 + swz / 64; C = (st & 1) * 32 + (swz % 64) / 2; }
__device__ __forceinline__ int perm32(int rho) { const int n = rho >> 4, i = rho & 15; return 8 * (i >> 2) + 4 * n + (i & 3); }
struct Unit { int pm, pn; };
struct Gemm { const bf16_t* A; const bf16_t* Bt; int M, N, K; };
struct StaticOrder {
  int nM, nN, nwg, G, c;
  __device__ void init(int M, int N, int G_, int c_) { nM = M / BM; nN = N / BM; nwg = nM * nN; G = G_; c = c_; }
  __device__ bool next(int i, Unit& u) const {
    const long L = (long)i * G + c; if (L >= nwg) return false;
    int wgid = (int)L; { const int q = nwg / NXCD, r = nwg % NXCD, xcd = wgid % NXCD, off = wgid / NXCD; wgid = (xcd < r ? xcd * (q + 1) : r * (q + 1) + (xcd - r) * q) + off; }
    const int nig = WGM * nN, gid = wgid / nig, fm = gid * WGM, gsz = (nM - fm) < WGM ? (nM - fm) : WGM;
    u.pm = fm + ((wgid % nig) % gsz); u.pn = (wgid % nig) / gsz; return true;
  }
  __device__ __forceinline__ void a_ready(const Unit&) const {}
  __device__ __forceinline__ void done(const Unit&) const {}
};
template <class Epi, class Sched>
__device__ __forceinline__ void gemm_phase(LAS unsigned char* lds, const Gemm g, const Sched& S, const Epi& E) {
  const int tid = phase_tid(), wid = __builtin_amdgcn_readfirstlane(tid >> 6), lane = tid & 63, wr = wid >> 2, wc = wid & 3, fr = lane & 15, fq = lane >> 4;
  const int K = g.K, nt = K / BK;
  unsigned voffA[2], voffB[2];
#pragma unroll
  for (int i = 0; i < 2; ++i) { int R, C; stage_rc(tid * 16 + i * 8192, R, C); const int Rb = Epi::PERM ? ((R & ~31) + perm32(R & 31)) : R;
    voffA[i] = (unsigned)(R * K + C) * 2u; voffB[i] = (unsigned)(Rb * K + C) * 2u; }
  const size_t kstep = (size_t)(BK * 2);
  const size_t hstep = (size_t)HALF * K * 2;
  const size_t tstep = 2 * hstep;
  const unsigned ldsw = (unsigned)wid * 1024u;
  const int aoff = lds_byte(wr * 64 + fr, fq * 8), boff = lds_byte(wc * 32 + fr, fq * 8);
#define PG8_SA(b, h) (((b) * 2 + (h)) * HTB)
#define PG8_SB(b, h) ((4 + (b) * 2 + (h)) * HTB)
#define PG8_STAGE(bufoff, gbase, voff) do { _Pragma("unroll") for (int _i = 0; _i < 2; ++_i) \
    __builtin_amdgcn_global_load_lds((const unsigned*)((const char*)(gbase) + (voff)[_i]), (LAS unsigned*)(lds + (bufoff) + ldsw + _i * 8192), 16, 0, 0); } while (0)
#define PG8_LDA(dst, b, h) do { _Pragma("unroll") for (int m = 0; m < 4; ++m) _Pragma("unroll") for (int k = 0; k < 2; ++k) dst[m][k] = *(const LAS bf16x8*)(lds + PG8_SA(b, h) + aoff + m * 2048 + k * 1024); } while (0)
#define PG8_LDB(dst, b, h) do { _Pragma("unroll") for (int n = 0; n < 2; ++n) _Pragma("unroll") for (int k = 0; k < 2; ++k) dst[n][k] = *(const LAS bf16x8*)(lds + PG8_SB(b, h) + boff + n * 2048 + k * 1024); } while (0)
#define PG8_MMA(ai, bj, At, Bt) do { __builtin_amdgcn_s_setprio(1); _Pragma("unroll") for (int m = 0; m < 4; ++m) _Pragma("unroll") for (int n = 0; n < 2; ++n) _Pragma("unroll") for (int k = 0; k < 2; ++k) \
    acc[ai][bj][m][n] = __builtin_amdgcn_mfma_f32_16x16x32_bf16(Bt[n][k], At[m][k], acc[ai][bj][m][n], 0, 0, 0); __builtin_amdgcn_s_setprio(0); } while (0)
#define PG8_WAIT_V(n) asm volatile("s_waitcnt vmcnt(" #n ")" ::: "memory")
#define PG8_WAIT_L(n) asm volatile("s_waitcnt lgkmcnt(" #n ")" ::: "memory")
#define PG8_BAR __builtin_amdgcn_s_barrier()
#define PG8_SCHED __builtin_amdgcn_sched_barrier(0)
  Unit cur, nxt; int ui = 0;
  if (!S.next(0, cur)) return;
  f32x4 acc[2][2][4][2];
#pragma unroll
  for (int a = 0; a < 2; ++a)
#pragma unroll
    for (int b = 0; b < 2; ++b)
#pragma unroll
      for (int m = 0; m < 4; ++m)
#pragma unroll
        for (int n = 0; n < 2; ++n) acc[a][b][m][n] = (f32x4){0.f, 0.f, 0.f, 0.f};
  bf16x8 At[4][2], B0[2][2], B1[2][2];
  const char* cA = (const char*)g.A + (size_t)cur.pm * tstep; const char* cB = (const char*)g.Bt + (size_t)cur.pn * tstep;
  S.a_ready(cur);
  PG8_STAGE(PG8_SB(0, 0), cB, voffB); PG8_STAGE(PG8_SA(0, 0), cA, voffA); PG8_STAGE(PG8_SB(0, 1), cB + hstep, voffB); PG8_STAGE(PG8_SA(0, 1), cA + hstep, voffA);
  if (wr == 1) PG8_BAR;
  PG8_WAIT_V(4); PG8_BAR;
  PG8_STAGE(PG8_SB(1, 0), cB + kstep, voffB); PG8_STAGE(PG8_SA(1, 0), cA + kstep, voffA); PG8_STAGE(PG8_SB(1, 1), cB + hstep + kstep, voffB);
  PG8_WAIT_V(6); PG8_BAR;
  for (;;) {
    const bool has_next = S.next(ui + 1, nxt);
    const char* nA = has_next ? (const char*)g.A + (size_t)nxt.pm * tstep : cA; const char* nB = has_next ? (const char*)g.Bt + (size_t)nxt.pn * tstep : cB;
    for (int t = 0; t < nt; t += 2) {
      const bool last = (t == nt - 2);
      const char* a1 = cA + (size_t)(t + 1) * kstep;
      const char* a2 = last ? nA : cA + (size_t)(t + 2) * kstep; const char* b2 = last ? nB : cB + (size_t)(t + 2) * kstep;
      const char* a3 = a2 + kstep; const char* b3 = b2 + kstep;
      if (last && has_next) S.a_ready(nxt);
      PG8_LDB(B0, 0, 0); PG8_SCHED; PG8_LDA(At, 0, 0); PG8_STAGE(PG8_SA(1, 1), a1 + hstep, voffA);
      PG8_WAIT_L(8); PG8_BAR; PG8_WAIT_L(0); PG8_MMA(0, 0, At, B0); PG8_BAR; PG8_SCHED;
      PG8_LDB(B1, 0, 1); PG8_STAGE(PG8_SB(0, 0), b2, voffB);
      PG8_BAR; PG8_WAIT_L(0); PG8_MMA(0, 1, At, B1); PG8_BAR;
      PG8_LDA(At, 0, 1); PG8_STAGE(PG8_SA(0, 0), a2, voffA);
      PG8_BAR; PG8_WAIT_L(0); PG8_MMA(1, 0, At, B0); PG8_BAR; PG8_SCHED;
      PG8_STAGE(PG8_SB(0, 1), b2 + hstep, voffB);
      PG8_WAIT_V(6); PG8_BAR; PG8_MMA(1, 1, At, B1); PG8_BAR;
      PG8_LDB(B0, 1, 0); PG8_SCHED; PG8_LDA(At, 1, 0); PG8_STAGE(PG8_SA(0, 1), a2 + hstep, voffA);
      PG8_WAIT_L(8); PG8_BAR; PG8_WAIT_L(0); PG8_MMA(0, 0, At, B0); PG8_BAR; PG8_SCHED;
      PG8_LDB(B1, 1, 1); PG8_STAGE(PG8_SB(1, 0), b3, voffB);
      PG8_BAR; PG8_WAIT_L(0); PG8_MMA(0, 1, At, B1); PG8_BAR;
      PG8_LDA(At, 1, 1); PG8_STAGE(PG8_SA(1, 0), a3, voffA);
      PG8_BAR; PG8_WAIT_L(0); PG8_MMA(1, 0, At, B0); PG8_BAR; PG8_SCHED;
      PG8_STAGE(PG8_SB(1, 1), b3 + hstep, voffB);
      PG8_WAIT_V(6); PG8_BAR; PG8_MMA(1, 1, At, B1); PG8_BAR;
    }
    if constexpr (!Epi::AFTER_DRAIN) { E(acc, cur, wr, wc, fr, fq); S.done(cur); }
    if (!has_next) break;
#pragma unroll
    for (int a = 0; a < 2; ++a)
#pragma unroll
      for (int b = 0; b < 2; ++b)
#pragma unroll
        for (int m = 0; m < 4; ++m)
#pragma unroll
          for (int n = 0; n < 2; ++n) acc[a][b][m][n] = (f32x4){0.f, 0.f, 0.f, 0.f};
    cur = nxt; cA = nA; cB = nB; ++ui;
  }
  PG8_WAIT_V(0);
  if (wr == 0) PG8_BAR;
  PG8_BAR;
  if constexpr (Epi::AFTER_DRAIN) { E.fused(acc, cur, wr, wc, fr, fq, (char*)lds); S.done(cur); }
#undef PG8_SA
#undef PG8_SB
#undef PG8_STAGE
#undef PG8_LDA
#undef PG8_LDB
#undef PG8_MMA
#undef PG8_WAIT_V
#undef PG8_WAIT_L
#undef PG8_BAR
#undef PG8_SCHED
}
struct EpiBf16S {
  static constexpr bool PERM = true, AFTER_DRAIN = false;
  bf16_t* d0; int ld0; int c0; bf16_t* d1; int ld1; int c1; bf16_t* d2; int ld2;
  __device__ __forceinline__ void operator()(const f32x4 (&acc)[2][2][4][2], const Unit& u, int wr, int wc, int fr, int fq) const {
    const int colt = u.pn * BM;
    bf16_t* base; int ld;
    if (colt < c0) { base = d0 + colt; ld = ld0; } else if (colt < c1) { base = d1 + (colt - c0); ld = ld1; } else { base = d2 + (colt - c1); ld = ld2; }
    const int L = fq * 16 + fr;
    const int srcl = ((L & 3) * 16 + (L >> 2)) * 4;
    const int row0 = u.pm * BM + wr * 64 + (L >> 2), col0 = wc * 32 + 8 * (L & 3);
#pragma unroll
    for (int ai = 0; ai < 2; ++ai)
#pragma unroll
      for (int m = 0; m < 4; ++m) {
        bf16_t* rowp = base + (size_t)(row0 + ai * HALF + m * 16) * ld + col0;
#pragma unroll
        for (int bj = 0; bj < 2; ++bj) {
          const f32x4 v0 = acc[ai][bj][m][0], v1 = acc[ai][bj][m][1];
          u32x4 w; w[0] = pk_bf16(v0[0], v0[1]); w[1] = pk_bf16(v0[2], v0[3]); w[2] = pk_bf16(v1[0], v1[1]); w[3] = pk_bf16(v1[2], v1[3]);
          u32x4 x;
#pragma unroll
          for (int k = 0; k < 4; ++k) x[k] = (unsigned)__builtin_amdgcn_ds_bpermute(srcl, (int)w[k]);
          *(u32x4*)(rowp + bj * HALF) = x;
        }
      }
  }
};
struct EpiOutRes {
  static constexpr bool PERM = true, AFTER_DRAIN = false;
  bf16_t* pre; const bf16_t* h0;
  __device__ __forceinline__ void operator()(const f32x4 (&acc)[2][2][4][2], const Unit& u, int wr, int wc, int fr, int fq) const {
    const int row0 = u.pm * BM + wr * 64 + fr, col0 = u.pn * BM + wc * 32 + 8 * fq;
#pragma unroll
    for (int ai = 0; ai < 2; ++ai)
#pragma unroll
      for (int m = 0; m < 4; ++m) {
        const size_t off = (size_t)(row0 + ai * HALF + m * 16) * 1024 + col0;
#pragma unroll
        for (int bj = 0; bj < 2; ++bj) {
          const size_t o = off + bj * HALF;
          const u32x4 h = *(const u32x4*)(h0 + o);
          const f32x4 v0 = acc[ai][bj][m][0], v1 = acc[ai][bj][m][1];
          u32x4 w;
          w[0] = pk_bf16(v0[0] + ALPHA * bflo(h[0]), v0[1] + ALPHA * bfhi(h[0]));
          w[1] = pk_bf16(v0[2] + ALPHA * bflo(h[1]), v0[3] + ALPHA * bfhi(h[1]));
          w[2] = pk_bf16(v1[0] + ALPHA * bflo(h[2]), v1[1] + ALPHA * bfhi(h[2]));
          w[3] = pk_bf16(v1[2] + ALPHA * bflo(h[3]), v1[3] + ALPHA * bfhi(h[3]));
          *(u32x4*)(pre + o) = w;
        }
      }
  }
};
struct OneUnit {
  Unit u;
  __device__ bool next(int i, Unit& o) const { if (i) return false; o = u; return true; }
  __device__ __forceinline__ void a_ready(const Unit&) const {}
  __device__ __forceinline__ void done(const Unit&) const {}
};
struct EpiPeerScore {
  static constexpr bool PERM = false, AFTER_DRAIN = true;
  unsigned short* experts; float* gates;
  static constexpr int LDC = 260;
  __device__ void fused(const f32x4 (&acc)[2][2][4][2], const Unit& u, int wr, int wc, int fr, int fq, char* smem) const {
    float* Ct = (float*)smem;
    unsigned char* ibase = (unsigned char*)smem + 128 * LDC * 4;
    const int tid = phase_tid();
    const int row = tid >> 2, j = (tid >> 1) & 1, half = tid & 1;
#pragma unroll
    for (int ai = 0; ai < 2; ++ai) {
#pragma unroll
      for (int bj = 0; bj < 2; ++bj)
#pragma unroll
        for (int m = 0; m < 4; ++m)
#pragma unroll
          for (int n = 0; n < 2; ++n)
            *(f32x4*)(Ct + (wr * 64 + m * 16 + fr) * LDC + bj * 128 + wc * 32 + n * 16 + 4 * fq) = acc[ai][bj][m][n];
      lds_barrier();
      unsigned v[16];
      const float* rowp = Ct + row * LDC + j * 128 + half * 64;
#pragma unroll
      for (int grp = 0; grp < 4; ++grp) {
        unsigned o[16];
#pragma unroll
        for (int c4 = 0; c4 < 4; ++c4) {
          f32x4 sv = *(const f32x4*)(rowp + grp * 16 + c4 * 4);
#pragma unroll
          for (int k = 0; k < 4; ++k) o[c4 * 4 + k] = (fkey(sv[k]) & ~127u) | (unsigned)(127 - (half * 64 + grp * 16 + c4 * 4 + k));
        }
        sort16_desc(o);
        if (grp == 0) {
#pragma unroll
          for (int k = 0; k < 16; ++k) v[k] = o[k];
        } else merge16_desc(v, o);
      }
      {
        unsigned o[16];
#pragma unroll
        for (int k = 0; k < 16; ++k) o[k] = __shfl_xor(v[k], 1);
        merge16_desc(v, o);
      }
      unsigned w[16];
#pragma unroll
      for (int k = 0; k < 16; ++k) w[k] = __shfl_xor(v[k], 2);
      unsigned v0[16], v1[16];
#pragma unroll
      for (int k = 0; k < 16; ++k) { unsigned a0 = v[k], b0 = w[k]; asm volatile("" : "+v"(a0), "+v"(b0)); v0[k] = j ? b0 : a0; v1[k] = j ? a0 : b0; }
      unsigned char* ib = ibase + row * 32;
      if ((tid & 3) == 0) {
#pragma unroll
        for (int q4 = 0; q4 < 4; ++q4) {
          unsigned x0 = 0u, x1 = 0u;
#pragma unroll
          for (int k = 0; k < 4; ++k) { x0 |= (127u - (v0[q4 * 4 + k] & 127u)) << (8 * k); x1 |= (127u - (v1[q4 * 4 + k] & 127u)) << (8 * k); }
          ((unsigned*)ib)[q4] = x0; ((unsigned*)ib)[4 + q4] = x1;
        }
      }
      float f1[16], f2[16];
#pragma unroll
      for (int k = 0; k < 16; ++k) { f1[k] = keyf(v0[k] & ~127u); f2[k] = keyf(v1[k] & ~127u); }
      unsigned c[16];
      {
        const int qd_ = tid & 3;
        const bool q1 = qd_ == 1, q2 = qd_ == 2, q3 = qd_ == 3;
        { const float xa = f1[0], xb = (q3 ? f2[3] : (q2 ? f2[2] : (q1 ? f2[1] : f2[0]))); const unsigned tg = (q3 ? 252u : (q2 ? 253u : (q1 ? 254u : 255u))); c[0] = (fkey(xa + xb) & ~255u) | tg; }
        { const float xa = f1[0], xb = (q3 ? f2[7] : (q2 ? f2[6] : (q1 ? f2[5] : f2[4]))); const unsigned tg = (q3 ? 248u : (q2 ? 249u : (q1 ? 250u : 251u))); c[1] = (fkey(xa + xb) & ~255u) | tg; }
        { const float xa = f1[0], xb = (q3 ? f2[11] : (q2 ? f2[10] : (q1 ? f2[9] : f2[8]))); const unsigned tg = (q3 ? 244u : (q2 ? 245u : (q1 ? 246u : 247u))); c[2] = (fkey(xa + xb) & ~255u) | tg; }
        { const float xa = f1[0], xb = (q3 ? f2[15] : (q2 ? f2[14] : (q1 ? f2[13] : f2[12]))); const unsigned tg = (q3 ? 240u : (q2 ? 241u : (q1 ? 242u : 243u))); c[3] = (fkey(xa + xb) & ~255u) | tg; }
        { const float xa = f1[1], xb = (q3 ? f2[3] : (q2 ? f2[2] : (q1 ? f2[1] : f2[0]))); const unsigned tg = (q3 ? 236u : (q2 ? 237u : (q1 ? 238u : 239u))); c[4] = (fkey(xa + xb) & ~255u) | tg; }
        { const float xa = f1[1], xb = (q3 ? f2[7] : (q2 ? f2[6] : (q1 ? f2[5] : f2[4]))); const unsigned tg = (q3 ? 232u : (q2 ? 233u : (q1 ? 234u : 235u))); c[5] = (fkey(xa + xb) & ~255u) | tg; }
        { const float xa = f1[2], xb = (q3 ? f2[3] : (q2 ? f2[2] : (q1 ? f2[1] : f2[0]))); const unsigned tg = (q3 ? 220u : (q2 ? 221u : (q1 ? 222u : 223u))); c[6] = (fkey(xa + xb) & ~255u) | tg; }
        { const float xa = (q3 ? f1[3] : (q2 ? f1[3] : (q1 ? f1[3] : f1[2]))), xb = (q3 ? f2[2] : (q2 ? f2[1] : (q1 ? f2[0] : f2[4]))); const unsigned tg = (q3 ? 205u : (q2 ? 206u : (q1 ? 207u : 219u))); c[7] = (fkey(xa + xb) & ~255u) | tg; }
        { const float xa = (q3 ? f1[4] : (q2 ? f1[4] : (q1 ? f1[4] : f1[3]))), xb = (q3 ? f2[2] : (q2 ? f2[1] : (q1 ? f2[0] : f2[3]))); const unsigned tg = (q3 ? 189u : (q2 ? 190u : (q1 ? 191u : 204u))); c[8] = (fkey(xa + xb) & ~255u) | tg; }
        { const float xa = (q3 ? f1[6] : (q2 ? f1[6] : f1[5])), xb = (q3 ? f2[1] : (q2 ? f2[0] : (q1 ? f2[1] : f2[0]))); const unsigned tg = (q3 ? 158u : (q2 ? 159u : (q1 ? 174u : 175u))); c[9] = (fkey(xa + xb) & ~255u) | tg; }
        { const float xa = (q3 ? f1[9] : (q2 ? f1[8] : f1[7])), xb = (q3 ? f2[0] : (q2 ? f2[0] : (q1 ? f2[1] : f2[0]))); const unsigned tg = (q3 ? 111u : (q2 ? 127u : (q1 ? 142u : 143u))); c[10] = (fkey(xa + xb) & ~255u) | tg; }
        { const float xa = (q3 ? f1[13] : (q2 ? f1[12] : (q1 ? f1[11] : f1[10]))), xb = f2[0]; const unsigned tg = (q3 ? 47u : (q2 ? 63u : (q1 ? 79u : 95u))); c[11] = (fkey(xa + xb) & ~255u) | tg; }
        { const float xa = (q3 ? -3.0e38f : (q2 ? -3.0e38f : (q1 ? f1[15] : f1[14]))), xb = (q3 ? 0.f : (q2 ? 0.f : f2[0])); const unsigned tg = (q3 ? 0u : (q2 ? 0u : (q1 ? 15u : 31u))); c[12] = (fkey(xa + xb) & ~255u) | tg; }
        c[13] = 0u; c[14] = 0u; c[15] = 0u;
        sort16_desc(c);
        unsigned o[16];
#pragma unroll
        for (int k = 0; k < 16; ++k) o[k] = __shfl_xor(c[k], 1);
        merge16_desc(c, o);
#pragma unroll
        for (int k = 0; k < 16; ++k) o[k] = __shfl_xor(c[k], 2);
        merge16_desc(c, o);
      }
      float e[16];
      const float mx = keyf(c[0] & ~255u);
      float sum = 0.f;
#pragma unroll
      for (int k = 0; k < 16; ++k) { e[k] = __expf(keyf(c[k] & ~255u) - mx); sum += e[k]; }
      const float inv = 1.f / sum;
      asm volatile("s_waitcnt lgkmcnt(0)" ::: "memory");
      const int qd = tid & 3;
      const size_t idx = ((size_t)(u.pm * BM + ai * HALF + row) * 8 + u.pn) * 16 + qd * 4;
      unsigned ew[2]; float gt[4];
#pragma unroll
      for (int k = 0; k < 4; ++k) {
        unsigned k0 = c[k], k1 = c[4 + k], k2 = c[8 + k], k3 = c[12 + k]; float e0 = e[k], e1 = e[4 + k], e2 = e[8 + k], e3 = e[12 + k];
        asm volatile("" : "+v"(k0), "+v"(k1), "+v"(k2), "+v"(k3), "+v"(e0), "+v"(e1), "+v"(e2), "+v"(e3));
        const unsigned key = qd == 0 ? k0 : qd == 1 ? k1 : qd == 2 ? k2 : k3;
        const float ev = qd == 0 ? e0 : qd == 1 ? e1 : qd == 2 ? e2 : e3;
        const unsigned ab = 255u - (key & 255u);
        const unsigned ex = (unsigned)ib[ab >> 4] * 128u + (unsigned)ib[16 + (ab & 15)];
        if (k & 1) ew[k >> 1] |= ex << 16; else ew[k >> 1] = ex;
        gt[k] = ev * inv;
      }
      *(u32x2*)(experts + idx) = (u32x2){ew[0], ew[1]};
      *(f32x4*)(gates + idx) = (f32x4){gt[0], gt[1], gt[2], gt[3]};
      lds_barrier();
    }
  }
};
template <class Epi>
__device__ __forceinline__ void run_drained(char* smem, const bf16_t* A, const bf16_t* Bt, int M, int N, int K, const Epi& E) {
  StaticOrder S; S.init(M, N, gridDim.x, blockIdx.x);
  for (int i = 0;; ++i) {
    Unit u; if (!S.next(i, u)) break;
    gemm_phase((LAS unsigned char*)smem, Gemm{A, Bt, M, N, K}, OneUnit{u}, E);
  }
}
template <class Epi>
__device__ __forceinline__ void run(char* smem, const bf16_t* A, const bf16_t* Bt, int M, int N, int K, const Epi& E) {
  StaticOrder S; S.init(M, N, gridDim.x, blockIdx.x);
  gemm_phase((LAS unsigned char*)smem, Gemm{A, Bt, M, N, K}, S, E);
}
}

__device__ void conv_phase(const Params& p, char* smem) {
  bf16_t* raw = (bf16_t*)smem;
  const int tid = phase_tid();
  u32x4 rr_[3];
  auto gload = [&](int item) {
    const int cb = item % 24, c = (item / 24) % NCH, seq = item / (24 * NCH);
#pragma unroll
    for (int j = 0; j < 3; ++j) {
      const int i = tid + j * NTHREADS;
      const int rr = i >> 3, k8 = i & 7;
      const int pos = c * 128 - 2 + rr - MPAD;
      u32x4 v = {0u, 0u, 0u, 0u};
      if (i < 132 * 8 && pos >= 0 && pos < LSEQ) v = *(const u32x4*)(p.xbc_raw + (size_t)row_of(seq, pos) * 1536 + cb * 64 + k8 * 8);
      rr_[j] = v;
    }
  };
  if ((int)blockIdx.x < NSEQ * NCH * 24) gload(blockIdx.x);
  for (int item = blockIdx.x; item < NSEQ * NCH * 24; item += gridDim.x) {
    const int cb = item % 24, c = (item / 24) % NCH, seq = item / (24 * NCH);
    __syncthreads();
#pragma unroll
    for (int j = 0; j < 3; ++j) {
      const int i = tid + j * NTHREADS;
      if (i < 132 * 8) *(u32x4*)(raw + (i >> 3) * 64 + (i & 7) * 8) = rr_[j];
    }
    __syncthreads();
    if (item + (int)gridDim.x < NSEQ * NCH * 24) gload(item + gridDim.x);
    const int ch = tid & 63, l0 = (tid >> 6) * 16;
    const int gch = cb * 64 + ch;
    float w[5];
#pragma unroll
    for (int k = 0; k < 5; ++k) w[k] = p.conv_w[k * 1536 + gch];
    const float bias = p.conv_b[gch];
    float win[20];
#pragma unroll
    for (int i = 0; i < 20; ++i) win[i] = bf2f(raw[(l0 + i) * 64 + ch]);
    float o[16];
#pragma unroll
    for (int i = 0; i < 16; ++i) {
      float a = bias;
#pragma unroll
      for (int k = 0; k < 5; ++k) a += w[k] * win[i + k];
      int pos = c * 128 + l0 + i - MPAD;
      o[i] = (pos >= 0 && pos < LSEQ) ? silu_f(a) : 0.f;
    }
    u32x4 lo, hi;
    lo[0] = pk_bf16(o[0], o[1]); lo[1] = pk_bf16(o[2], o[3]); lo[2] = pk_bf16(o[4], o[5]); lo[3] = pk_bf16(o[6], o[7]);
    hi[0] = pk_bf16(o[8], o[9]); hi[1] = pk_bf16(o[10], o[11]); hi[2] = pk_bf16(o[12], o[13]); hi[3] = pk_bf16(o[14], o[15]);
    if (cb < 16) {
      bf16_t* d = p.XT + ((((size_t)seq * NCH + c) * 16 + cb) * 64 + ch) * 128 + l0;
      *(u32x4*)d = lo; *(u32x4*)(d + 8) = hi;
    } else if (cb < 20) {
      const int g = (cb - 16) >> 1, n = ((cb - 16) & 1) * 64 + ch;
      bf16_t* d = p.BmT + ((((size_t)seq * NCH + c) * 2 + g) * 128 + n) * 128 + l0;
      *(u32x4*)d = lo; *(u32x4*)(d + 8) = hi;
      bf16_t* d2 = p.Bm + ((size_t)seq * LP + c * 128 + l0) * 256 + g * 128 + n;
#pragma unroll
      for (int i = 0; i < 16; ++i) d2[(size_t)i * 256] = f2bf(o[i]);
    } else {
      const int g = (cb - 20) >> 1, n = ((cb - 20) & 1) * 64 + ch;
      bf16_t* d2 = p.Cm + ((size_t)seq * LP + c * 128 + l0) * 256 + g * 128 + n;
#pragma unroll
      for (int i = 0; i < 16; ++i) d2[(size_t)i * 256] = f2bf(o[i]);
    }
  }
}

__device__ void token_phase(const Params& p) {
  const int lane = phase_tid() & 63, wid = phase_tid() >> 6;
  for (int row = blockIdx.x * 8 + wid; row < TP; row += gridDim.x * 8) {
    if (row >= TM) {
      unsigned* dq = (unsigned*)(p.cqn + (size_t)row * 384) + lane * 3;
      dq[0] = 0u; dq[1] = 0u; dq[2] = 0u;
      *(u32x2*)(p.ckvn + (size_t)row * 256 + lane * 4) = (u32x2){0u, 0u};
      continue;
    }
    const bf16_t* src = p.rest + (size_t)row * 768;
    {
      const unsigned* s = (const unsigned*)(src + 32) + lane * 3;
      unsigned a0 = s[0], a1 = s[1], a2 = s[2];
      float v[6] = {bflo(a0), bfhi(a0), bflo(a1), bfhi(a1), bflo(a2), bfhi(a2)};
      float ss = 0.f;
#pragma unroll
      for (int j = 0; j < 6; ++j) ss += v[j] * v[j];
      const float r = rsqrtf(wave_sum(ss) * (1.f / 384.f) + EPS);
      const float* g = p.q_norm_g + lane * 6;
      unsigned* d = (unsigned*)(p.cqn + (size_t)row * 384) + lane * 3;
      d[0] = pk_bf16(v[0] * r * g[0], v[1] * r * g[1]);
      d[1] = pk_bf16(v[2] * r * g[2], v[3] * r * g[3]);
      d[2] = pk_bf16(v[4] * r * g[4], v[5] * r * g[5]);
    }
    {
      u32x2 a = *(const u32x2*)(src + 416 + lane * 4);
      float v[4] = {bflo(a[0]), bfhi(a[0]), bflo(a[1]), bfhi(a[1])};
      float ss = v[0] * v[0] + v[1] * v[1] + v[2] * v[2] + v[3] * v[3];
      const float r = rsqrtf(wave_sum(ss) * (1.f / 256.f) + EPS);
      const float* g = p.kv_norm_g + lane * 4;
      u32x2 w;
      w[0] = pk_bf16(v[0] * r * g[0], v[1] * r * g[1]); w[1] = pk_bf16(v[2] * r * g[2], v[3] * r * g[3]);
      *(u32x2*)(p.ckvn + (size_t)row * 256 + lane * 4) = w;
    }
    if (lane < 16) {
      const float pos = (float)(row < TX ? NMETA + (row & (SEQ - 1)) : row - TX);
      const float inv = exp2f(-(float)lane * (13.287712379549449f / 16.f));
      const float ang = pos * inv;
      float sn, cs; fast_sincos(ang, sn, cs);
      const float x1 = bf2f(src[672 + lane]), x2 = bf2f(src[688 + lane]);
      p.kr[(size_t)row * 32 + lane] = f2bf(x1 * cs - x2 * sn);
      p.kr[(size_t)row * 32 + 16 + lane] = f2bf(x1 * sn + x2 * cs);
    }
  }
}

__device__ void dt_phase(const Params& p) {
  const int lane = phase_tid() & 63, wid = phase_tid() >> 6;
  for (int item = blockIdx.x * 8 + wid; item < NSEQ * 2 * NCH; item += gridDim.x * 8) {
    const int c = item % NCH, dir = (item / NCH) & 1, seq = item / (NCH * 2);
    u32x4 raw[2][2];
#pragma unroll
    for (int j = 0; j < 2; ++j) {
      const int pos = c * 128 + lane * 2 + j - MPAD;
      raw[j][0] = (u32x4){0u, 0u, 0u, 0u}; raw[j][1] = raw[j][0];
      if (pos >= 0) {
        const bf16_t* src = p.rest + (size_t)row_of(seq, pos) * 768 + dir * 16;
        raw[j][0] = *(const u32x4*)src; raw[j][1] = *(const u32x4*)(src + 8);
      }
    }
    const float* biasp = dir ? p.dt_bias_b : p.dt_bias_f;
    const float* alogp = dir ? p.a_log_b : p.a_log_f;
#pragma unroll
    for (int h = 0; h < 16; ++h) {
      const float bias = biasp[h];
      const float a = -__expf(alogp[h]);
      float dt[2], da[2];
#pragma unroll
      for (int j = 0; j < 2; ++j) {
        const int pos = c * 128 + lane * 2 + j - MPAD;
        const unsigned w = raw[j][h >> 3][(h >> 1) & 3];
        const float x = ((h & 1) ? bfhi(w) : bflo(w)) + bias;
        const float v = pos >= 0 ? (x > 20.f ? x : log1pf(__expf(x))) : 0.f;
        dt[j] = v; da[j] = v * a;
      }
      const float s2 = da[0] + da[1];
      float incl = s2;
#pragma unroll
      for (int o = 1; o < 64; o <<= 1) { float t = __shfl_up(incl, o); if (lane >= o) incl += t; }
      const float excl = incl - s2;
      const float tot = __shfl(incl, 63);
      const size_t base = ((size_t)(seq * 2 + dir) * 16 + h) * LP + c * 128 + lane * 2;
      float P0, P1;
      if (dir == 0) { P0 = excl + da[0]; P1 = incl; } else { P0 = -excl; P1 = -(excl + da[0]); }
      *(float2*)(p.dtv + base) = make_float2(dt[0], dt[1]);
      *(float2*)(p.Pv + base) = make_float2(P0, P1);
      if (lane == 0) p.Atot[((size_t)(seq * 2 + dir) * 16 + h) * NCH + c] = tot;
    }
  }
}

__device__ __forceinline__ void xcd_group_map(int b, int& gg, int& j) { const int r = b & 7, k = b >> 3; j = k & 7; gg = (k >> 3) * 8 + r; }
constexpr int KS_STRIDE = 208, VS_STRIDE = 136;
constexpr int ATT_STAGE = 64 * KS_STRIDE + 64 * VS_STRIDE;
static_assert(2 * ATT_STAGE <= 160 * 1024 - 64, "attn lds");
__device__ void attn_phase(const Params& p, char* smem) {
  const int tid = phase_tid(), lane = tid & 63, wid = tid >> 6;
  const int r32 = lane & 31, hh = lane >> 5;
  for (int item0 = blockIdx.x; item0 < NSEQ * 8 * 8; item0 += gridDim.x) {
    int item = item0;
    if (gridDim.x == 256) { int gg, j; xcd_group_map(blockIdx.x, gg, j); item = ((item0 >> 8) * 32 + gg) * 8 + j; }
    const int qb = item & 7, h = (item >> 3) & 7, seq = item >> 6;
    const float qscale = 0.10206207261596575f * 1.4426950408889634f;
    bf16x8 qf[6];
    {
      const int qi = qb * 256 + wid * 32 + r32;
      const bf16_t* qp = p.q + ((size_t)seq * SEQ + qi) * 768 + h * 96 + hh * 8;
      const float pos = (float)(NMETA + qi);
      u32x4 v[6];
#pragma unroll
      for (int i = 0; i < 6; ++i) v[i] = *(const u32x4*)(qp + i * 16);
#pragma unroll
      for (int i = 0; i < 4; ++i) {
        u32x4 w;
#pragma unroll
        for (int j = 0; j < 4; ++j) w[j] = pk_bf16(bflo(v[i][j]) * qscale, bfhi(v[i][j]) * qscale);
        qf[i] = as_bf16x8(w);
      }
      u32x4 w1, w2;
#pragma unroll
      for (int j = 0; j < 4; ++j) {
        float o1[2], o2[2];
#pragma unroll
        for (int e = 0; e < 2; ++e) {
          const int k = 8 * hh + 2 * j + e;
          const float x1 = e ? bfhi(v[4][j]) : bflo(v[4][j]), x2 = e ? bfhi(v[5][j]) : bflo(v[5][j]);
          const float inv = exp2f(-(float)k * (13.287712379549449f / 16.f));
          float sn, cs; fast_sincos(pos * inv, sn, cs);
          o1[e] = (x1 * cs - x2 * sn) * qscale; o2[e] = (x1 * sn + x2 * cs) * qscale;
        }
        w1[j] = pk_bf16(o1[0], o1[1]); w2[j] = pk_bf16(o2[0], o2[1]);
      }
      qf[4] = as_bf16x8(w1); qf[5] = as_bf16x8(w2);
    }
    f32x16 oacc[2], negm;
#pragma unroll
    for (int i = 0; i < 16; ++i) { oacc[0][i] = 0.f; oacc[1][i] = 0.f; negm[i] = 0.f; }
    float l_run = 0.f;

    u32x4 rk, rkr, rv;
    const bf16_t* vTb = p.vT + (size_t)(h * 64) * TP;
    auto gload = [&](int kt) {
      const u32x4 zero = {0u, 0u, 0u, 0u};
      if (kt < 32) {
        { int key = tid >> 3, ch = tid & 7;
          rk = *(const u32x4*)(p.Kb + ((size_t)seq * SEQ + kt * 64 + key) * 512 + h * 64 + ch * 8); }
        if (tid < 256) { int key = tid >> 2, ch = tid & 3;
          rkr = *(const u32x4*)(p.kr + ((size_t)seq * SEQ + kt * 64 + key) * 32 + ch * 8); }
        { int dv = tid >> 3, ch = tid & 7;
          rv = *(const u32x4*)(vTb + (size_t)dv * TP + seq * SEQ + kt * 64 + ch * 8); }
      } else {
        { int key = tid >> 3, ch = tid & 7;
          rk = key < 16 ? *(const u32x4*)(p.Kb + (size_t)(TX + key) * 512 + h * 64 + ch * 8) : zero; }
        if (tid < 256) { int key = tid >> 2, ch = tid & 3;
          rkr = key < 16 ? *(const u32x4*)(p.kr + (size_t)(TX + key) * 32 + ch * 8) : zero; }
        { int dv = tid >> 3, ch = tid & 7;
          rv = ch < 2 ? *(const u32x4*)(vTb + (size_t)dv * TP + TX + ch * 8) : zero; }
      }
    };
    auto sstore = [&](int st) {
      char* ks = smem + st * ATT_STAGE; char* vs = ks + 64 * KS_STRIDE;
      { int key = tid >> 3, ch = tid & 7; *(u32x4*)(ks + key * KS_STRIDE + ch * 16) = rk; }
      if (tid < 256) { int key = tid >> 2, ch = tid & 3; *(u32x4*)(ks + key * KS_STRIDE + 128 + ch * 16) = rkr; }
      { int dv = tid >> 3, ch = tid & 7; char* d = vs + dv * VS_STRIDE + ch * 16;
        *(u32x2*)d = (u32x2){rv[0], rv[1]}; *(u32x2*)(d + 8) = (u32x2){rv[2], rv[3]}; }
    };
    lds_barrier();
    gload(0); sstore(0);
    lds_barrier();
    for (int kt = 0; kt < 33; ++kt) {
      const int cur = kt & 1;
      if (kt + 1 < 33) gload(kt + 1);
      const char* ks_ = smem + cur * ATT_STAGE; const char* vs_ = ks_ + 64 * KS_STRIDE;
      f32x16 sacc[2];
      bf16x8 kfr[6][2];
#pragma unroll
      for (int ks = 0; ks < 6; ++ks)
#pragma unroll
        for (int t2 = 0; t2 < 2; ++t2) kfr[ks][t2] = *(const bf16x8*)(ks_ + (t2 * 32 + r32) * KS_STRIDE + ks * 32 + hh * 16);
      __builtin_amdgcn_sched_barrier(0);
#pragma unroll
      for (int ks = 0; ks < 6; ++ks)
#pragma unroll
        for (int t2 = 0; t2 < 2; ++t2)
          sacc[t2] = __builtin_amdgcn_mfma_f32_32x32x16_bf16(kfr[ks][t2], qf[ks], ks == 0 ? negm : sacc[t2], 0, 0, 0);
      __builtin_amdgcn_sched_barrier(0);
      u32x2 vfa[2][2][2], vfb[2][2][2];
#pragma unroll
      for (int t2 = 0; t2 < 2; ++t2)
#pragma unroll
        for (int s2 = 0; s2 < 2; ++s2)
#pragma unroll
          for (int dvt = 0; dvt < 2; ++dvt) {
            const char* vp = vs_ + (dvt * 32 + r32) * VS_STRIDE + (t2 * 32 + s2 * 16 + 4 * hh) * 2;
            vfa[t2][s2][dvt] = *(const u32x2*)vp; vfb[t2][s2][dvt] = *(const u32x2*)(vp + 16);
          }
      __builtin_amdgcn_sched_barrier(0);
      if (kt == 32) {
#pragma unroll
        for (int t2 = 0; t2 < 2; ++t2)
#pragma unroll
          for (int i = 0; i < 16; ++i) {
            int kk = t2 * 32 + (i & 3) + 8 * (i >> 2) + 4 * hh;
            if (kk >= 16) sacc[t2][i] = -1e30f;
          }
      }
      {
        float mx = sacc[0][0];
#pragma unroll
        for (int t2 = 0; t2 < 2; ++t2)
#pragma unroll
          for (int i = 0; i < 16; ++i) mx = fmaxf(mx, sacc[t2][i]);
        mx = fmaxf(mx, __shfl_xor(mx, 32));
        if (kt == 0 || __any(mx > 8.f)) {
          const float d = kt == 0 ? mx : fmaxf(mx, 0.f);
          const float alpha = kt == 0 ? 1.f : __builtin_amdgcn_exp2f(-d);
#pragma unroll
          for (int i = 0; i < 16; ++i) {
            sacc[0][i] -= d; sacc[1][i] -= d; negm[i] -= d;
            oacc[0][i] *= alpha; oacc[1][i] *= alpha;
          }
          l_run *= alpha;
        }
        float ps = 0.f;
#pragma unroll
        for (int t2 = 0; t2 < 2; ++t2)
#pragma unroll
          for (int i = 0; i < 16; ++i) { float e = __builtin_amdgcn_exp2f(sacc[t2][i]); sacc[t2][i] = e; ps += e; }
        l_run += ps;
      }
#pragma unroll
      for (int t2 = 0; t2 < 2; ++t2)
#pragma unroll
        for (int s2 = 0; s2 < 2; ++s2) {
          u32x4 pw;
#pragma unroll
          for (int j = 0; j < 4; ++j) pw[j] = pk_bf16(sacc[t2][s2 * 8 + 2 * j], sacc[t2][s2 * 8 + 2 * j + 1]);
          const bf16x8 pf = as_bf16x8(pw);
#pragma unroll
          for (int dvt = 0; dvt < 2; ++dvt) {
            const u32x2 a2 = vfa[t2][s2][dvt], b2 = vfb[t2][s2][dvt];
            bf16x8 vf = as_bf16x8((u32x4){a2[0], a2[1], b2[0], b2[1]});
            oacc[dvt] = __builtin_amdgcn_mfma_f32_32x32x16_bf16(vf, pf, oacc[dvt], 0, 0, 0);
          }
        }
      if (kt + 1 < 33) sstore(cur ^ 1);
      lds_barrier();
    }
    {
      const float l_tot = l_run + __shfl_xor(l_run, 32);
      const float inv = __builtin_amdgcn_rcpf(l_tot);
      const int qi = qb * 256 + wid * 32 + r32;
      bf16_t* op = p.o + ((size_t)seq * SEQ + qi) * 512 + h * 64;
#pragma unroll
      for (int dvt = 0; dvt < 2; ++dvt)
#pragma unroll
        for (int g4 = 0; g4 < 4; ++g4) {
          u32x2 w;
          w[0] = pk_bf16(oacc[dvt][g4 * 4 + 0] * inv, oacc[dvt][g4 * 4 + 1] * inv);
          w[1] = pk_bf16(oacc[dvt][g4 * 4 + 2] * inv, oacc[dvt][g4 * 4 + 3] * inv);
          *(u32x2*)(op + dvt * 32 + g4 * 8 + hh * 4) = w;
        }
    }
  }
  lds_barrier();
}

constexpr int SS_ROW = 272;
constexpr int SS_XT = 264;

constexpr int DG_CC = 0, DG_BC = 128 * SS_ROW, DG_XT = 2 * 128 * SS_ROW, DG_AR = DG_XT + 2 * 64 * SS_XT, DG_BW = DG_AR + 2 * 2048, DG_LDS = DG_BW + 8 * 512;
static_assert(DG_LDS <= 150 * 1024, "diag lds");
__device__ void ssd_diag_phase(const Params& p, char* smem) {
  const int tid = phase_tid(), lane = tid & 63, wid = tid >> 6;
  const int r32 = lane & 31, hh = lane >> 5;
  const int pt = wid & 1, lt = wid >> 1;
  const int l = lt * 32 + r32;
  for (int item = blockIdx.x; item < NSEQ * 16 * 2; item += gridDim.x) {
    const int g = item & 1, c = 1 + ((item >> 1) & 15), seq = item >> 5;
    u32x4 rx[2]; float ra = 0.f;
    auto gload_head = [&](int h) {
      const bf16_t* xt = p.XT + (((size_t)seq * NCH + c) * 16 + h) * 64 * 128;
#pragma unroll
      for (int i = 0; i < 2; ++i) { int id = tid + i * 512; int r = id >> 4, k = id & 15;
        rx[i] = *(const u32x4*)(xt + (size_t)r * 128 + k * 8); }
      const int arr = tid >> 7, idx = tid & 127, dir = arr & 1;
      const float* src = (arr < 2 ? p.Pv : p.dtv) + ((size_t)(seq * 2 + dir) * 16 + h) * LP + c * 128 + idx;
      ra = *src;
    };
    auto sstore_head = [&](int buf) {
#pragma unroll
      for (int i = 0; i < 2; ++i) { int id = tid + i * 512; int r = id >> 4, k = id & 15;
        char* d = smem + DG_XT + buf * 64 * SS_XT + r * SS_XT + k * 16;
        *(u32x2*)d = (u32x2){rx[i][0], rx[i][1]}; *(u32x2*)(d + 8) = (u32x2){rx[i][2], rx[i][3]}; }
      ((float*)(smem + DG_AR + buf * 2048))[tid] = ra;
    };
    lds_barrier();
    {
      const bf16_t* cm = p.Cm + ((size_t)seq * LP + c * 128) * 256 + g * 128;
      const bf16_t* bm = p.Bm + ((size_t)seq * LP + c * 128) * 256 + g * 128;
      u32x4 rc[4], rb[4];
#pragma unroll
      for (int i = 0; i < 4; ++i) { int id = tid + i * 512; int r = id >> 4, k = id & 15;
        rc[i] = *(const u32x4*)(cm + (size_t)r * 256 + k * 8); rb[i] = *(const u32x4*)(bm + (size_t)r * 256 + k * 8); }
      gload_head(g * 8);
#pragma unroll
      for (int i = 0; i < 4; ++i) { int id = tid + i * 512; int r = id >> 4, k = id & 15;
        *(u32x4*)(smem + DG_CC + r * SS_ROW + k * 16) = rc[i]; *(u32x4*)(smem + DG_BC + r * SS_ROW + k * 16) = rb[i]; }
      sstore_head(0);
    }
    lds_barrier();
    f32x16 xacc[4];
#pragma unroll
    for (int st = 0; st < 4; ++st) {
#pragma unroll
      for (int i = 0; i < 16; ++i) xacc[st][i] = 0.f;
#pragma unroll
      for (int ks = 0; ks < 8; ++ks) {
        bf16x8 bfg = *(const bf16x8*)(smem + DG_BC + (st * 32 + r32) * SS_ROW + ks * 32 + hh * 16);
        bf16x8 cfk = *(const bf16x8*)(smem + DG_CC + l * SS_ROW + ks * 32 + hh * 16);
        xacc[st] = __builtin_amdgcn_mfma_f32_32x32x16_bf16(bfg, cfk, xacc[st], 0, 0, 0);
      }
    }
    for (int h8 = 0; h8 < 8; ++h8) {
      const int h = g * 8 + h8, buf = h8 & 1;
      if (h8 + 1 < 8) gload_head(h + 1);
      const char* xtb = smem + DG_XT + buf * 64 * SS_XT;
      const float* Pf = (const float*)(smem + DG_AR + buf * 2048);
      const float* Pb = Pf + 128; const float* Df = Pf + 256; const float* Db = Pf + 384;
      const float Pfl = Pf[l], Pbl = Pb[l];
      float* bw = (float*)(smem + DG_BW + wid * 512);
      const float PrefF = Pf[lt * 32], PrefB = Pb[lt * 32 + 31];
      const float af = __expf(Pfl - PrefF), ab = __expf(Pbl - PrefB);
#pragma unroll
      for (int r = 0; r < 2; ++r) {
        const int sx = lane + 64 * r;
        float bv = 0.f;
        if (sx < lt * 32) bv = Df[sx] * __expf(PrefF - Pf[sx]);
        else if (sx >= (lt + 1) * 32) bv = Db[sx] * __expf(PrefB - Pb[sx]);
        bw[sx] = bv;
      }
      asm volatile("s_waitcnt lgkmcnt(0)" ::: "memory");
      f32x16 yacc;
#pragma unroll
      for (int i = 0; i < 16; ++i) yacc[i] = 0.f;
#pragma unroll
      for (int st = 0; st < 4; ++st) {
        float m[16];
        if (st != lt) {
          const float a = st < lt ? af : ab;
#pragma unroll
          for (int i = 0; i < 16; ++i) { const int sx = st * 32 + (i & 3) + 8 * (i >> 2) + 4 * hh;
            m[i] = xacc[st][i] * (a * bw[sx]); }
        } else {
#pragma unroll
          for (int i = 0; i < 16; ++i) { const int sx = st * 32 + (i & 3) + 8 * (i >> 2) + 4 * hh;
            const float wf = Df[sx] * __expf(Pfl - Pf[sx]), wb = Db[sx] * __expf(Pbl - Pb[sx]);
            m[i] = xacc[st][i] * ((sx <= l ? wf : 0.f) + (sx >= l ? wb : 0.f)); }
        }
#pragma unroll
        for (int s2 = 0; s2 < 2; ++s2) {
          u32x4 pw;
#pragma unroll
          for (int j = 0; j < 4; ++j) pw[j] = pk_bf16(m[s2 * 8 + 2 * j], m[s2 * 8 + 2 * j + 1]);
          const char* xp = xtb + (pt * 32 + r32) * SS_XT + (st * 32 + s2 * 16 + 4 * hh) * 2;
          u32x2 a = *(const u32x2*)xp, b2 = *(const u32x2*)(xp + 16);
          bf16x8 xf = as_bf16x8((u32x4){a[0], a[1], b2[0], b2[1]});
          yacc = __builtin_amdgcn_mfma_f32_32x32x16_bf16(xf, as_bf16x8(pw), yacc, 0, 0, 0);
        }
      }
      const float dskip = p.d_skip[h];
      bf16_t* yp = p.Y + ((size_t)seq * SEQ + (c - 1) * 128 + l) * 1024 + h * 64 + pt * 32 + 4 * hh;
#pragma unroll
      for (int g4 = 0; g4 < 4; ++g4) {
        float v[4];
#pragma unroll
        for (int j = 0; j < 4; ++j) {
          const int pp = pt * 32 + g4 * 8 + 4 * hh + j;
          v[j] = yacc[g4 * 4 + j] + dskip * bf2f(*(const bf16_t*)(xtb + pp * SS_XT + l * 2));
        }
        u32x2 w; w[0] = pk_bf16(v[0], v[1]); w[1] = pk_bf16(v[2], v[3]);
        *(u32x2*)(yp + g4 * 8) = w;
      }
      if (h8 + 1 < 8) sstore_head(buf ^ 1);
      lds_barrier();
    }
  }
  lds_barrier();
}

constexpr int OFF_CC = 0, OFF_BT = 128 * SS_ROW, OFF_XT = 2 * 128 * SS_ROW;
constexpr int OFF_XW = OFF_XT + 64 * SS_XT, OFF_SB = OFF_XW + 64 * SS_ROW, OFF_P = OFF_SB + 64 * SS_ROW, OFF_DT = OFF_P + 512;
constexpr int OFF_AT = OFF_DT + 512;
constexpr int OFF_WS = OFF_AT + 128;
constexpr int OFF_YT = OFF_WS + 512;
constexpr int SSD_LDS = OFF_YT + 128 * 272;
static_assert(SSD_LDS <= 160 * 1024 - 64, "ssd lds");
__device__ void ssd_phase(const Params& p, char* smem) {
  const int tid = phase_tid(), lane = tid & 63, wid = tid >> 6;
  const int r32 = lane & 31, hh = lane >> 5;
  const int pt = wid & 1, lt = wid >> 1;
  float* Ps = (float*)(smem + OFF_P);
  float* Ds = (float*)(smem + OFF_DT);
  const int NI = NSEQ * 16, G = gridDim.x;
  const bool split = G >= 256 && G < NI;
  for (int u = 0;; ++u) {
    int item, dir0, dir1; bool to_yb2 = false;
    if (!split) { item = blockIdx.x + u * G; if (item >= NI) break; dir0 = 0; dir1 = 2; }
    else if (G == 256) {
      int gg, j; xcd_group_map(blockIdx.x, gg, j);
      if (u == 0) { item = gg * 8 + j; dir0 = 0; dir1 = 2; }
      else if (u == 1) { item = G + (gg >> 1) * 8 + j; dir0 = gg & 1; dir1 = dir0 + 1; to_yb2 = true; }
      else break;
    }
    else if (u == 0) { item = blockIdx.x; dir0 = 0; dir1 = 2; }
    else { const int hidx = blockIdx.x + (u - 1) * G; if (hidx >= 2 * (NI - G)) break; item = G + (hidx >> 1); dir0 = hidx & 1; dir1 = dir0 + 1; to_yb2 = true; }
    const int h = item & 15, seq = item >> 4, g = h >> 3;
    for (int dir = dir0; dir < dir1; ++dir) {
      const bool yb2 = (dir == 1) && to_yb2;
      f32x16 sacc;
#pragma unroll
      for (int i = 0; i < 16; ++i) sacc[i] = 0.f;
      const float* dtp = p.dtv + ((size_t)(seq * 2 + dir) * 16 + h) * LP;
      const float* Pp = p.Pv + ((size_t)(seq * 2 + dir) * 16 + h) * LP;
      const float* Ap = p.Atot + ((size_t)(seq * 2 + dir) * 16 + h) * NCH;
      u32x4 rc[4], rbt[4], rx[2];
      float rp = 0.f, rd = 0.f;
      auto gload = [&](int c) {
        const bf16_t* cm = p.Cm + ((size_t)seq * LP + c * 128) * 256 + g * 128;
        const bf16_t* bt = p.BmT + (((size_t)seq * NCH + c) * 2 + g) * 128 * 128;
        const bf16_t* xt = p.XT + (((size_t)seq * NCH + c) * 16 + h) * 64 * 128;
#pragma unroll
        for (int i = 0; i < 4; ++i) { int id = tid + i * 512; int r = id >> 4, k = id & 15;
          rc[i] = *(const u32x4*)(cm + (size_t)r * 256 + k * 8);
          rbt[i] = *(const u32x4*)(bt + (size_t)r * 128 + k * 8); }
#pragma unroll
        for (int i = 0; i < 2; ++i) { int id = tid + i * 512; int r = id >> 4, k = id & 15;
          rx[i] = *(const u32x4*)(xt + (size_t)r * 128 + k * 8); }
        if (tid < 128) { rp = Pp[c * 128 + tid]; rd = dtp[c * 128 + tid]; }
      };
      auto sstore = [&](int cs) {
#pragma unroll
        for (int i = 0; i < 4; ++i) { int id = tid + i * 512; int r = id >> 4, k = id & 15;
          *(u32x4*)(smem + OFF_CC + r * SS_ROW + k * 16) = rc[i];
          *(u32x4*)(smem + OFF_BT + r * SS_ROW + k * 16) = rbt[i]; }
#pragma unroll
        for (int i = 0; i < 2; ++i) { int id = tid + i * 512; int r = id >> 4, k = id & 15;
          char* d = smem + OFF_XT + r * SS_XT + k * 16;
          *(u32x2*)d = (u32x2){rx[i][0], rx[i][1]}; *(u32x2*)(d + 8) = (u32x2){rx[i][2], rx[i][3]}; }
        if (tid < 128) {
          Ps[tid] = rp; Ds[tid] = rd;
          ((float*)(smem + OFF_WS))[tid] = rd * (dir == 0 ? __expf(Ap[cs] - rp) : __expf(-rp));
        }
      };
      const int c_first = dir == 0 ? 0 : NCH - 1, c_last = dir == 0 ? NCH - 1 : 1, c_step = dir == 0 ? 1 : -1;
      lds_barrier();
      gload(c_first);
      if (tid < NCH) ((float*)(smem + OFF_AT))[tid] = Ap[tid];
      for (int i = tid; i < 64 * SS_ROW / 4; i += NTHREADS) ((unsigned*)(smem + OFF_SB))[i] = 0u;
      sstore(c_first);
      lds_barrier();
      for (int c = c_first;; c += c_step) {
        const bool last = (c == c_last);
        const bool first = (c == c_first);
        const float atot = ((const float*)(smem + OFF_AT))[c];
        const int l = lt * 32 + r32;
        const bool emit = (c >= 1) && !first;
        const int yrow = tid >> 2, yseg = tid & 3;
        bf16_t* yp = yb2 ? p.Yb2 + ((size_t)(item - G) * SEQ + (c - 1) * 128 + yrow) * 64 + yseg * 16
                         : p.Y + ((size_t)seq * SEQ + (c - 1) * 128 + yrow) * 1024 + h * 64 + yseg * 16;
        u32x4 yold[2] = {{0u, 0u, 0u, 0u}, {0u, 0u, 0u, 0u}};
        if (emit && !yb2) {
          yold[0] = *(const u32x4*)yp; yold[1] = *(const u32x4*)(yp + 8);
        }
        if (!last) gload(c + c_step);
        if (!last) {
          const int pp = tid >> 3, l0 = (tid & 7) * 16;
          const char* srow = smem + OFF_XT + pp * SS_XT + l0 * 2;
          char* drow = smem + OFF_XW + pp * SS_ROW + l0 * 2;
#pragma unroll
          for (int q4 = 0; q4 < 4; ++q4) {
            u32x2 v = *(const u32x2*)(srow + q4 * 8);
            const f32x4 w = *(const f32x4*)(smem + OFF_WS + (l0 + q4 * 4) * 4);
            u32x2 o;
            o[0] = pk_bf16(bflo(v[0]) * w[0], bfhi(v[0]) * w[1]);
            o[1] = pk_bf16(bflo(v[1]) * w[2], bfhi(v[1]) * w[3]);
            *(u32x2*)(drow + q4 * 8) = o;
          }
        }
        if (emit) {
          const float Pl = Ps[l];
          f32x16 yacc;
#pragma unroll
          for (int i = 0; i < 16; ++i) yacc[i] = 0.f;
#pragma unroll
          for (int ks = 0; ks < 8; ++ks) {
            bf16x8 sf = *(const bf16x8*)(smem + OFF_SB + (pt * 32 + r32) * SS_ROW + ks * 32 + hh * 16);
            bf16x8 cfk = *(const bf16x8*)(smem + OFF_CC + l * SS_ROW + ks * 32 + hh * 16);
            yacc = __builtin_amdgcn_mfma_f32_32x32x16_bf16(sf, cfk, yacc, 0, 0, 0);
          }
          const float ysc = dir == 0 ? __expf(Pl) : __expf(Pl + atot);
#pragma unroll
          for (int g4 = 0; g4 < 4; ++g4)
            *(f32x4*)(smem + OFF_YT + l * 272 + (pt * 32 + g4 * 8 + 4 * hh) * 4) =
                (f32x4){yacc[g4 * 4] * ysc, yacc[g4 * 4 + 1] * ysc, yacc[g4 * 4 + 2] * ysc, yacc[g4 * 4 + 3] * ysc};
        }
        lds_barrier();
        if (emit || (yb2 && c >= 1)) {
          float v[16];
#pragma unroll
          for (int q4 = 0; q4 < 4; ++q4) {
            const f32x4 t4 = emit ? *(const f32x4*)(smem + OFF_YT + yrow * 272 + yseg * 64 + q4 * 16) : (f32x4){0.f, 0.f, 0.f, 0.f};
            v[q4 * 4] = t4[0]; v[q4 * 4 + 1] = t4[1]; v[q4 * 4 + 2] = t4[2]; v[q4 * 4 + 3] = t4[3];
          }
          u32x4 w0, w1;
#pragma unroll
          for (int j = 0; j < 4; ++j) {
            w0[j] = pk_bf16(v[2 * j] + bflo(yold[0][j]), v[2 * j + 1] + bfhi(yold[0][j]));
            w1[j] = pk_bf16(v[8 + 2 * j] + bflo(yold[1][j]), v[8 + 2 * j + 1] + bfhi(yold[1][j]));
          }
          *(u32x4*)yp = w0; *(u32x4*)(yp + 8) = w1;
        }
        if (!last) {
          const float dec = __expf(atot);
#pragma unroll
          for (int i = 0; i < 16; ++i) sacc[i] *= dec;
#pragma unroll
          for (int ks = 0; ks < 8; ++ks) {
            bf16x8 xf = *(const bf16x8*)(smem + OFF_XW + (pt * 32 + r32) * SS_ROW + ks * 32 + hh * 16);
            bf16x8 bfg = *(const bf16x8*)(smem + OFF_BT + (lt * 32 + r32) * SS_ROW + ks * 32 + hh * 16);
            sacc = __builtin_amdgcn_mfma_f32_32x32x16_bf16(bfg, xf, sacc, 0, 0, 0);
          }
#pragma unroll
          for (int g4 = 0; g4 < 4; ++g4)
            *(u32x2*)(smem + OFF_SB + (pt * 32 + r32) * SS_ROW + (lt * 32 + g4 * 8 + 4 * hh) * 2) =
                (u32x2){pk_bf16(sacc[g4 * 4], sacc[g4 * 4 + 1]), pk_bf16(sacc[g4 * 4 + 2], sacc[g4 * 4 + 3])};
        }
        lds_barrier();
        if (last) break;
        sstore(c + c_step);
        lds_barrier();
      }
    }
  }
  lds_barrier();
}

__device__ void gate_phase(const Params& p) {
  const int lane = phase_tid() & 63, wid = phase_tid() >> 6;
  const int G = gridDim.x;
  const bool split = G >= 256 && G < NSEQ * 16;
  struct In { u32x4 y[2], z[2], y2[2], o; };
  auto load = [&](In& d, int row) {
#pragma unroll
    for (int c = 0; c < 2; ++c) {
      d.y[c] = *(const u32x4*)(p.Y + (size_t)row * 1024 + c * 512 + lane * 8);
      d.z[c] = *(const u32x4*)(p.z + (size_t)row * 1024 + c * 512 + lane * 8);
      const int item = (row >> 11) * 16 + c * 8 + (lane >> 3);
      d.y2[c] = (u32x4){0u, 0u, 0u, 0u};
      if (split && item >= G) d.y2[c] = *(const u32x4*)(p.Yb2 + ((size_t)(item - G) * SEQ + (row & (SEQ - 1))) * 64 + (lane & 7) * 8);
    }
    d.o = *(const u32x4*)(p.o + (size_t)row * 512 + lane * 8);
  };
  const int stride = gridDim.x * 8;
  int row = blockIdx.x * 8 + wid;
  In cur, nxt;
  if (row < TX) load(cur, row);
  for (; row < TX; row += stride) {
    if (row + stride < TX) load(nxt, row + stride);
    float v[16];
    float ss = 0.f;
#pragma unroll
    for (int c = 0; c < 2; ++c) {
#pragma unroll
      for (int j = 0; j < 4; ++j) {
        float a = (bflo(cur.y[c][j]) + bflo(cur.y2[c][j])) * silu_f(bflo(cur.z[c][j])), b2 = (bfhi(cur.y[c][j]) + bfhi(cur.y2[c][j])) * silu_f(bfhi(cur.z[c][j]));
        v[c * 8 + 2 * j] = a; v[c * 8 + 2 * j + 1] = b2; ss += a * a + b2 * b2;
      }
    }
    const float r = rsqrtf(wave_sum(ss) * (1.f / 1024.f) + EPS);
#pragma unroll
    for (int c = 0; c < 2; ++c) {
      const float* g = p.ssm_norm_g + c * 512 + lane * 8;
      u32x4 w;
#pragma unroll
      for (int j = 0; j < 4; ++j) w[j] = pk_bf16(v[c * 8 + 2 * j] * r * g[2 * j], v[c * 8 + 2 * j + 1] * r * g[2 * j + 1]);
      *(u32x4*)(p.ycat + (size_t)row * 1536 + c * 512 + lane * 8) = w;
    }
    {
      const u32x4 o = cur.o;
      float f[8] = {bflo(o[0]), bfhi(o[0]), bflo(o[1]), bfhi(o[1]), bflo(o[2]), bfhi(o[2]), bflo(o[3]), bfhi(o[3])};
      float s2 = 0.f;
#pragma unroll
      for (int j = 0; j < 8; ++j) s2 += f[j] * f[j];
      const float r2 = rsqrtf(wave_sum(s2) * (1.f / 512.f) + EPS);
      const float* g = p.attn_norm_g + lane * 8;
      u32x4 w;
#pragma unroll
      for (int j = 0; j < 4; ++j) w[j] = pk_bf16(f[2 * j] * r2 * g[2 * j], f[2 * j + 1] * r2 * g[2 * j + 1]);
      *(u32x4*)(p.ycat + (size_t)row * 1536 + 1024 + lane * 8) = w;
    }
    cur = nxt;
  }
}

__device__ void ln1_phase(const Params& p) {
  const int lane = phase_tid() & 63, wid = phase_tid() >> 6;
  const int stride = gridDim.x * 8;
  int row = blockIdx.x * 8 + wid;
  u32x4 nx[2];
  if (row < TX) { nx[0] = *(const u32x4*)(p.pre + (size_t)row * DM + lane * 8); nx[1] = *(const u32x4*)(p.pre + (size_t)row * DM + 512 + lane * 8); }
  for (; row < TX; row += stride) {
    const u32x4 cu[2] = {nx[0], nx[1]};
    if (row + stride < TX) { nx[0] = *(const u32x4*)(p.pre + (size_t)(row + stride) * DM + lane * 8); nx[1] = *(const u32x4*)(p.pre + (size_t)(row + stride) * DM + 512 + lane * 8); }
    float v[16];
#pragma unroll
    for (int c = 0; c < 2; ++c) {
#pragma unroll
      for (int j = 0; j < 4; ++j) { v[c * 8 + 2 * j] = bflo(cu[c][j]); v[c * 8 + 2 * j + 1] = bfhi(cu[c][j]); }
    }
    float s = 0.f;
#pragma unroll
    for (int j = 0; j < 16; ++j) s += v[j];
    const float mu = wave_sum(s) * (1.f / DM);
    float s2 = 0.f;
#pragma unroll
    for (int j = 0; j < 16; ++j) { float d = v[j] - mu; s2 += d * d; }
    const float rstd = rsqrtf(wave_sum(s2) * (1.f / DM) + EPS);
#pragma unroll
    for (int c = 0; c < 2; ++c) {
      const float* g = p.ln1_g + c * 512 + lane * 8; const float* b = p.ln1_b + c * 512 + lane * 8;
      float o[8];
#pragma unroll
      for (int j = 0; j < 8; ++j) o[j] = (v[c * 8 + j] - mu) * rstd * g[j] + b[j];
      *(u32x4*)(p.h1 + (size_t)row * DM + c * 512 + lane * 8) = pack8(o);
      float am = 0.f;
#pragma unroll
      for (int j = 0; j < 8; ++j) am = fmaxf(am, fabsf(o[j]));
      am = fmaxf(am, __builtin_bit_cast(float, __builtin_amdgcn_update_dpp(0, __builtin_bit_cast(int, am), 0x128, 0xf, 0xf, true)));
      am = fmaxf(am, __builtin_bit_cast(float, __builtin_amdgcn_update_dpp(0, __builtin_bit_cast(int, am), 0x124, 0xf, 0xf, true)));
      am = fmaxf(am, __builtin_bit_cast(float, __builtin_amdgcn_update_dpp(0, __builtin_bit_cast(int, am), 0x122, 0xf, 0xf, true)));
      am = fmaxf(am, __builtin_bit_cast(float, __builtin_amdgcn_update_dpp(0, __builtin_bit_cast(int, am), 0x121, 0xf, 0xf, true)));
      const float sc = am > 0.f ? am * (1.f / 127.f) : 1.f;
      const float inv = 1.f / sc;
      unsigned w0 = 0u, w1 = 0u;
#pragma unroll
      for (int j = 0; j < 4; ++j) {
        w0 |= ((unsigned)__float2int_rn(o[j] * inv) & 255u) << (8 * j);
        w1 |= ((unsigned)__float2int_rn(o[4 + j] * inv) & 255u) << (8 * j);
      }
      *(u32x2*)(p.h1q + (size_t)row * DM + c * 512 + lane * 8) = (u32x2){w0, w1};
      if ((lane & 15) == 0) p.sx[(size_t)row * 8 + c * 4 + (lane >> 4)] = sc;
    }
  }
}

template <bool INT8>
__device__ void quant_rows(const float* __restrict__ src, unsigned char* __restrict__ dstq, float* __restrict__ scl) {
  const int lane = phase_tid() & 63, wid = phase_tid() >> 6;
  for (int e = blockIdx.x * 8 + wid; e < 16384; e += gridDim.x * 8) {
    const float* r = src + (size_t)e * 1024 + lane * 4;
    f32x4 a[4];
#pragma unroll
    for (int j = 0; j < 4; ++j) a[j] = *(const f32x4*)(r + j * 256);
    float m = 0.f;
#pragma unroll
    for (int j = 0; j < 4; ++j)
#pragma unroll
      for (int k = 0; k < 4; ++k) m = fmaxf(m, fabsf(a[j][k]));
#pragma unroll
    for (int o = 32; o >= 1; o >>= 1) m = fmaxf(m, __shfl_xor(m, o));
    const float sc = m > 0.f ? m * (INT8 ? (1.f / 127.f) : (1.f / 240.f)) : 1.f;
    const float inv = 1.f / sc;
#pragma unroll
    for (int j = 0; j < 4; ++j) {
      unsigned w;
      if (INT8) {
        w = 0u;
#pragma unroll
        for (int k = 0; k < 4; ++k) w |= ((unsigned)__float2int_rn(a[j][k] * inv) & 255u) << (8 * k);
      } else {
        int t = __builtin_amdgcn_cvt_pk_fp8_f32(a[j][0] * inv, a[j][1] * inv, 0, false);
        t = __builtin_amdgcn_cvt_pk_fp8_f32(a[j][2] * inv, a[j][3] * inv, t, true);
        w = (unsigned)t;
      }
      *(unsigned*)(dstq + ((size_t)(j * 2 + (lane >> 5)) * 16384 + e) * 128 + (lane & 31) * 4) = w;
    }
    if (lane == 0) scl[e] = sc;
  }
}

__device__ __forceinline__ float dpp_add8(float v) {
  v += __builtin_bit_cast(float, __builtin_amdgcn_update_dpp(0, __builtin_bit_cast(int, v), 0xB1, 0xf, 0xf, true));
  v += __builtin_bit_cast(float, __builtin_amdgcn_update_dpp(0, __builtin_bit_cast(int, v), 0x4E, 0xf, 0xf, true));
  v += __builtin_bit_cast(float, __builtin_amdgcn_update_dpp(0, __builtin_bit_cast(int, v), 0x141, 0xf, 0xf, true));
  return v;
}
__device__ __forceinline__ void fp8x16_to_f32(u32x4 w, float (&f)[16]) {
#pragma unroll
  for (int j = 0; j < 4; ++j) {
    f32x2_t lo = __builtin_amdgcn_cvt_pk_f32_fp8((int)w[j], false);
    f32x2_t hi = __builtin_amdgcn_cvt_pk_f32_fp8((int)w[j], true);
    f[4 * j] = lo[0]; f[4 * j + 1] = lo[1]; f[4 * j + 2] = hi[0]; f[4 * j + 3] = hi[1];
  }
}

__device__ void peer_u_phase(const Params& p, char* smem) {
  const int lane = phase_tid() & 63, wid = phase_tid() >> 6;
  const int sg = lane >> 3, q = lane & 7;
  const int nr = gridDim.x >> 3;
  if ((int)blockIdx.x >= nr * 8) return;
  const volatile LAS unsigned* st = (const volatile LAS unsigned*)(smem + LDS_BYTES - 32);
  const bool xok = st[4] != 0u;
  const int slice = xok ? (int)st[2] : (int)(blockIdx.x & 7), rank = xok ? (int)st[3] : (int)(blockIdx.x >> 3);
  const unsigned char* Us = p.Uq + (size_t)slice * 16384 * 128 + q * 16;
  const int stride = nr * 8;
  int t = rank * 8 + wid;
  if (t >= TX) return;
  struct Ids { u32x4 e[2]; u32x4 xq; float sx; };
  auto load_ids = [&](Ids& d, int tt) {
    tt = tt < TX ? tt : TX - 1;
    const unsigned short* ep = p.experts + (size_t)tt * 128 + sg * 16;
    d.e[0] = *(const u32x4*)ep; d.e[1] = *(const u32x4*)(ep + 8);
    d.xq = *(const u32x4*)(p.h1q + (size_t)tt * DM + slice * 128 + q * 16);
    d.sx = p.sx[(size_t)tt * 8 + slice];
  };
  auto issue = [&](u32x4 (&uq)[8], const u32x4& ew) {
#pragma unroll
    for (int j = 0; j < 4; ++j) {
      uq[2 * j] = *(const u32x4*)(Us + (size_t)(ew[j] & 0xffffu) * 128);
      uq[2 * j + 1] = *(const u32x4*)(Us + (size_t)(ew[j] >> 16) * 128);
    }
  };
  auto compute = [&](const u32x4 (&uq)[8], const u32x4& xq, float sxv, float (&pdv)[8]) {
#pragma unroll
    for (int i = 0; i < 8; ++i) {
      int d = 0;
#pragma unroll
      for (int j = 0; j < 4; ++j) d = __builtin_amdgcn_sdot4((int)uq[i][j], (int)xq[j], d, false);
      d += __builtin_amdgcn_update_dpp(0, d, 0xB1, 0xf, 0xf, true);
      d += __builtin_amdgcn_update_dpp(0, d, 0x4E, 0xf, 0xf, true);
      d += __builtin_amdgcn_update_dpp(0, d, 0x141, 0xf, 0xf, true);
      pdv[i] = (float)d * sxv;
    }
  };
  auto step = [&](Ids& cur, Ids& nxt, Ids& nn, u32x4 (&P)[8], u32x4 (&Q)[8], u32x4 (&R)[8]) -> bool {
    const bool has1 = t + stride < TX;
    issue(R, nxt.e[0]);
    load_ids(nn, t + 2 * stride);
    float pa[8], pb[8];
    compute(P, cur.xq, cur.sx, pa);
    issue(P, nxt.e[1]);
    compute(Q, cur.xq, cur.sx, pb);
    if (q == 0) {
      bf16_t* dst = p.pd + ((size_t)slice * TX + t) * 128 + sg * 16;
      *(u32x4*)dst = (u32x4){pk_bf16(pa[0], pa[1]), pk_bf16(pa[2], pa[3]), pk_bf16(pa[4], pa[5]), pk_bf16(pa[6], pa[7])};
      *(u32x4*)(dst + 8) = (u32x4){pk_bf16(pb[0], pb[1]), pk_bf16(pb[2], pb[3]), pk_bf16(pb[4], pb[5]), pk_bf16(pb[6], pb[7])};
    }
    return has1;
  };
  Ids A, B, C;
  u32x4 X[8], Y[8], Z[8];
  load_ids(A, t);
  load_ids(B, t + stride);
  issue(X, A.e[0]);
  issue(Y, A.e[1]);
  for (;;) {
    if (!step(A, B, C, X, Y, Z)) break;
    t += stride;
    if (!step(B, C, A, Z, X, Y)) break;
    t += stride;
    if (!step(C, A, B, Y, Z, X)) break;
    t += stride;
  }
}

__device__ void peer_c_phase(const Params& p) {
  const size_t n4 = (size_t)TX * 128 / 4;
  const int tid = phase_tid();
  for (size_t i0 = (size_t)blockIdx.x * NTHREADS; i0 < n4; i0 += (size_t)gridDim.x * NTHREADS) {
    const size_t i = i0 + tid;
    f32x4 s = {0.f, 0.f, 0.f, 0.f};
#pragma unroll
    for (int sl = 0; sl < 8; ++sl) {
      const u32x2 w = *(const u32x2*)(p.pd + (size_t)sl * TX * 128 + i * 4);
      s[0] += bflo(w[0]); s[1] += bfhi(w[0]); s[2] += bflo(w[1]); s[3] += bfhi(w[1]);
    }
    const f32x4 g = *(const f32x4*)(p.gates + i * 4);
    const u32x2 ew = *(const u32x2*)(p.experts + i * 4);
    const int ev[4] = {(int)(ew[0] & 0xffffu), (int)(ew[0] >> 16), (int)(ew[1] & 0xffffu), (int)(ew[1] >> 16)};
    float c[4];
    float am = 0.f;
#pragma unroll
    for (int j = 0; j < 4; ++j) {
      const float d = s[j] * p.su[ev[j]];
      c[j] = g[j] * 0.5f * d * (1.f + erff(d * 0.70710678118654752f)) * p.sv[ev[j]];
      am = fmaxf(am, fabsf(c[j]));
    }
#pragma unroll
    for (int o = 16; o >= 1; o >>= 1) am = fmaxf(am, __shfl_xor(am, o));
    const float sc = am > 0.f ? am * (1.f / 240.f) : 1.f;
    const float inv = 1.f / sc;
    int w = __builtin_amdgcn_cvt_pk_fp8_f32(c[0] * inv, c[1] * inv, 0, false);
    w = __builtin_amdgcn_cvt_pk_fp8_f32(c[2] * inv, c[3] * inv, w, true);
    const size_t t = i >> 5; const int gq = (int)(i & 31);
    const int c4 = gq & 3, sgq = gq >> 2, a4 = sgq >> 2, r4 = sgq & 3;
    unsigned outw = 0u;
#pragma unroll
    for (int m = 0; m < 4; ++m) {
      const int srcl = (tid & 32) + (4 * a4 + m) * 4 + c4;
      const unsigned vm = (unsigned)__builtin_amdgcn_ds_bpermute(srcl * 4, w);
      outw |= ((vm >> (8 * r4)) & 255u) << (8 * m);
    }
    ((unsigned*)(p.cq + t * 128))[(4 * c4 + r4) * 2 + a4] = outw;
    if (gq == 0) p.csc[t] = sc;
  }
}

typedef int v2i_t __attribute__((ext_vector_type(2)));
constexpr int PV_BLK = 1024 + 32;
constexpr int PV_WAVE_LDS = 16 * PV_BLK + 512;
static_assert(8 * PV_WAVE_LDS <= 160 * 1024 - 64, "peer v lds");
__device__ void peer_v_phase(const Params& p, char* smem) {
  const int lane = phase_tid() & 63, wid = __builtin_amdgcn_readfirstlane(phase_tid() >> 6);
  const int sg = (lane >> 2) & 7, q = (lane >> 5) * 4 + (lane & 3);
  const int kg = lane >> 4;
  const int nr = gridDim.x >> 3;
  if ((int)blockIdx.x >= nr * 8) return;
  const volatile LAS unsigned* st = (const volatile LAS unsigned*)(smem + LDS_BYTES - 32);
  const bool xok = st[4] != 0u;
  const int slice = xok ? (int)st[2] : (int)(blockIdx.x & 7), rank = xok ? (int)st[3] : (int)(blockIdx.x >> 3);
  const unsigned char* Vs = p.Vq + (size_t)slice * 16384 * 128 + q * 16;
  LAS char* wb = (LAS char*)smem + wid * PV_WAVE_LDS;
  const int stride = nr * 8;
  int t = rank * 8 + wid;
  if (t >= TX) return;
  struct Ids { u32x4 e[2]; u32x2 a[4]; float sc; u32x4 xa, xb; };
  auto ldg16 = [&](u32x4& d, const void* ptr) { asm volatile("global_load_dwordx4 %0, %1, off" : "=v"(d) : "v"(ptr) : "memory"); };
  auto ldg8 = [&](u32x2& d, const void* ptr) { asm volatile("global_load_dwordx2 %0, %1, off" : "=v"(d) : "v"(ptr) : "memory"); };
  auto ldg4 = [&](float& d, const void* ptr) { asm volatile("global_load_dword %0, %1, off" : "=v"(d) : "v"(ptr) : "memory"); };
  auto load_ids = [&](Ids& d, int tt) {
    tt = tt < TX ? tt : TX - 1;
    const bf16_t* xp = p.h1 + (size_t)tt * DM + slice * 128 + (lane & 7) * 16;
    ldg16(d.xa, xp); ldg16(d.xb, xp + 8);
    const unsigned short* ep = p.experts + (size_t)tt * 128 + sg * 16;
    ldg16(d.e[0], ep); ldg16(d.e[1], ep + 8);
    const unsigned char* cp = p.cq + (size_t)tt * 128 + kg * 8;
#pragma unroll
    for (int ks = 0; ks < 4; ++ks) ldg8(d.a[ks], cp + ks * 32);
    ldg4(d.sc, p.csc + tt);
  };
  auto pin = [&](Ids& d) {
    asm volatile("" : "+v"(d.xa), "+v"(d.xb), "+v"(d.e[0]), "+v"(d.e[1]), "+v"(d.a[0]), "+v"(d.a[1]), "+v"(d.a[2]), "+v"(d.a[3]), "+v"(d.sc));
  };
  const unsigned wb_lds = (unsigned)__builtin_amdgcn_readfirstlane((int)(unsigned)(unsigned long long)wb);
  auto dma = [&](const unsigned char* gsrc, unsigned lds_dst) {
    unsigned keep;
    asm volatile("s_mov_b32 %0, m0\n\ts_mov_b32 m0, %2\n\ts_nop 0\n\tglobal_load_lds_dwordx4 %1, off\n\ts_mov_b32 m0, %0"
                 : "=&s"(keep) : "v"(gsrc), "s"(lds_dst) : "memory");
  };
  auto issue = [&](int half, const u32x4& ew) {
    asm volatile("s_waitcnt lgkmcnt(0)" ::: "memory");
#pragma unroll
    for (int j = 0; j < 4; ++j) {
      dma(Vs + (size_t)(ew[j] & 0xffffu) * 128, wb_lds + (unsigned)((half * 8 + 2 * j) * PV_BLK));
      dma(Vs + (size_t)(ew[j] >> 16) * 128, wb_lds + (unsigned)((half * 8 + 2 * j + 1) * PV_BLK));
    }
  };
  f32x4 acc[8];
  const int troff = ((lane & 15) >> 1) * 64 + (lane & 1) * 8;
  auto consume = [&](int half, const Ids& d) {
#pragma unroll
    for (int k2 = 0; k2 < 2; ++k2) {
      const u32x2 av = d.a[half * 2 + k2];
      const long a = (long)(((unsigned long long)av[1] << 32) | (unsigned long long)av[0]);
      const LAS char* blk = wb + (half * 8 + k2 * 4 + kg) * PV_BLK + troff;
#pragma unroll
      for (int nt = 0; nt < 8; ++nt) {
        const v2i_t bv = __builtin_amdgcn_ds_read_tr8_b64_v2i32((LAS v2i_t*)(blk + (nt >> 2) * 512 + (nt & 3) * 16));
        const long bl = (long)(((unsigned long long)(unsigned)bv[1] << 32) | (unsigned long long)(unsigned)bv[0]);
        acc[nt] = __builtin_amdgcn_mfma_f32_16x16x32_fp8_fp8(a, bl, acc[nt], 0, 0, 0);
      }
    }
  };
  Ids A, B, C;
  asm volatile("s_waitcnt vmcnt(0)" ::: "memory");
  load_ids(A, t);
  load_ids(B, t + stride);
  asm volatile("s_waitcnt vmcnt(0)" ::: "memory");
  pin(A); pin(B);
  issue(0, A.e[0]);
  auto step = [&](Ids& cur, Ids& nxt, Ids& nn, bool first) -> bool {
    const bool has1 = t + stride < TX;
    load_ids(nn, t + 2 * stride);
    issue(1, cur.e[1]);
#pragma unroll
    for (int nt = 0; nt < 8; ++nt) acc[nt] = (f32x4){0.f, 0.f, 0.f, 0.f};
    if (first) asm volatile("s_waitcnt vmcnt(16)" ::: "memory"); else asm volatile("s_waitcnt vmcnt(18)" ::: "memory");
    consume(0, cur);
    issue(0, nxt.e[0]);
    asm volatile("s_waitcnt vmcnt(8)" ::: "memory");
    pin(nn);
    consume(1, cur);
    LAS float* yt = (LAS float*)(wb + 16 * PV_BLK);
    if (lane < 16) {
#pragma unroll
      for (int nt = 0; nt < 8; ++nt) yt[nt * 16 + lane] = acc[nt][0];
    }
    asm volatile("s_waitcnt lgkmcnt(0)" ::: "memory");
    if (lane < 8) {
      float v[16];
#pragma unroll
      for (int j = 0; j < 4; ++j) { const f32x4 f = *(const LAS f32x4*)(yt + lane * 16 + j * 4); v[4 * j] = f[0]; v[4 * j + 1] = f[1]; v[4 * j + 2] = f[2]; v[4 * j + 3] = f[3]; }
      float xs[16];
#pragma unroll
      for (int j = 0; j < 4; ++j) { xs[2 * j] = bflo(cur.xa[j]); xs[2 * j + 1] = bfhi(cur.xa[j]); xs[8 + 2 * j] = bflo(cur.xb[j]); xs[8 + 2 * j + 1] = bfhi(cur.xb[j]); }
      bf16_t* dst = p.pre2 + (size_t)t * DM + slice * 128 + lane * 16;
      u32x4 w0, w1;
#pragma unroll
      for (int j = 0; j < 4; ++j) {
        w0[j] = pk_bf16(ALPHA * xs[2 * j] + cur.sc * v[2 * j], ALPHA * xs[2 * j + 1] + cur.sc * v[2 * j + 1]);
        w1[j] = pk_bf16(ALPHA * xs[8 + 2 * j] + cur.sc * v[8 + 2 * j], ALPHA * xs[8 + 2 * j + 1] + cur.sc * v[8 + 2 * j + 1]);
      }
      *(u32x4*)dst = w0; *(u32x4*)(dst + 8) = w1;
    }
    return has1;
  };
  if (step(A, B, C, true)) {
    t += stride;
    for (;;) {
      if (!step(B, C, A, false)) break;
      t += stride;
      if (!step(C, A, B, false)) break;
      t += stride;
      if (!step(A, B, C, false)) break;
      t += stride;
    }
  }
  asm volatile("s_waitcnt vmcnt(0)" ::: "memory");
}

__device__ void ln2_phase(const Params& p) {
  const int lane = phase_tid() & 63, wid = phase_tid() >> 6;
  const int stride = gridDim.x * 8;
  int row = blockIdx.x * 8 + wid;
  u32x2 nx[4];
  if (row < TX) {
#pragma unroll
    for (int c = 0; c < 4; ++c) nx[c] = *(const u32x2*)(p.pre2 + (size_t)row * DM + c * 256 + lane * 4); }
  for (; row < TX; row += stride) {
    float* dst = p.out + (size_t)row * DM;
    float v[16];
#pragma unroll
    for (int c = 0; c < 4; ++c) { v[c * 4] = bflo(nx[c][0]); v[c * 4 + 1] = bfhi(nx[c][0]); v[c * 4 + 2] = bflo(nx[c][1]); v[c * 4 + 3] = bfhi(nx[c][1]); }
    if (row + stride < TX) {
#pragma unroll
      for (int c = 0; c < 4; ++c) nx[c] = *(const u32x2*)(p.pre2 + (size_t)(row + stride) * DM + c * 256 + lane * 4); }
    float s = 0.f;
#pragma unroll
    for (int j = 0; j < 16; ++j) s += v[j];
    const float mu = wave_sum(s) * (1.f / DM);
    float s2 = 0.f;
#pragma unroll
    for (int j = 0; j < 16; ++j) { float d = v[j] - mu; s2 += d * d; }
    const float rstd = rsqrtf(wave_sum(s2) * (1.f / DM) + EPS);
#pragma unroll
    for (int c = 0; c < 4; ++c) {
      const f32x4 g = *(const f32x4*)(p.ln2_g + c * 256 + lane * 4), bb = *(const f32x4*)(p.ln2_b + c * 256 + lane * 4);
      f32x4 o;
#pragma unroll
      for (int j = 0; j < 4; ++j) o[j] = (v[c * 4 + j] - mu) * rstd * g[j] + bb[j];
      *(f32x4*)(dst + c * 256 + lane * 4) = o;
    }
  }
}


#define XB_TMO      128
#define XB_XCNT(j)  (256  + 64 * (j))
#define XB_XSUB(j)  (1280 + 64 * (j))
#define XB_XGEN(j)  (2304 + 64 * (j))
#define XB_TOP      3328
#define XB_TOPGEN   3392
#define XCD_BAR_WORDS 3456
#define XB_SPIN_CAP (1u << 22)
__device__ __forceinline__ unsigned xb_ld(unsigned* p)              { return __hip_atomic_load(p, __ATOMIC_RELAXED, __HIP_MEMORY_SCOPE_AGENT); }
__device__ __forceinline__ unsigned xb_add(unsigned* p, unsigned v) { return __hip_atomic_fetch_add(p, v, __ATOMIC_RELAXED, __HIP_MEMORY_SCOPE_AGENT); }
__device__ __forceinline__ unsigned xb_xcc_id() { return (unsigned)__builtin_amdgcn_s_getreg((3 << 11) | 20) & 0xFu; }
#define XB_SPIN(cond, bar) do { unsigned _sp = 0; while (cond) { __builtin_amdgcn_s_sleep(1); \
    if ((++_sp & 255u) == 0u) { if (xb_ld(&(bar)[XB_TMO])) break; if (_sp > XB_SPIN_CAP) { atomicAdd(&(bar)[XB_TMO], 1u); break; } } } } while (0)
struct XcdBarrier { unsigned* bar; unsigned x; volatile LAS unsigned* st; };
__device__ __forceinline__ XcdBarrier xcd_barrier_post(unsigned* bar, volatile LAS unsigned* st) {
  XcdBarrier b; b.bar = bar; b.x = xb_xcc_id(); b.st = st;
  if (threadIdx.x == 0) (void)xb_add(&bar[XB_XCNT(b.x)], 1u);
  return b;
}
__device__ __forceinline__ void xcd_barrier_complete(unsigned* bar, unsigned x, unsigned& nloc, unsigned& nx) {
  const unsigned G = gridDim.x * gridDim.y * gridDim.z;
  unsigned sum, cnt, mine, sp = 0u;
  for (;;) {
    sum = 0u; cnt = 0u; mine = 0u;
#pragma unroll
    for (unsigned j = 0; j < 16; ++j) { const unsigned c = xb_ld(&bar[XB_XCNT(j)]); sum += c; cnt += (c > 0u) ? 1u : 0u; mine = (j == x) ? c : mine; }
    if (sum == G) break;
    __builtin_amdgcn_s_sleep(1);
    if ((++sp & 255u) == 0u) { if (xb_ld(&bar[XB_TMO])) break; if (sp > XB_SPIN_CAP) { atomicAdd(&bar[XB_TMO], 1u); break; } }
  }
  nloc = mine > 0u ? mine : 1u; nx = cnt > 0u ? cnt : 1u;
}
__device__ __forceinline__ void xcd_barrier(const XcdBarrier& b) {
  asm volatile("s_waitcnt vmcnt(0)" ::: "memory");
  __syncthreads();
  if (threadIdx.x == 0) {
    unsigned* bar = b.bar;
    __builtin_amdgcn_s_waitcnt(0);
    unsigned nloc = b.st[0], nx = b.st[1];
    if (nloc == 0u) { xcd_barrier_complete(bar, b.x, nloc, nx); b.st[0] = nloc; b.st[1] = nx; }
    const unsigned old = xb_add(&bar[XB_XSUB(b.x)], 1u);
    const unsigned gen = old / nloc;
    if (old + 1u == (gen + 1u) * nloc) {
      __builtin_amdgcn_fence(__ATOMIC_RELEASE, "agent");
      asm volatile("s_waitcnt vmcnt(0)" ::: "memory");
      const unsigned og = xb_add(&bar[XB_TOP], 1u);
      const unsigned tg = og / nx;
      if (og + 1u == (tg + 1u) * nx) xb_add(&bar[XB_TOPGEN], 1u);
      else XB_SPIN(xb_ld(&bar[XB_TOPGEN]) == tg, bar);
      __builtin_amdgcn_fence(__ATOMIC_ACQUIRE, "agent");
      xb_add(&bar[XB_XGEN(b.x)], 1u);
      asm volatile("s_waitcnt vmcnt(0)" ::: "memory");
    } else {
      XB_SPIN(xb_ld(&bar[XB_XGEN(b.x)]) == gen, bar);
      __builtin_amdgcn_fence(__ATOMIC_ACQUIRE, "agent");
      asm volatile("s_waitcnt vmcnt(0)" ::: "memory");
    }
  }
  __syncthreads();
}

template <int PH>
__device__ __forceinline__ void run_phase(const Params& p, char* smem) {
  if constexpr (PH == 0) {
    transpose_convert(p.w_in, p.WinT, 1024, 3264, DINP, smem);
    transpose_convert(p.w_uq, p.WuqT, 384, 768, 768, smem);
    for (int i = blockIdx.x * NTHREADS + threadIdx.x; i < 512 * 256; i += gridDim.x * NTHREADS) {
      const int j = i >> 8, k = i & 255;
      const float* src = p.w_ukv + (size_t)k * 1024 + (j >> 6) * 128 + (j & 63);
      p.WkT[i] = f2bf(src[0]); p.WvT[i] = f2bf(src[64]);
    }
    transpose_convert(p.w_out, p.WoutT, 1536, 1024, 1024, smem);
    fold_peer(p, smem);
    ln_in_phase(p);
  } else if constexpr (PH == 1) {
    pg8::run(smem, p.h0, p.WinT, TP, DINP, 1024, pg8::EpiBf16S{p.z, 1024, 1024, p.xbc_raw, 1536, 2560, p.rest, 768});
  } else if constexpr (PH == 2) {
    conv_phase(p, smem);
    token_phase(p);
    dt_phase(p);
  } else if constexpr (PH == 3) {
    pg8::run(smem, p.cqn, p.WuqT, TX, 768, 384, pg8::EpiBf16S{p.q, 768, 1 << 30, nullptr, 0, 1 << 30, nullptr, 0});
    pg8::run(smem, p.ckvn, p.WkT, TP, 512, 256, pg8::EpiBf16S{p.Kb, 512, 1 << 30, nullptr, 0, 1 << 30, nullptr, 0});
    pg8::run(smem, p.WvT, p.ckvn, 512, TP, 256, pg8::EpiBf16S{p.vT, TP, 1 << 30, nullptr, 0, 1 << 30, nullptr, 0});
  } else if constexpr (PH == 4) {
    attn_phase(p, smem);
  } else if constexpr (PH == 5) {
    ssd_phase(p, smem);
  } else if constexpr (PH == 6) {
    gate_phase(p);
  } else if constexpr (PH == 7) {
    pg8::run(smem, p.ycat, p.WoutT, TX, 1024, 1536, pg8::EpiOutRes{p.pre, p.h0});
  } else if constexpr (PH == 8) {
    ln1_phase(p);
    quant_rows<true>(p.peer_u, p.Uq, p.su);
    quant_rows<false>(p.peer_v, p.Vq, p.sv);
  } else if constexpr (PH == 9) {
    pg8::run_drained(smem, p.h1, p.WpT, TX, 2048, 1024, pg8::EpiPeerScore{p.experts, p.gates});
  } else if constexpr (PH == 11) {
    peer_u_phase(p, smem);
  } else if constexpr (PH == 12) {
    peer_c_phase(p);
  } else if constexpr (PH == 13) {
    peer_v_phase(p, smem);
  } else if constexpr (PH == 14) {
    ln2_phase(p);
  } else if constexpr (PH == 15) {
    ssd_diag_phase(p, smem);
  }
}

__global__ void __launch_bounds__(NTHREADS) mega_kernel(Params p) {
  extern __shared__ __attribute__((aligned(16))) char smem[];
  cg::grid_group grid = cg::this_grid();
  volatile LAS unsigned* st = (volatile LAS unsigned*)(smem + LDS_BYTES - 32);
  if (threadIdx.x == 0) {
    st[0] = 0u; st[1] = 0u;
    const unsigned xcc = xb_xcc_id();
    st[2] = xcc; st[3] = xb_add(&p.bar[xcc], 1u);
  }
  __syncthreads();
  XcdBarrier xb = xcd_barrier_post(p.bar, st);
  run_phase<0>(p, smem); grid.sync();
  if (threadIdx.x == 0) {
    unsigned ok = (gridDim.x & 7u) == 0u ? 1u : 0u;
    for (unsigned j = 0; j < 16; ++j) { const unsigned c = xb_ld(&p.bar[j]); if (c != (j < 8 ? gridDim.x >> 3 : 0u)) ok = 0u; }
    st[4] = ok;
  }
  __syncthreads();
  run_phase<1>(p, smem); xcd_barrier(xb);
  run_phase<2>(p, smem); xcd_barrier(xb);
  run_phase<15>(p, smem); xcd_barrier(xb);
  run_phase<5>(p, smem); xcd_barrier(xb);
  run_phase<3>(p, smem); xcd_barrier(xb);
  run_phase<4>(p, smem); xcd_barrier(xb);
  run_phase<6>(p, smem); xcd_barrier(xb);
  run_phase<7>(p, smem); xcd_barrier(xb);
  run_phase<8>(p, smem); xcd_barrier(xb);
  run_phase<9>(p, smem); xcd_barrier(xb);
  run_phase<11>(p, smem); xcd_barrier(xb);
  run_phase<12>(p, smem); xcd_barrier(xb);
  run_phase<13>(p, smem); xcd_barrier(xb);
  run_phase<14>(p, smem);
}

extern "C" void kernel_launch(void* const* d_in, const int* in_sizes, int n_in,
                              void* d_out, int out_size, void* d_ws, size_t ws_size,
                              hipStream_t stream) {
  Params p{};
  const float** in = (const float**)&p.x_prompt;
  for (int i = 0; i < 28; ++i) in[i] = (const float*)d_in[i];
  p.out = (float*)d_out;
  char* ws = (char*)d_ws;
  size_t off = 0;
  auto take = [&](size_t bytes) { char* r = ws + off; off += (bytes + 255) & ~(size_t)255; return r; };
  p.h0 = (bf16_t*)take((size_t)TP * 1024 * 2);
  p.WinT = (bf16_t*)take((size_t)DINP * 1024 * 2);
  p.WuqT = (bf16_t*)take((size_t)768 * 384 * 2);
  p.WkT = (bf16_t*)take((size_t)512 * 256 * 2);
  p.WvT = (bf16_t*)take((size_t)512 * 256 * 2);
  p.WoutT = (bf16_t*)take((size_t)1024 * 1536 * 2);
  p.WpT = (bf16_t*)take((size_t)2048 * 1024 * 2);
  char* zreg = take((size_t)TP * 1024 * 2);
  char* r1 = take((size_t)TP * 1536 * 2);
  char* r2 = take((size_t)TP * 768 * 2);
  p.cqn = (bf16_t*)take((size_t)TP * 384 * 2);
  p.ckvn = (bf16_t*)take((size_t)TP * 256 * 2);
  p.kr = (bf16_t*)take((size_t)TP * 32 * 2);
  p.dtv = (float*)take((size_t)NSEQ * 2 * 16 * LP * 4);
  p.Pv = (float*)take((size_t)NSEQ * 2 * 16 * LP * 4);
  p.Atot = (float*)take((size_t)NSEQ * 2 * 16 * NCH * 4);
  p.bar = (unsigned*)take((size_t)XCD_BAR_WORDS * 4);
  if (off > ws_size) { fprintf(stderr, "workspace too small: need %zu have %zu\n", off, ws_size); return; }
  p.z = (bf16_t*)zreg;
  p.xbc_raw = (bf16_t*)r1;
  p.rest = (bf16_t*)r2;
  char* dout = (char*)d_out;
  p.XT = (bf16_t*)dout;
  p.Cm = (bf16_t*)(dout + (size_t)NSEQ * NCH * 16 * 64 * 128 * 2);
  p.Bm = p.Cm + (size_t)NSEQ * LP * 256;
  p.BmT = p.Bm + (size_t)NSEQ * LP * 256;
  p.pre = (bf16_t*)d_out;
  p.Kb = (bf16_t*)dout;
  p.vT = p.Kb + (size_t)TP * 512;
  p.o = p.vT + (size_t)512 * TP;
  p.Y = (bf16_t*)r1;
  p.Yb2 = p.Y + (size_t)TX * 1024;
  p.q = (bf16_t*)r2;
  p.ycat = (bf16_t*)r2;
  p.h1 = p.h0;
  p.Uq = (unsigned char*)zreg;
  p.Vq = p.Uq + (size_t)8 * 16384 * 128;
  p.su = (float*)(p.Vq + (size_t)8 * 16384 * 128);
  p.sv = p.su + 16384;
  p.sx = p.sv + 16384;
  p.h1q = (unsigned char*)(p.sx + (size_t)TX * 8);
  p.pd = (bf16_t*)d_out;
  p.cq = (unsigned char*)r2;
  p.csc = (float*)(r2 + (size_t)8 * 1024 * 1024);
  p.pre2 = (bf16_t*)(r2 + (size_t)16 * 1024 * 1024);
  p.experts = (unsigned short*)(r1 + (size_t)TX * 256 * 4);
  p.gates = (float*)(r1 + (size_t)TX * 256 * 4 + (size_t)TX * 128 * 4);

  static int grid_blocks = 0;
  if (!grid_blocks) {
    int dev = 0, cus = 0, per_cu = 0;
    (void)hipGetDevice(&dev);
    (void)hipDeviceGetAttribute(&cus, hipDeviceAttributeMultiprocessorCount, dev);
    (void)hipFuncSetAttribute((const void*)mega_kernel, hipFuncAttributeMaxDynamicSharedMemorySize, (int)LDS_BYTES);
    (void)hipOccupancyMaxActiveBlocksPerMultiprocessor(&per_cu, mega_kernel, NTHREADS, LDS_BYTES);
    if (per_cu > 1) per_cu = 1;
    grid_blocks = cus * per_cu;
  }
  (void)hipMemsetAsync(p.bar, 0, (size_t)XCD_BAR_WORDS * 4, stream);
  void* args[] = {&p};
  hipError_t e = hipLaunchCooperativeKernel((void*)mega_kernel, dim3(grid_blocks), dim3(NTHREADS), args, LDS_BYTES, stream);
  if (e != hipSuccess) fprintf(stderr, "cooperative launch failed: %s (grid %d)\n", hipGetErrorString(e), grid_blocks);
}
```

```cpp
#include <hip/hip_runtime.h>
#include <hip/hip_cooperative_groups.h>
#include <cstdio>
#include <cstdint>
namespace cg = cooperative_groups;

typedef unsigned short bf16_t;
typedef short bf16x8 __attribute__((ext_vector_type(8)));
typedef float f32x4 __attribute__((ext_vector_type(4)));
typedef float f32x16 __attribute__((ext_vector_type(16)));
typedef unsigned u32x4 __attribute__((ext_vector_type(4)));
typedef unsigned u32x2 __attribute__((ext_vector_type(2)));

#define NTHREADS 512
#define LAS __attribute__((address_space(3)))
constexpr int DM = 1024;
constexpr int NSEQ = 24, SEQ = 2048, NMETA = 16, LSEQ = 2064;
constexpr int TX = NSEQ * SEQ;
constexpr int TM = TX + NMETA;
constexpr int TP = 49408;
constexpr int LP = 2176, NCH = 17, MPAD = 112;
constexpr int DINP = 3328;
constexpr float EPS = 1e-5f;
constexpr float ALPHA = 1.189207115002721f;
constexpr size_t LDS_BYTES = 160 * 1024;

struct Params {
  const float *x_prompt, *x_sample, *meta, *ln_in_g, *ln_in_b, *w_in, *conv_w, *conv_b,
      *dt_bias_f, *dt_bias_b, *a_log_f, *a_log_b, *d_skip, *ssm_norm_g, *q_norm_g, *w_uq, *kv_norm_g, *w_ukv,
      *attn_norm_g, *w_out, *ln1_g, *ln1_b, *peer_wq, *peer_sk, *peer_u, *peer_v, *ln2_g, *ln2_b;
  float* out;
  bf16_t *h0, *WinT, *WuqT, *WkT, *WvT, *WoutT, *WpT, *z, *xbc_raw, *rest, *cqn, *ckvn, *kr;
  float *dtv, *Pv, *Atot;
  bf16_t *XT, *Cm, *Bm, *BmT;
  bf16_t *q, *Kb, *vT, *o, *Y, *Yb2, *ycat, *h1;
  unsigned char *Uq, *Vq;
  unsigned char* h1q;
  float *su, *sv, *sx;
  bf16_t* pd;
  bf16_t* pre2;
  unsigned char* cq;
  float* csc;
  unsigned* bar;
  bf16_t* pre;
  unsigned short* experts;
  float* gates;
};

__device__ __forceinline__ int phase_tid() { int t = threadIdx.x; asm volatile("" : "+v"(t)); return t; }
__device__ __forceinline__ void lds_barrier() {
  asm volatile("s_waitcnt lgkmcnt(0)" ::: "memory");
  __builtin_amdgcn_s_barrier();
  asm volatile("" ::: "memory");
}
__device__ __forceinline__ float bf2f(bf16_t v) { return __uint_as_float(((unsigned)v) << 16); }
__device__ __forceinline__ float bflo(unsigned v) { return __uint_as_float(v << 16); }
__device__ __forceinline__ float bfhi(unsigned v) { return __uint_as_float(v & 0xffff0000u); }
typedef __bf16 bf16x2_t __attribute__((ext_vector_type(2)));
typedef float f32x2_t __attribute__((ext_vector_type(2)));
__device__ __forceinline__ unsigned pk_bf16(float lo, float hi) {
  f32x2_t f = {lo, hi};
  bf16x2_t b = __builtin_convertvector(f, bf16x2_t);
  return __builtin_bit_cast(unsigned, b);
}
__device__ __forceinline__ bf16_t f2bf(float f) { return (bf16_t)(pk_bf16(f, 0.f) & 0xffffu); }
__device__ __forceinline__ float wave_sum(float v) {
#pragma unroll
  for (int o = 32; o >= 1; o >>= 1) v += __shfl_xor(v, o);
  return v;
}
__device__ __forceinline__ void fast_sincos(float ang, float& sn, float& cs) {
  const float r = __builtin_amdgcn_fractf(ang * 0.15915494309189535f);
  sn = __builtin_amdgcn_sinf(r); cs = __builtin_amdgcn_cosf(r);
}
__device__ __forceinline__ float silu_f(float x) { return x * __builtin_amdgcn_rcpf(1.f + __expf(-x)); }
__device__ __forceinline__ int row_of(int seq, int pos) { return pos < NMETA ? TX + pos : seq * SEQ + pos - NMETA; }
__device__ __forceinline__ bf16x8 as_bf16x8(u32x4 v) { return __builtin_bit_cast(bf16x8, v); }

__device__ void transpose_convert(const float* in, bf16_t* out, int R, int C, int CP, char* smem) {
  float* tile = (float*)smem;
  const int tr = (R + 63) / 64, tc = (CP + 63) / 64;
  for (int t = blockIdx.x; t < tr * tc; t += gridDim.x) {
    const int r0 = (t / tc) * 64, c0 = (t % tc) * 64;
    __syncthreads();
    for (int i = phase_tid(); i < 4096; i += NTHREADS) {
      int r = i >> 6, c = i & 63;
      float v = 0.f;
      if (r0 + r < R && c0 + c < C) v = in[(size_t)(r0 + r) * C + c0 + c];
      tile[r * 65 + c] = v;
    }
    __syncthreads();
    for (int i = phase_tid(); i < 4096; i += NTHREADS) {
      int c = i >> 6, r = i & 63;
      if (r0 + r < R && c0 + c < CP) out[(size_t)(c0 + c) * R + r0 + r] = f2bf(tile[r * 65 + c]);
    }
  }
}

__device__ void fold_peer(const Params& p, char* smem) {
  float* wq_s = (float*)smem;
  float* sk_s = wq_s + 32 * 128;
  for (int item = blockIdx.x; item < 16 * 32; item += gridDim.x) {
    const int hj2 = item >> 5, k0 = (item & 31) * 32;
    const int h = hj2 >> 1, j = hj2 & 1;
    const float* skp = p.peer_sk + (size_t)(j * 8 + h) * 128 * 128;
    __syncthreads();
    for (int i = phase_tid(); i < 32 * 128; i += NTHREADS) {
      int k = i >> 7, d = i & 127;
      wq_s[i] = p.peer_wq[(size_t)(k0 + k) * 2048 + hj2 * 128 + d];
    }
    for (int i = phase_tid(); i < 128 * 128; i += NTHREADS) {
      int n = i >> 7, d = i & 127;
      sk_s[n * 129 + d] = skp[i];
    }
    __syncthreads();
    const int n = phase_tid() & 127, kq = phase_tid() >> 7;
    float acc[8];
#pragma unroll
    for (int i = 0; i < 8; ++i) acc[i] = 0.f;
    for (int d = 0; d < 128; ++d) {
      float s = sk_s[n * 129 + d];
#pragma unroll
      for (int i = 0; i < 8; ++i) acc[i] += wq_s[(kq * 8 + i) * 128 + d] * s;
    }
    u32x4 v;
    v[0] = pk_bf16(acc[0], acc[1]); v[1] = pk_bf16(acc[2], acc[3]);
    v[2] = pk_bf16(acc[4], acc[5]); v[3] = pk_bf16(acc[6], acc[7]);
    *(u32x4*)(p.WpT + (size_t)(hj2 * 128 + n) * 1024 + k0 + kq * 8) = v;
  }
}

__device__ void ln_in_phase(const Params& p) {
  const int lane = phase_tid() & 63, wid = phase_tid() >> 6;
  const int stride = gridDim.x * 8;
  auto src_of = [&](int row) -> const float* {
    return row < 8 * SEQ ? p.x_prompt + (size_t)row * DM : row < TX ? p.x_sample + (size_t)(row - 8 * SEQ) * DM : p.meta + (size_t)(row - TX) * DM;
  };
  int row = blockIdx.x * 8 + wid;
  f32x4 nx[4];
  if (row < TM) { const float* sp = src_of(row);
#pragma unroll
    for (int c = 0; c < 4; ++c) nx[c] = *(const f32x4*)(sp + c * 256 + lane * 4); }
  for (; row < TP; row += stride) {
    bf16_t* dst = p.h0 + (size_t)row * DM;
    if (row >= TM) {
      u32x4 zv = {0u, 0u, 0u, 0u};
      *(u32x4*)(dst + lane * 8) = zv; *(u32x4*)(dst + 512 + lane * 8) = zv;
      continue;
    }
    float v[16];
#pragma unroll
    for (int c = 0; c < 4; ++c)
#pragma unroll
      for (int j = 0; j < 4; ++j) v[c * 4 + j] = nx[c][j];
    if (row + stride < TM) { const float* sp = src_of(row + stride);
#pragma unroll
      for (int c = 0; c < 4; ++c) nx[c] = *(const f32x4*)(sp + c * 256 + lane * 4); }
    float s = 0.f;
#pragma unroll
    for (int j = 0; j < 16; ++j) s += v[j];
    const float mu = wave_sum(s) * (1.f / DM);
    float s2 = 0.f;
#pragma unroll
    for (int j = 0; j < 16; ++j) { float d = v[j] - mu; s2 += d * d; }
    const float rstd = rsqrtf(wave_sum(s2) * (1.f / DM) + EPS);
#pragma unroll
    for (int c = 0; c < 4; ++c) {
      const f32x4 g = *(const f32x4*)(p.ln_in_g + c * 256 + lane * 4), bb = *(const f32x4*)(p.ln_in_b + c * 256 + lane * 4);
      float o[4];
#pragma unroll
      for (int j = 0; j < 4; ++j) o[j] = (v[c * 4 + j] - mu) * rstd * g[j] + bb[j];
      *(u32x2*)(dst + c * 256 + lane * 4) = (u32x2){pk_bf16(o[0], o[1]), pk_bf16(o[2], o[3])};
    }
  }
}

__device__ __forceinline__ u32x4 pack8(const float (&v)[8]) {
  u32x4 w;
  w[0] = pk_bf16(v[0], v[1]); w[1] = pk_bf16(v[2], v[3]); w[2] = pk_bf16(v[4], v[5]); w[3] = pk_bf16(v[6], v[7]);
  return w;
}
__device__ __forceinline__ unsigned fkey(float f) {
  unsigned u = __float_as_uint(f);
  return u ^ (((unsigned)((int)u >> 31)) | 0x80000000u);
}
__device__ __forceinline__ float keyf(unsigned k) {
  unsigned u = (k & 0x80000000u) ? (k ^ 0x80000000u) : ~k;
  return __uint_as_float(u);
}
__device__ __forceinline__ void sort16_desc(unsigned (&v)[16]) {
  { unsigned _h = max(v[0], v[13]); v[13] = min(v[0], v[13]); v[0] = _h; }
  { unsigned _h = max(v[1], v[12]); v[12] = min(v[1], v[12]); v[1] = _h; }
  { unsigned _h = max(v[2], v[15]); v[15] = min(v[2], v[15]); v[2] = _h; }
  { unsigned _h = max(v[3], v[14]); v[14] = min(v[3], v[14]); v[3] = _h; }
  { unsigned _h = max(v[4], v[8]); v[8] = min(v[4], v[8]); v[4] = _h; }
  { unsigned _h = max(v[5], v[6]); v[6] = min(v[5], v[6]); v[5] = _h; }
  { unsigned _h = max(v[7], v[11]); v[11] = min(v[7], v[11]); v[7] = _h; }
  { unsigned _h = max(v[9], v[10]); v[10] = min(v[9], v[10]); v[9] = _h; }
  { unsigned _h = max(v[0], v[5]); v[5] = min(v[0], v[5]); v[0] = _h; }
  { unsigned _h = max(v[1], v[7]); v[7] = min(v[1], v[7]); v[1] = _h; }
  { unsigned _h = max(v[2], v[9]); v[9] = min(v[2], v[9]); v[2] = _h; }
  { unsigned _h = max(v[3], v[4]); v[4] = min(v[3], v[4]); v[3] = _h; }
  { unsigned _h = max(v[6], v[13]); v[13] = min(v[6], v[13]); v[6] = _h; }
  { unsigned _h = max(v[8], v[14]); v[14] = min(v[8], v[14]); v[8] = _h; }
  { unsigned _h = max(v[10], v[15]); v[15] = min(v[10], v[15]); v[10] = _h; }
  { unsigned _h = max(v[11], v[12]); v[12] = min(v[11], v[12]); v[11] = _h; }
  { unsigned _h = max(v[0], v[1]); v[1] = min(v[0], v[1]); v[0] = _h; }
  { unsigned _h = max(v[2], v[3]); v[3] = min(v[2], v[3]); v[2] = _h; }
  { unsigned _h = max(v[4], v[5]); v[5] = min(v[4], v[5]); v[4] = _h; }
  { unsigned _h = max(v[6], v[8]); v[8] = min(v[6], v[8]); v[6] = _h; }
  { unsigned _h = max(v[7], v[9]); v[9] = min(v[7], v[9]); v[7] = _h; }
  { unsigned _h = max(v[10], v[11]); v[11] = min(v[10], v[11]); v[10] = _h; }
  { unsigned _h = max(v[12], v[13]); v[13] = min(v[12], v[13]); v[12] = _h; }
  { unsigned _h = max(v[14], v[15]); v[15] = min(v[14], v[15]); v[14] = _h; }
  { unsigned _h = max(v[0], v[2]); v[2] = min(v[0], v[2]); v[0] = _h; }
  { unsigned _h = max(v[1], v[3]); v[3] = min(v[1], v[3]); v[1] = _h; }
  { unsigned _h = max(v[4], v[10]); v[10] = min(v[4], v[10]); v[4] = _h; }
  { unsigned _h = max(v[5], v[11]); v[11] = min(v[5], v[11]); v[5] = _h; }
  { unsigned _h = max(v[6], v[7]); v[7] = min(v[6], v[7]); v[6] = _h; }
  { unsigned _h = max(v[8], v[9]); v[9] = min(v[8], v[9]); v[8] = _h; }
  { unsigned _h = max(v[12], v[14]); v[14] = min(v[12], v[14]); v[12] = _h; }
  { unsigned _h = max(v[13], v[15]); v[15] = min(v[13], v[15]); v[13] = _h; }
  { unsigned _h = max(v[1], v[2]); v[2] = min(v[1], v[2]); v[1] = _h; }
  { unsigned _h = max(v[3], v[12]); v[12] = min(v[3], v[12]); v[3] = _h; }
  { unsigned _h = max(v[4], v[6]); v[6] = min(v[4], v[6]); v[4] = _h; }
  { unsigned _h = max(v[5], v[7]); v[7] = min(v[5], v[7]); v[5] = _h; }
  { unsigned _h = max(v[8], v[10]); v[10] = min(v[8], v[10]); v[8] = _h; }
  { unsigned _h = max(v[9], v[11]); v[11] = min(v[9], v[11]); v[9] = _h; }
  { unsigned _h = max(v[13], v[14]); v[14] = min(v[13], v[14]); v[13] = _h; }
  { unsigned _h = max(v[1], v[4]); v[4] = min(v[1], v[4]); v[1] = _h; }
  { unsigned _h = max(v[2], v[6]); v[6] = min(v[2], v[6]); v[2] = _h; }
  { unsigned _h = max(v[5], v[8]); v[8] = min(v[5], v[8]); v[5] = _h; }
  { unsigned _h = max(v[7], v[10]); v[10] = min(v[7], v[10]); v[7] = _h; }
  { unsigned _h = max(v[9], v[13]); v[13] = min(v[9], v[13]); v[9] = _h; }
  { unsigned _h = max(v[11], v[14]); v[14] = min(v[11], v[14]); v[11] = _h; }
  { unsigned _h = max(v[2], v[4]); v[4] = min(v[2], v[4]); v[2] = _h; }
  { unsigned _h = max(v[3], v[6]); v[6] = min(v[3], v[6]); v[3] = _h; }
  { unsigned _h = max(v[9], v[12]); v[12] = min(v[9], v[12]); v[9] = _h; }
  { unsigned _h = max(v[11], v[13]); v[13] = min(v[11], v[13]); v[11] = _h; }
  { unsigned _h = max(v[3], v[5]); v[5] = min(v[3], v[5]); v[3] = _h; }
  { unsigned _h = max(v[6], v[8]); v[8] = min(v[6], v[8]); v[6] = _h; }
  { unsigned _h = max(v[7], v[9]); v[9] = min(v[7], v[9]); v[7] = _h; }
  { unsigned _h = max(v[10], v[12]); v[12] = min(v[10], v[12]); v[10] = _h; }
  { unsigned _h = max(v[3], v[4]); v[4] = min(v[3], v[4]); v[3] = _h; }
  { unsigned _h = max(v[5], v[6]); v[6] = min(v[5], v[6]); v[5] = _h; }
  { unsigned _h = max(v[7], v[8]); v[8] = min(v[7], v[8]); v[7] = _h; }
  { unsigned _h = max(v[9], v[10]); v[10] = min(v[9], v[10]); v[9] = _h; }
  { unsigned _h = max(v[11], v[12]); v[12] = min(v[11], v[12]); v[11] = _h; }
  { unsigned _h = max(v[6], v[7]); v[7] = min(v[6], v[7]); v[6] = _h; }
  { unsigned _h = max(v[8], v[9]); v[9] = min(v[8], v[9]); v[8] = _h; }
}
__device__ __forceinline__ void merge16_desc(unsigned (&v)[16], const unsigned (&o)[16]) {
  v[0] = max(v[0], o[15]);
  v[1] = max(v[1], o[14]);
  v[2] = max(v[2], o[13]);
  v[3] = max(v[3], o[12]);
  v[4] = max(v[4], o[11]);
  v[5] = max(v[5], o[10]);
  v[6] = max(v[6], o[9]);
  v[7] = max(v[7], o[8]);
  v[8] = max(v[8], o[7]);
  v[9] = max(v[9], o[6]);
  v[10] = max(v[10], o[5]);
  v[11] = max(v[11], o[4]);
  v[12] = max(v[12], o[3]);
  v[13] = max(v[13], o[2]);
  v[14] = max(v[14], o[1]);
  v[15] = max(v[15], o[0]);
  { unsigned _h = max(v[0], v[8]); v[8] = min(v[0], v[8]); v[0] = _h; }
  { unsigned _h = max(v[1], v[9]); v[9] = min(v[1], v[9]); v[1] = _h; }
  { unsigned _h = max(v[2], v[10]); v[10] = min(v[2], v[10]); v[2] = _h; }
  { unsigned _h = max(v[3], v[11]); v[11] = min(v[3], v[11]); v[3] = _h; }
  { unsigned _h = max(v[4], v[12]); v[12] = min(v[4], v[12]); v[4] = _h; }
  { unsigned _h = max(v[5], v[13]); v[13] = min(v[5], v[13]); v[5] = _h; }
  { unsigned _h = max(v[6], v[14]); v[14] = min(v[6], v[14]); v[6] = _h; }
  { unsigned _h = max(v[7], v[15]); v[15] = min(v[7], v[15]); v[7] = _h; }
  { unsigned _h = max(v[0], v[4]); v[4] = min(v[0], v[4]); v[0] = _h; }
  { unsigned _h = max(v[1], v[5]); v[5] = min(v[1], v[5]); v[1] = _h; }
  { unsigned _h = max(v[2], v[6]); v[6] = min(v[2], v[6]); v[2] = _h; }
  { unsigned _h = max(v[3], v[7]); v[7] = min(v[3], v[7]); v[3] = _h; }
  { unsigned _h = max(v[8], v[12]); v[12] = min(v[8], v[12]); v[8] = _h; }
  { unsigned _h = max(v[9], v[13]); v[13] = min(v[9], v[13]); v[9] = _h; }
  { unsigned _h = max(v[10], v[14]); v[14] = min(v[10], v[14]); v[10] = _h; }
  { unsigned _h = max(v[11], v[15]); v[15] = min(v[11], v[15]); v[11] = _h; }
  { unsigned _h = max(v[0], v[2]); v[2] = min(v[0], v[2]); v[0] = _h; }
  { unsigned _h = max(v[1], v[3]); v[3] = min(v[1], v[3]); v[1] = _h; }
  { unsigned _h = max(v[4], v[6]); v[6] = min(v[4], v[6]); v[4] = _h; }
  { unsigned _h = max(v[5], v[7]); v[7] = min(v[5], v[7]); v[5] = _h; }
  { unsigned _h = max(v[8], v[10]); v[10] = min(v[8], v[10]); v[8] = _h; }
  { unsigned _h = max(v[9], v[11]); v[11] = min(v[9], v[11]); v[9] = _h; }
  { unsigned _h = max(v[12], v[14]); v[14] = min(v[12], v[14]); v[12] = _h; }
  { unsigned _h = max(v[13], v[15]); v[15] = min(v[13], v[15]); v[13] = _h; }
  { unsigned _h = max(v[0], v[1]); v[1] = min(v[0], v[1]); v[0] = _h; }
  { unsigned _h = max(v[2], v[3]); v[3] = min(v[2], v[3]); v[2] = _h; }
  { unsigned _h = max(v[4], v[5]); v[5] = min(v[4], v[5]); v[4] = _h; }
  { unsigned _h = max(v[6], v[7]); v[7] = min(v[6], v[7]); v[6] = _h; }
  { unsigned _h = max(v[8], v[9]); v[9] = min(v[8], v[9]); v[8] = _h; }
  { unsigned _h = max(v[10], v[11]); v[11] = min(v[10], v[11]); v[10] = _h; }
  { unsigned _h = max(v[12], v[13]); v[13] = min(v[12], v[13]); v[12] = _h; }
  { unsigned _h = max(v[14], v[15]); v[15] = min(v[14], v[15]); v[14] = _h; }
}
#define TOPK_INSERT_FROM(V, X, J0) { _Pragma("unroll") for (int _j = (J0); _j < 16; ++_j) { unsigned _hi = max(V[_j], X); X = min(V[_j], X); V[_j] = _hi; } }
#define TOPK_INSERT(V, X) { _Pragma("unroll") for (int _j = 0; _j < 16; ++_j) { unsigned _hi = max(V[_j], X); X = min(V[_j], X); V[_j] = _hi; } }

namespace pg8 {
constexpr int BM = 256, BK = 64, HALF = 128, HTB = HALF * BK * 2, STAGE_BYTES = 8 * HTB, NXCD = 8, WGM = 8;
__device__ __forceinline__ int lds_byte(int r, int c) { const int st = (r >> 4) * 2 + (c >> 5), rr = r & 15, cc = c & 31, ob = rr * 64 + cc * 2; return st * 1024 + (ob ^ (((ob >> 9) & 1) << 5)); }
__device__ __forceinline__ void stage_rc(int b, int& R, int& C) { const int st = b / 1024, sb = b % 1024, swz = sb ^ (((sb >> 9) & 1) << 5); R = (st >> 1) * 16 + swz / 64; C = (st & 1) * 32 + (swz % 64) / 2; }
__device__ __forceinline__ int perm32(int rho) { const int n = rho >> 4, i = rho & 15; return 8 * (i >> 2) + 4 * n + (i & 3); }
struct Unit { int pm, pn; };
struct Gemm { const bf16_t* A; const bf16_t* Bt; int M, N, K; };
struct StaticOrder {
  int nM, nN, nwg, G, c;
  __device__ void init(int M, int N, int G_, int c_) { nM = M / BM; nN = N / BM; nwg = nM * nN; G = G_; c = c_; }
  __device__ bool next(int i, Unit& u) const {
    const long L = (long)i * G + c; if (L >= nwg) return false;
    int wgid = (int)L; { const int q = nwg / NXCD, r = nwg % NXCD, xcd = wgid % NXCD, off = wgid / NXCD; wgid = (xcd < r ? xcd * (q + 1) : r * (q + 1) + (xcd - r) * q) + off; }
    const int nig = WGM * nN, gid = wgid / nig, fm = gid * WGM, gsz = (nM - fm) < WGM ? (nM - fm) : WGM;
    u.pm = fm + ((wgid % nig) % gsz); u.pn = (wgid % nig) / gsz; return true;
  }
  __device__ __forceinline__ void a_ready(const Unit&) const {}
  __device__ __forceinline__ void done(const Unit&) const {}
};
template <class Epi, class Sched>
__device__ __forceinline__ void gemm_phase(LAS unsigned char* lds, const Gemm g, const Sched& S, const Epi& E) {
  const int tid = phase_tid(), wid = __builtin_amdgcn_readfirstlane(tid >> 6), lane = tid & 63, wr = wid >> 2, wc = wid & 3, fr = lane & 15, fq = lane >> 4;
  const int K = g.K, nt = K / BK;
  unsigned voffA[2], voffB[2];
#pragma unroll
  for (int i = 0; i < 2; ++i) { int R, C; stage_rc(tid * 16 + i * 8192, R, C); const int Rb = Epi::PERM ? ((R & ~31) + perm32(R & 31)) : R;
    voffA[i] = (unsigned)(R * K + C) * 2u; voffB[i] = (unsigned)(Rb * K + C) * 2u; }
  const size_t kstep = (size_t)(BK * 2);
  const size_t hstep = (size_t)HALF * K * 2;
  const size_t tstep = 2 * hstep;
  const unsigned ldsw = (unsigned)wid * 1024u;
  const int aoff = lds_byte(wr * 64 + fr, fq * 8), boff = lds_byte(wc * 32 + fr, fq * 8);
#define PG8_SA(b, h) (((b) * 2 + (h)) * HTB)
#define PG8_SB(b, h) ((4 + (b) * 2 + (h)) * HTB)
#define PG8_STAGE(bufoff, gbase, voff) do { _Pragma("unroll") for (int _i = 0; _i < 2; ++_i) \
    __builtin_amdgcn_global_load_lds((const unsigned*)((const char*)(gbase) + (voff)[_i]), (LAS unsigned*)(lds + (bufoff) + ldsw + _i * 8192), 16, 0, 0); } while (0)
#define PG8_LDA(dst, b, h) do { _Pragma("unroll") for (int m = 0; m < 4; ++m) _Pragma("unroll") for (int k = 0; k < 2; ++k) dst[m][k] = *(const LAS bf16x8*)(lds + PG8_SA(b, h) + aoff + m * 2048 + k * 1024); } while (0)
#define PG8_LDB(dst, b, h) do { _Pragma("unroll") for (int n = 0; n < 2; ++n) _Pragma("unroll") for (int k = 0; k < 2; ++k) dst[n][k] = *(const LAS bf16x8*)(lds + PG8_SB(b, h) + boff + n * 2048 + k * 1024); } while (0)
#define PG8_MMA(ai, bj, At, Bt) do { __builtin_amdgcn_s_setprio(1); _Pragma("unroll") for (int m = 0; m < 4; ++m) _Pragma("unroll") for (int n = 0; n < 2; ++n) _Pragma("unroll") for (int k = 0; k < 2; ++k) \
    acc[ai][bj][m][n] = __builtin_amdgcn_mfma_f32_16x16x32_bf16(Bt[n][k], At[m][k], acc[ai][bj][m][n], 0, 0, 0); __builtin_amdgcn_s_setprio(0); } while (0)
#define PG8_WAIT_V(n) asm volatile("s_waitcnt vmcnt(" #n ")" ::: "memory")
#define PG8_WAIT_L(n) asm volatile("s_waitcnt lgkmcnt(" #n ")" ::: "memory")
#define PG8_BAR __builtin_amdgcn_s_barrier()
#define PG8_SCHED __builtin_amdgcn_sched_barrier(0)
  Unit cur, nxt; int ui = 0;
  if (!S.next(0, cur)) return;
  f32x4 acc[2][2][4][2];
#pragma unroll
  for (int a = 0; a < 2; ++a)
#pragma unroll
    for (int b = 0; b < 2; ++b)
#pragma unroll
      for (int m = 0; m < 4; ++m)
#pragma unroll
        for (int n = 0; n < 2; ++n) acc[a][b][m][n] = (f32x4){0.f, 0.f, 0.f, 0.f};
  bf16x8 At[4][2], B0[2][2], B1[2][2];
  const char* cA = (const char*)g.A + (size_t)cur.pm * tstep; const char* cB = (const char*)g.Bt + (size_t)cur.pn * tstep;
  S.a_ready(cur);
  PG8_STAGE(PG8_SB(0, 0), cB, voffB); PG8_STAGE(PG8_SA(0, 0), cA, voffA); PG8_STAGE(PG8_SB(0, 1), cB + hstep, voffB); PG8_STAGE(PG8_SA(0, 1), cA + hstep, voffA);
  if (wr == 1) PG8_BAR;
  PG8_WAIT_V(4); PG8_BAR;
  PG8_STAGE(PG8_SB(1, 0), cB + kstep, voffB); PG8_STAGE(PG8_SA(1, 0), cA + kstep, voffA); PG8_STAGE(PG8_SB(1, 1), cB + hstep + kstep, voffB);
  PG8_WAIT_V(6); PG8_BAR;
  for (;;) {
    const bool has_next = S.next(ui + 1, nxt);
    const char* nA = has_next ? (const char*)g.A + (size_t)nxt.pm * tstep : cA; const char* nB = has_next ? (const char*)g.Bt + (size_t)nxt.pn * tstep : cB;
    for (int t = 0; t < nt; t += 2) {
      const bool last = (t == nt - 2);
      const char* a1 = cA + (size_t)(t + 1) * kstep;
      const char* a2 = last ? nA : cA + (size_t)(t + 2) * kstep; const char* b2 = last ? nB : cB + (size_t)(t + 2) * kstep;
      const char* a3 = a2 + kstep; const char* b3 = b2 + kstep;
      if (last && has_next) S.a_ready(nxt);
      PG8_LDB(B0, 0, 0); PG8_SCHED; PG8_LDA(At, 0, 0); PG8_STAGE(PG8_SA(1, 1), a1 + hstep, voffA);
      PG8_WAIT_L(8); PG8_BAR; PG8_WAIT_L(0); PG8_MMA(0, 0, At, B0); PG8_BAR; PG8_SCHED;
      PG8_LDB(B1, 0, 1); PG8_STAGE(PG8_SB(0, 0), b2, voffB);
      PG8_BAR; PG8_WAIT_L(0); PG8_MMA(0, 1, At, B1); PG8_BAR;
      PG8_LDA(At, 0, 1); PG8_STAGE(PG8_SA(0, 0), a2, voffA);
      PG8_BAR; PG8_WAIT_L(0); PG8_MMA(1, 0, At, B0); PG8_BAR; PG8_SCHED;
      PG8_STAGE(PG8_SB(0, 1), b2 + hstep, voffB);
      PG8_WAIT_V(6); PG8_BAR; PG8_MMA(1, 1, At, B1); PG8_BAR;
      PG8_LDB(B0, 1, 0); PG8_SCHED; PG8_LDA(At, 1, 0); PG8_STAGE(PG8_SA(0, 1), a2 + hstep, voffA);
      PG8_WAIT_L(8); PG8_BAR; PG8_WAIT_L(0); PG8_MMA(0, 0, At, B0); PG8_BAR; PG8_SCHED;
      PG8_LDB(B1, 1, 1); PG8_STAGE(PG8_SB(1, 0), b3, voffB);
      PG8_BAR; PG8_WAIT_L(0); PG8_MMA(0, 1, At, B1); PG8_BAR;
      PG8_LDA(At, 1, 1); PG8_STAGE(PG8_SA(1, 0), a3, voffA);
      PG8_BAR; PG8_WAIT_L(0); PG8_MMA(1, 0, At, B0); PG8_BAR; PG8_SCHED;
      PG8_STAGE(PG8_SB(1, 1), b3 + hstep, voffB);
      PG8_WAIT_V(6); PG8_BAR; PG8_MMA(1, 1, At, B1); PG8_BAR;
    }
    if constexpr (!Epi::AFTER_DRAIN) { E(acc, cur, wr, wc, fr, fq); S.done(cur); }
    if (!has_next) break;
#pragma unroll
    for (int a = 0; a < 2; ++a)
#pragma unroll
      for (int b = 0; b < 2; ++b)
#pragma unroll
        for (int m = 0; m < 4; ++m)
#pragma unroll
          for (int n = 0; n < 2; ++n) acc[a][b][m][n] = (f32x4){0.f, 0.f, 0.f, 0.f};
    cur = nxt; cA = nA; cB = nB; ++ui;
  }
  PG8_WAIT_V(0);
  if (wr == 0) PG8_BAR;
  PG8_BAR;
  if constexpr (Epi::AFTER_DRAIN) { E.fused(acc, cur, wr, wc, fr, fq, (char*)lds); S.done(cur); }
#undef PG8_SA
#undef PG8_SB
#undef PG8_STAGE
#undef PG8_LDA
#undef PG8_LDB
#undef PG8_MMA
#undef PG8_WAIT_V
#undef PG8_WAIT_L
#undef PG8_BAR
#undef PG8_SCHED
}
struct EpiBf16S {
  static constexpr bool PERM = true, AFTER_DRAIN = false;
  bf16_t* d0; int ld0; int c0; bf16_t* d1; int ld1; int c1; bf16_t* d2; int ld2;
  __device__ __forceinline__ void operator()(const f32x4 (&acc)[2][2][4][2], const Unit& u, int wr, int wc, int fr, int fq) const {
    const int colt = u.pn * BM;
    bf16_t* base; int ld;
    if (colt < c0) { base = d0 + colt; ld = ld0; } else if (colt < c1) { base = d1 + (colt - c0); ld = ld1; } else { base = d2 + (colt - c1); ld = ld2; }
    const int L = fq * 16 + fr;
    const int srcl = ((L & 3) * 16 + (L >> 2)) * 4;
    const int row0 = u.pm * BM + wr * 64 + (L >> 2), col0 = wc * 32 + 8 * (L & 3);
#pragma unroll
    for (int ai = 0; ai < 2; ++ai)
#pragma unroll
      for (int m = 0; m < 4; ++m) {
        bf16_t* rowp = base + (size_t)(row0 + ai * HALF + m * 16) * ld + col0;
#pragma unroll
        for (int bj = 0; bj < 2; ++bj) {
          const f32x4 v0 = acc[ai][bj][m][0], v1 = acc[ai][bj][m][1];
          u32x4 w; w[0] = pk_bf16(v0[0], v0[1]); w[1] = pk_bf16(v0[2], v0[3]); w[2] = pk_bf16(v1[0], v1[1]); w[3] = pk_bf16(v1[2], v1[3]);
          u32x4 x;
#pragma unroll
          for (int k = 0; k < 4; ++k) x[k] = (unsigned)__builtin_amdgcn_ds_bpermute(srcl, (int)w[k]);
          *(u32x4*)(rowp + bj * HALF) = x;
        }
      }
  }
};
struct EpiOutRes {
  static constexpr bool PERM = true, AFTER_DRAIN = false;
  bf16_t* pre; const bf16_t* h0;
  __device__ __forceinline__ void operator()(const f32x4 (&acc)[2][2][4][2], const Unit& u, int wr, int wc, int fr, int fq) const {
    const int row0 = u.pm * BM + wr * 64 + fr, col0 = u.pn * BM + wc * 32 + 8 * fq;
#pragma unroll
    for (int ai = 0; ai < 2; ++ai)
#pragma unroll
      for (int m = 0; m < 4; ++m) {
        const size_t off = (size_t)(row0 + ai * HALF + m * 16) * 1024 + col0;
#pragma unroll
        for (int bj = 0; bj < 2; ++bj) {
          const size_t o = off + bj * HALF;
          const u32x4 h = *(const u32x4*)(h0 + o);
          const f32x4 v0 = acc[ai][bj][m][0], v1 = acc[ai][bj][m][1];
          u32x4 w;
          w[0] = pk_bf16(v0[0] + ALPHA * bflo(h[0]), v0[1] + ALPHA * bfhi(h[0]));
          w[1] = pk_bf16(v0[2] + ALPHA * bflo(h[1]), v0[3] + ALPHA * bfhi(h[1]));
          w[2] = pk_bf16(v1[0] + ALPHA * bflo(h[2]), v1[1] + ALPHA * bfhi(h[2]));
          w[3] = pk_bf16(v1[2] + ALPHA * bflo(h[3]), v1[3] + ALPHA * bfhi(h[3]));
          *(u32x4*)(pre + o) = w;
        }
      }
  }
};
struct OneUnit {
  Unit u;
  __device__ bool next(int i, Unit& o) const { if (i) return false; o = u; return true; }
  __device__ __forceinline__ void a_ready(const Unit&) const {}
  __device__ __forceinline__ void done(const Unit&) const {}
};
struct EpiPeerScore {
  static constexpr bool PERM = false, AFTER_DRAIN = true;
  unsigned short* experts; float* gates;
  static constexpr int LDC = 260;
  __device__ void fused(const f32x4 (&acc)[2][2][4][2], const Unit& u, int wr, int wc, int fr, int fq, char* smem) const {
    float* Ct = (float*)smem;
    unsigned char* ibase = (unsigned char*)smem + 128 * LDC * 4;
    const int tid = phase_tid();
    const int row = tid >> 2, j = (tid >> 1) & 1, half = tid & 1;
#pragma unroll
    for (int ai = 0; ai < 2; ++ai) {
#pragma unroll
      for (int bj = 0; bj < 2; ++bj)
#pragma unroll
        for (int m = 0; m < 4; ++m)
#pragma unroll
          for (int n = 0; n < 2; ++n)
            *(f32x4*)(Ct + (wr * 64 + m * 16 + fr) * LDC + bj * 128 + wc * 32 + n * 16 + 4 * fq) = acc[ai][bj][m][n];
      lds_barrier();
      unsigned v[16];
      const float* rowp = Ct + row * LDC + j * 128 + half * 64;
#pragma unroll
      for (int grp = 0; grp < 4; ++grp) {
        unsigned o[16];
#pragma unroll
        for (int c4 = 0; c4 < 4; ++c4) {
          f32x4 sv = *(const f32x4*)(rowp + grp * 16 + c4 * 4);
#pragma unroll
          for (int k = 0; k < 4; ++k) o[c4 * 4 + k] = (fkey(sv[k]) & ~127u) | (unsigned)(127 - (half * 64 + grp * 16 + c4 * 4 + k));
        }
        sort16_desc(o);
        if (grp == 0) {
#pragma unroll
          for (int k = 0; k < 16; ++k) v[k] = o[k];
        } else merge16_desc(v, o);
      }
      {
        unsigned o[16];
#pragma unroll
        for (int k = 0; k < 16; ++k) o[k] = __shfl_xor(v[k], 1);
        merge16_desc(v, o);
      }
      unsigned w[16];
#pragma unroll
      for (int k = 0; k < 16; ++k) w[k] = __shfl_xor(v[k], 2);
      unsigned v0[16], v1[16];
#pragma unroll
      for (int k = 0; k < 16; ++k) { unsigned a0 = v[k], b0 = w[k]; asm volatile("" : "+v"(a0), "+v"(b0)); v0[k] = j ? b0 : a0; v1[k] = j ? a0 : b0; }
      unsigned char* ib = ibase + row * 32;
      if ((tid & 3) == 0) {
#pragma unroll
        for (int q4 = 0; q4 < 4; ++q4) {
          unsigned x0 = 0u, x1 = 0u;
#pragma unroll
          for (int k = 0; k < 4; ++k) { x0 |= (127u - (v0[q4 * 4 + k] & 127u)) << (8 * k); x1 |= (127u - (v1[q4 * 4 + k] & 127u)) << (8 * k); }
          ((unsigned*)ib)[q4] = x0; ((unsigned*)ib)[4 + q4] = x1;
        }
      }
      float f1[16], f2[16];
#pragma unroll
      for (int k = 0; k < 16; ++k) { f1[k] = keyf(v0[k] & ~127u); f2[k] = keyf(v1[k] & ~127u); }
      unsigned c[16];
      {
        const int qd_ = tid & 3;
        const bool q1 = qd_ == 1, q2 = qd_ == 2, q3 = qd_ == 3;
        { const float xa = f1[0], xb = (q3 ? f2[3] : (q2 ? f2[2] : (q1 ? f2[1] : f2[0]))); const unsigned tg = (q3 ? 252u : (q2 ? 253u : (q1 ? 254u : 255u))); c[0] = (fkey(xa + xb) & ~255u) | tg; }
        { const float xa = f1[0], xb = (q3 ? f2[7] : (q2 ? f2[6] : (q1 ? f2[5] : f2[4]))); const unsigned tg = (q3 ? 248u : (q2 ? 249u : (q1 ? 250u : 251u))); c[1] = (fkey(xa + xb) & ~255u) | tg; }
        { const float xa = f1[0], xb = (q3 ? f2[11] : (q2 ? f2[10] : (q1 ? f2[9] : f2[8]))); const unsigned tg = (q3 ? 244u : (q2 ? 245u : (q1 ? 246u : 247u))); c[2] = (fkey(xa + xb) & ~255u) | tg; }
        { const float xa = f1[0], xb = (q3 ? f2[15] : (q2 ? f2[14] : (q1 ? f2[13] : f2[12]))); const unsigned tg = (q3 ? 240u : (q2 ? 241u : (q1 ? 242u : 243u))); c[3] = (fkey(xa + xb) & ~255u) | tg; }
        { const float xa = f1[1], xb = (q3 ? f2[3] : (q2 ? f2[2] : (q1 ? f2[1] : f2[0]))); const unsigned tg = (q3 ? 236u : (q2 ? 237u : (q1 ? 238u : 239u))); c[4] = (fkey(xa + xb) & ~255u) | tg; }
        { const float xa = f1[1], xb = (q3 ? f2[7] : (q2 ? f2[6] : (q1 ? f2[5] : f2[4]))); const unsigned tg = (q3 ? 232u : (q2 ? 233u : (q1 ? 234u : 235u))); c[5] = (fkey(xa + xb) & ~255u) | tg; }
        { const float xa = f1[2], xb = (q3 ? f2[3] : (q2 ? f2[2] : (q1 ? f2[1] : f2[0]))); const unsigned tg = (q3 ? 220u : (q2 ? 221u : (q1 ? 222u : 223u))); c[6] = (fkey(xa + xb) & ~255u) | tg; }
        { const float xa = (q3 ? f1[3] : (q2 ? f1[3] : (q1 ? f1[3] : f1[2]))), xb = (q3 ? f2[2] : (q2 ? f2[1] : (q1 ? f2[0] : f2[4]))); const unsigned tg = (q3 ? 205u : (q2 ? 206u : (q1 ? 207u : 219u))); c[7] = (fkey(xa + xb) & ~255u) | tg; }
        { const float xa = (q3 ? f1[4] : (q2 ? f1[4] : (q1 ? f1[4] : f1[3]))), xb = (q3 ? f2[2] : (q2 ? f2[1] : (q1 ? f2[0] : f2[3]))); const unsigned tg = (q3 ? 189u : (q2 ? 190u : (q1 ? 191u : 204u))); c[8] = (fkey(xa + xb) & ~255u) | tg; }
        { const float xa = (q3 ? f1[6] : (q2 ? f1[6] : f1[5])), xb = (q3 ? f2[1] : (q2 ? f2[0] : (q1 ? f2[1] : f2[0]))); const unsigned tg = (q3 ? 158u : (q2 ? 159u : (q1 ? 174u : 175u))); c[9] = (fkey(xa + xb) & ~255u) | tg; }
        { const float xa = (q3 ? f1[9] : (q2 ? f1[8] : f1[7])), xb = (q3 ? f2[0] : (q2 ? f2[0] : (q1 ? f2[1] : f2[0]))); const unsigned tg = (q3 ? 111u : (q2 ? 127u : (q1 ? 142u : 143u))); c[10] = (fkey(xa + xb) & ~255u) | tg; }
        { const float xa = (q3 ? f1[13] : (q2 ? f1[12] : (q1 ? f1[11] : f1[10]))), xb = f2[0]; const unsigned tg = (q3 ? 47u : (q2 ? 63u : (q1 ? 79u : 95u))); c[11] = (fkey(xa + xb) & ~255u) | tg; }
        { const float xa = (q3 ? -3.0e38f : (q2 ? -3.0e38f : (q1 ? f1[15] : f1[14]))), xb = (q3 ? 0.f : (q2 ? 0.f : f2[0])); const unsigned tg = (q3 ? 0u : (q2 ? 0u : (q1 ? 15u : 31u))); c[12] = (fkey(xa + xb) & ~255u) | tg; }
        c[13] = 0u; c[14] = 0u; c[15] = 0u;
        sort16_desc(c);
        unsigned o[16];
#pragma unroll
        for (int k = 0; k < 16; ++k) o[k] = __shfl_xor(c[k], 1);
        merge16_desc(c, o);
#pragma unroll
        for (int k = 0; k < 16; ++k) o[k] = __shfl_xor(c[k], 2);
        merge16_desc(c, o);
      }
      float e[16];
      const float mx = keyf(c[0] & ~255u);
      float sum = 0.f;
#pragma unroll
      for (int k = 0; k < 16; ++k) { e[k] = __expf(keyf(c[k] & ~255u) - mx); sum += e[k]; }
      const float inv = 1.f / sum;
      asm volatile("s_waitcnt lgkmcnt(0)" ::: "memory");
      const int qd = tid & 3;
      const size_t idx = ((size_t)(u.pm * BM + ai * HALF + row) * 8 + u.pn) * 16 + qd * 4;
      unsigned ew[2]; float gt[4];
#pragma unroll
      for (int k = 0; k < 4; ++k) {
        unsigned k0 = c[k], k1 = c[4 + k], k2 = c[8 + k], k3 = c[12 + k]; float e0 = e[k], e1 = e[4 + k], e2 = e[8 + k], e3 = e[12 + k];
        asm volatile("" : "+v"(k0), "+v"(k1), "+v"(k2), "+v"(k3), "+v"(e0), "+v"(e1), "+v"(e2), "+v"(e3));
        const unsigned key = qd == 0 ? k0 : qd == 1 ? k1 : qd == 2 ? k2 : k3;
        const float ev = qd == 0 ? e0 : qd == 1 ? e1 : qd == 2 ? e2 : e3;
        const unsigned ab = 255u - (key & 255u);
        const unsigned ex = (unsigned)ib[ab >> 4] * 128u + (unsigned)ib[16 + (ab & 15)];
        if (k & 1) ew[k >> 1] |= ex << 16; else ew[k >> 1] = ex;
        gt[k] = ev * inv;
      }
      *(u32x2*)(experts + idx) = (u32x2){ew[0], ew[1]};
      *(f32x4*)(gates + idx) = (f32x4){gt[0], gt[1], gt[2], gt[3]};
      lds_barrier();
    }
  }
};
template <class Epi>
__device__ __forceinline__ void run_drained(char* smem, const bf16_t* A, const bf16_t* Bt, int M, int N, int K, const Epi& E) {
  StaticOrder S; S.init(M, N, gridDim.x, blockIdx.x);
  for (int i = 0;; ++i) {
    Unit u; if (!S.next(i, u)) break;
    gemm_phase((LAS unsigned char*)smem, Gemm{A, Bt, M, N, K}, OneUnit{u}, E);
  }
}
template <class Epi>
__device__ __forceinline__ void run(char* smem, const bf16_t* A, const bf16_t* Bt, int M, int N, int K, const Epi& E) {
  StaticOrder S; S.init(M, N, gridDim.x, blockIdx.x);
  gemm_phase((LAS unsigned char*)smem, Gemm{A, Bt, M, N, K}, S, E);
}
}

__device__ void conv_phase(const Params& p, char* smem) {
  bf16_t* raw = (bf16_t*)smem;
  const int tid = phase_tid();
  u32x4 rr_[3];
  auto gload = [&](int item) {
    const int cb = item % 24, c = (item / 24) % NCH, seq = item / (24 * NCH);
#pragma unroll
    for (int j = 0; j < 3; ++j) {
      const int i = tid + j * NTHREADS;
      const int rr = i >> 3, k8 = i & 7;
      const int pos = c * 128 - 2 + rr - MPAD;
      u32x4 v = {0u, 0u, 0u, 0u};
      if (i < 132 * 8 && pos >= 0 && pos < LSEQ) v = *(const u32x4*)(p.xbc_raw + (size_t)row_of(seq, pos) * 1536 + cb * 64 + k8 * 8);
      rr_[j] = v;
    }
  };
  if ((int)blockIdx.x < NSEQ * NCH * 24) gload(blockIdx.x);
  for (int item = blockIdx.x; item < NSEQ * NCH * 24; item += gridDim.x) {
    const int cb = item % 24, c = (item / 24) % NCH, seq = item / (24 * NCH);
    __syncthreads();
#pragma unroll
    for (int j = 0; j < 3; ++j) {
      const int i = tid + j * NTHREADS;
      if (i < 132 * 8) *(u32x4*)(raw + (i >> 3) * 64 + (i & 7) * 8) = rr_[j];
    }
    __syncthreads();
    if (item + (int)gridDim.x < NSEQ * NCH * 24) gload(item + gridDim.x);
    const int ch = tid & 63, l0 = (tid >> 6) * 16;
    const int gch = cb * 64 + ch;
    float w[5];
#pragma unroll
    for (int k = 0; k < 5; ++k) w[k] = p.conv_w[k * 1536 + gch];
    const float bias = p.conv_b[gch];
    float win[20];
#pragma unroll
    for (int i = 0; i < 20; ++i) win[i] = bf2f(raw[(l0 + i) * 64 + ch]);
    float o[16];
#pragma unroll
    for (int i = 0; i < 16; ++i) {
      float a = bias;
#pragma unroll
      for (int k = 0; k < 5; ++k) a += w[k] * win[i + k];
      int pos = c * 128 + l0 + i - MPAD;
      o[i] = (pos >= 0 && pos < LSEQ) ? silu_f(a) : 0.f;
    }
    u32x4 lo, hi;
    lo[0] = pk_bf16(o[0], o[1]); lo[1] = pk_bf16(o[2], o[3]); lo[2] = pk_bf16(o[4], o[5]); lo[3] = pk_bf16(o[6], o[7]);
    hi[0] = pk_bf16(o[8], o[9]); hi[1] = pk_bf16(o[10], o[11]); hi[2] = pk_bf16(o[12], o[13]); hi[3] = pk_bf16(o[14], o[15]);
    if (cb < 16) {
      bf16_t* d = p.XT + ((((size_t)seq * NCH + c) * 16 + cb) * 64 + ch) * 128 + l0;
      *(u32x4*)d = lo; *(u32x4*)(d + 8) = hi;
    } else if (cb < 20) {
      const int g = (cb - 16) >> 1, n = ((cb - 16) & 1) * 64 + ch;
      bf16_t* d = p.BmT + ((((size_t)seq * NCH + c) * 2 + g) * 128 + n) * 128 + l0;
      *(u32x4*)d = lo; *(u32x4*)(d + 8) = hi;
      bf16_t* d2 = p.Bm + ((size_t)seq * LP + c * 128 + l0) * 256 + g * 128 + n;
#pragma unroll
      for (int i = 0; i < 16; ++i) d2[(size_t)i * 256] = f2bf(o[i]);
    } else {
      const int g = (cb - 20) >> 1, n = ((cb - 20) & 1) * 64 + ch;
      bf16_t* d2 = p.Cm + ((size_t)seq * LP + c * 128 + l0) * 256 + g * 128 + n;
#pragma unroll
      for (int i = 0; i < 16; ++i) d2[(size_t)i * 256] = f2bf(o[i]);
    }
  }
}

__device__ void token_phase(const Params& p) {
  const int lane = phase_tid() & 63, wid = phase_tid() >> 6;
  for (int row = blockIdx.x * 8 + wid; row < TP; row += gridDim.x * 8) {
    if (row >= TM) {
      unsigned* dq = (unsigned*)(p.cqn + (size_t)row * 384) + lane * 3;
      dq[0] = 0u; dq[1] = 0u; dq[2] = 0u;
      *(u32x2*)(p.ckvn + (size_t)row * 256 + lane * 4) = (u32x2){0u, 0u};
      continue;
    }
    const bf16_t* src = p.rest + (size_t)row * 768;
    {
      const unsigned* s = (const unsigned*)(src + 32) + lane * 3;
      unsigned a0 = s[0], a1 = s[1], a2 = s[2];
      float v[6] = {bflo(a0), bfhi(a0), bflo(a1), bfhi(a1), bflo(a2), bfhi(a2)};
      float ss = 0.f;
#pragma unroll
      for (int j = 0; j < 6; ++j) ss += v[j] * v[j];
      const float r = rsqrtf(wave_sum(ss) * (1.f / 384.f) + EPS);
      const float* g = p.q_norm_g + lane * 6;
      unsigned* d = (unsigned*)(p.cqn + (size_t)row * 384) + lane * 3;
      d[0] = pk_bf16(v[0] * r * g[0], v[1] * r * g[1]);
      d[1] = pk_bf16(v[2] * r * g[2], v[3] * r * g[3]);
      d[2] = pk_bf16(v[4] * r * g[4], v[5] * r * g[5]);
    }
    {
      u32x2 a = *(const u32x2*)(src + 416 + lane * 4);
      float v[4] = {bflo(a[0]), bfhi(a[0]), bflo(a[1]), bfhi(a[1])};
      float ss = v[0] * v[0] + v[1] * v[1] + v[2] * v[2] + v[3] * v[3];
      const float r = rsqrtf(wave_sum(ss) * (1.f / 256.f) + EPS);
      const float* g = p.kv_norm_g + lane * 4;
      u32x2 w;
      w[0] = pk_bf16(v[0] * r * g[0], v[1] * r * g[1]); w[1] = pk_bf16(v[2] * r * g[2], v[3] * r * g[3]);
      *(u32x2*)(p.ckvn + (size_t)row * 256 + lane * 4) = w;
    }
    if (lane < 16) {
      const float pos = (float)(row < TX ? NMETA + (row & (SEQ - 1)) : row - TX);
      const float inv = exp2f(-(float)lane * (13.287712379549449f / 16.f));
      const float ang = pos * inv;
      float sn, cs; fast_sincos(ang, sn, cs);
      const float x1 = bf2f(src[672 + lane]), x2 = bf2f(src[688 + lane]);
      p.kr[(size_t)row * 32 + lane] = f2bf(x1 * cs - x2 * sn);
      p.kr[(size_t)row * 32 + 16 + lane] = f2bf(x1 * sn + x2 * cs);
    }
  }
}

__device__ void dt_phase(const Params& p) {
  const int lane = phase_tid() & 63, wid = phase_tid() >> 6;
  for (int item = blockIdx.x * 8 + wid; item < NSEQ * 2 * NCH; item += gridDim.x * 8) {
    const int c = item % NCH, dir = (item / NCH) & 1, seq = item / (NCH * 2);
    u32x4 raw[2][2];
#pragma unroll
    for (int j = 0; j < 2; ++j) {
      const int pos = c * 128 + lane * 2 + j - MPAD;
      raw[j][0] = (u32x4){0u, 0u, 0u, 0u}; raw[j][1] = raw[j][0];
      if (pos >= 0) {
        const bf16_t* src = p.rest + (size_t)row_of(seq, pos) * 768 + dir * 16;
        raw[j][0] = *(const u32x4*)src; raw[j][1] = *(const u32x4*)(src + 8);
      }
    }
    const float* biasp = dir ? p.dt_bias_b : p.dt_bias_f;
    const float* alogp = dir ? p.a_log_b : p.a_log_f;
#pragma unroll
    for (int h = 0; h < 16; ++h) {
      const float bias = biasp[h];
      const float a = -__expf(alogp[h]);
      float dt[2], da[2];
#pragma unroll
      for (int j = 0; j < 2; ++j) {
        const int pos = c * 128 + lane * 2 + j - MPAD;
        const unsigned w = raw[j][h >> 3][(h >> 1) & 3];
        const float x = ((h & 1) ? bfhi(w) : bflo(w)) + bias;
        const float v = pos >= 0 ? (x > 20.f ? x : log1pf(__expf(x))) : 0.f;
        dt[j] = v; da[j] = v * a;
      }
      const float s2 = da[0] + da[1];
      float incl = s2;
#pragma unroll
      for (int o = 1; o < 64; o <<= 1) { float t = __shfl_up(incl, o); if (lane >= o) incl += t; }
      const float excl = incl - s2;
      const float tot = __shfl(incl, 63);
      const size_t base = ((size_t)(seq * 2 + dir) * 16 + h) * LP + c * 128 + lane * 2;
      float P0, P1;
      if (dir == 0) { P0 = excl + da[0]; P1 = incl; } else { P0 = -excl; P1 = -(excl + da[0]); }
      *(float2*)(p.dtv + base) = make_float2(dt[0], dt[1]);
      *(float2*)(p.Pv + base) = make_float2(P0, P1);
      if (lane == 0) p.Atot[((size_t)(seq * 2 + dir) * 16 + h) * NCH + c] = tot;
    }
  }
}

__device__ __forceinline__ void xcd_group_map(int b, int& gg, int& j) { const int r = b & 7, k = b >> 3; j = k & 7; gg = (k >> 3) * 8 + r; }
constexpr int KS_STRIDE = 208, VS_STRIDE = 136;
constexpr int ATT_STAGE = 64 * KS_STRIDE + 64 * VS_STRIDE;
static_assert(2 * ATT_STAGE <= 160 * 1024 - 64, "attn lds");
__device__ void attn_phase(const Params& p, char* smem) {
  const int tid = phase_tid(), lane = tid & 63, wid = tid >> 6;
  const int r32 = lane & 31, hh = lane >> 5;
  for (int item0 = blockIdx.x; item0 < NSEQ * 8 * 8; item0 += gridDim.x) {
    int item = item0;
    if (gridDim.x == 256) { int gg, j; xcd_group_map(blockIdx.x, gg, j); item = ((item0 >> 8) * 32 + gg) * 8 + j; }
    const int qb = item & 7, h = (item >> 3) & 7, seq = item >> 6;
    const float qscale = 0.10206207261596575f * 1.4426950408889634f;
    bf16x8 qf[6];
    {
      const int qi = qb * 256 + wid * 32 + r32;
      const bf16_t* qp = p.q + ((size_t)seq * SEQ + qi) * 768 + h * 96 + hh * 8;
      const float pos = (float)(NMETA + qi);
      u32x4 v[6];
#pragma unroll
      for (int i = 0; i < 6; ++i) v[i] = *(const u32x4*)(qp + i * 16);
#pragma unroll
      for (int i = 0; i < 4; ++i) {
        u32x4 w;
#pragma unroll
        for (int j = 0; j < 4; ++j) w[j] = pk_bf16(bflo(v[i][j]) * qscale, bfhi(v[i][j]) * qscale);
        qf[i] = as_bf16x8(w);
      }
      u32x4 w1, w2;
#pragma unroll
      for (int j = 0; j < 4; ++j) {
        float o1[2], o2[2];
#pragma unroll
        for (int e = 0; e < 2; ++e) {
          const int k = 8 * hh + 2 * j + e;
          const float x1 = e ? bfhi(v[4][j]) : bflo(v[4][j]), x2 = e ? bfhi(v[5][j]) : bflo(v[5][j]);
          const float inv = exp2f(-(float)k * (13.287712379549449f / 16.f));
          float sn, cs; fast_sincos(pos * inv, sn, cs);
          o1[e] = (x1 * cs - x2 * sn) * qscale; o2[e] = (x1 * sn + x2 * cs) * qscale;
        }
        w1[j] = pk_bf16(o1[0], o1[1]); w2[j] = pk_bf16(o2[0], o2[1]);
      }
      qf[4] = as_bf16x8(w1); qf[5] = as_bf16x8(w2);
    }
    f32x16 oacc[2], negm;
#pragma unroll
    for (int i = 0; i < 16; ++i) { oacc[0][i] = 0.f; oacc[1][i] = 0.f; negm[i] = 0.f; }
    float l_run = 0.f;

    u32x4 rk, rkr, rv;
    const bf16_t* vTb = p.vT + (size_t)(h * 64) * TP;
    auto gload = [&](int kt) {
      const u32x4 zero = {0u, 0u, 0u, 0u};
      if (kt < 32) {
        { int key = tid >> 3, ch = tid & 7;
          rk = *(const u32x4*)(p.Kb + ((size_t)seq * SEQ + kt * 64 + key) * 512 + h * 64 + ch * 8); }
        if (tid < 256) { int key = tid >> 2, ch = tid & 3;
          rkr = *(const u32x4*)(p.kr + ((size_t)seq * SEQ + kt * 64 + key) * 32 + ch * 8); }
        { int dv = tid >> 3, ch = tid & 7;
          rv = *(const u32x4*)(vTb + (size_t)dv * TP + seq * SEQ + kt * 64 + ch * 8); }
      } else {
        { int key = tid >> 3, ch = tid & 7;
          rk = key < 16 ? *(const u32x4*)(p.Kb + (size_t)(TX + key) * 512 + h * 64 + ch * 8) : zero; }
        if (tid < 256) { int key = tid >> 2, ch = tid & 3;
          rkr = key < 16 ? *(const u32x4*)(p.kr + (size_t)(TX + key) * 32 + ch * 8) : zero; }
        { int dv = tid >> 3, ch = tid & 7;
          rv = ch < 2 ? *(const u32x4*)(vTb + (size_t)dv * TP + TX + ch * 8) : zero; }
      }
    };
    auto sstore = [&](int st) {
      char* ks = smem + st * ATT_STAGE; char* vs = ks + 64 * KS_STRIDE;
      { int key = tid >> 3, ch = tid & 7; *(u32x4*)(ks + key * KS_STRIDE + ch * 16) = rk; }
      if (tid < 256) { int key = tid >> 2, ch = tid & 3; *(u32x4*)(ks + key * KS_STRIDE + 128 + ch * 16) = rkr; }
      { int dv = tid >> 3, ch = tid & 7; char* d = vs + dv * VS_STRIDE + ch * 16;
        *(u32x2*)d = (u32x2){rv[0], rv[1]}; *(u32x2*)(d + 8) = (u32x2){rv[2], rv[3]}; }
    };
    lds_barrier();
    gload(0); sstore(0);
    lds_barrier();
    for (int kt = 0; kt < 33; ++kt) {
      const int cur = kt & 1;
      if (kt + 1 < 33) gload(kt + 1);
      const char* ks_ = smem + cur * ATT_STAGE; const char* vs_ = ks_ + 64 * KS_STRIDE;
      f32x16 sacc[2];
      bf16x8 kfr[6][2];
#pragma unroll
      for (int ks = 0; ks < 6; ++ks)
#pragma unroll
        for (int t2 = 0; t2 < 2; ++t2) kfr[ks][t2] = *(const bf16x8*)(ks_ + (t2 * 32 + r32) * KS_STRIDE + ks * 32 + hh * 16);
      __builtin_amdgcn_sched_barrier(0);
#pragma unroll
      for (int ks = 0; ks < 6; ++ks)
#pragma unroll
        for (int t2 = 0; t2 < 2; ++t2)
          sacc[t2] = __builtin_amdgcn_mfma_f32_32x32x16_bf16(kfr[ks][t2], qf[ks], ks == 0 ? negm : sacc[t2], 0, 0, 0);
      __builtin_amdgcn_sched_barrier(0);
      u32x2 vfa[2][2][2], vfb[2][2][2];
#pragma unroll
      for (int t2 = 0; t2 < 2; ++t2)
#pragma unroll
        for (int s2 = 0; s2 < 2; ++s2)
#pragma unroll
          for (int dvt = 0; dvt < 2; ++dvt) {
            const char* vp = vs_ + (dvt * 32 + r32) * VS_STRIDE + (t2 * 32 + s2 * 16 + 4 * hh) * 2;
            vfa[t2][s2][dvt] = *(const u32x2*)vp; vfb[t2][s2][dvt] = *(const u32x2*)(vp + 16);
          }
      __builtin_amdgcn_sched_barrier(0);
      if (kt == 32) {
#pragma unroll
        for (int t2 = 0; t2 < 2; ++t2)
#pragma unroll
          for (int i = 0; i < 16; ++i) {
            int kk = t2 * 32 + (i & 3) + 8 * (i >> 2) + 4 * hh;
            if (kk >= 16) sacc[t2][i] = -1e30f;
          }
      }
      {
        float mx = sacc[0][0];
#pragma unroll
        for (int t2 = 0; t2 < 2; ++t2)
#pragma unroll
          for (int i = 0; i < 16; ++i) mx = fmaxf(mx, sacc[t2][i]);
        mx = fmaxf(mx, __shfl_xor(mx, 32));
        if (kt == 0 || __any(mx > 8.f)) {
          const float d = kt == 0 ? mx : fmaxf(mx, 0.f);
          const float alpha = kt == 0 ? 1.f : __builtin_amdgcn_exp2f(-d);
#pragma unroll
          for (int i = 0; i < 16; ++i) {
            sacc[0][i] -= d; sacc[1][i] -= d; negm[i] -= d;
            oacc[0][i] *= alpha; oacc[1][i] *= alpha;
          }
          l_run *= alpha;
        }
        float ps = 0.f;
#pragma unroll
        for (int t2 = 0; t2 < 2; ++t2)
#pragma unroll
          for (int i = 0; i < 16; ++i) { float e = __builtin_amdgcn_exp2f(sacc[t2][i]); sacc[t2][i] = e; ps += e; }
        l_run += ps;
      }
#pragma unroll
      for (int t2 = 0; t2 < 2; ++t2)
#pragma unroll
        for (int s2 = 0; s2 < 2; ++s2) {
          u32x4 pw;
#pragma unroll
          for (int j = 0; j < 4; ++j) pw[j] = pk_bf16(sacc[t2][s2 * 8 + 2 * j], sacc[t2][s2 * 8 + 2 * j + 1]);
          const bf16x8 pf = as_bf16x8(pw);
#pragma unroll
          for (int dvt = 0; dvt < 2; ++dvt) {
            const u32x2 a2 = vfa[t2][s2][dvt], b2 = vfb[t2][s2][dvt];
            bf16x8 vf = as_bf16x8((u32x4){a2[0], a2[1], b2[0], b2[1]});
            oacc[dvt] = __builtin_amdgcn_mfma_f32_32x32x16_bf16(vf, pf, oacc[dvt], 0, 0, 0);
          }
        }
      if (kt + 1 < 33) sstore(cur ^ 1);
      lds_barrier();
    }
    {
      const float l_tot = l_run + __shfl_xor(l_run, 32);
      const float inv = __builtin_amdgcn_rcpf(l_tot);
      const int qi = qb * 256 + wid * 32 + r32;
      bf16_t* op = p.o + ((size_t)seq * SEQ + qi) * 512 + h * 64;
#pragma unroll
      for (int dvt = 0; dvt < 2; ++dvt)
#pragma unroll
        for (int g4 = 0; g4 < 4; ++g4) {
          u32x2 w;
          w[0] = pk_bf16(oacc[dvt][g4 * 4 + 0] * inv, oacc[dvt][g4 * 4 + 1] * inv);
          w[1] = pk_bf16(oacc[dvt][g4 * 4 + 2] * inv, oacc[dvt][g4 * 4 + 3] * inv);
          *(u32x2*)(op + dvt * 32 + g4 * 8 + hh * 4) = w;
        }
    }
  }
  lds_barrier();
}

constexpr int SS_ROW = 272;
constexpr int SS_XT = 264;

constexpr int DG_CC = 0, DG_BC = 128 * SS_ROW, DG_XT = 2 * 128 * SS_ROW, DG_AR = DG_XT + 2 * 64 * SS_XT, DG_BW = DG_AR + 2 * 2048, DG_LDS = DG_BW + 8 * 512;
static_assert(DG_LDS <= 150 * 1024, "diag lds");
__device__ void ssd_diag_phase(const Params& p, char* smem) {
  const int tid = phase_tid(), lane = tid & 63, wid = tid >> 6;
  const int r32 = lane & 31, hh = lane >> 5;
  const int pt = wid & 1, lt = wid >> 1;
  const int l = lt * 32 + r32;
  for (int item = blockIdx.x; item < NSEQ * 16 * 2; item += gridDim.x) {
    const int g = item & 1, c = 1 + ((item >> 1) & 15), seq = item >> 5;
    u32x4 rx[2]; float ra = 0.f;
    auto gload_head = [&](int h) {
      const bf16_t* xt = p.XT + (((size_t)seq * NCH + c) * 16 + h) * 64 * 128;
#pragma unroll
      for (int i = 0; i < 2; ++i) { int id = tid + i * 512; int r = id >> 4, k = id & 15;
        rx[i] = *(const u32x4*)(xt + (size_t)r * 128 + k * 8); }
      const int arr = tid >> 7, idx = tid & 127, dir = arr & 1;
      const float* src = (arr < 2 ? p.Pv : p.dtv) + ((size_t)(seq * 2 + dir) * 16 + h) * LP + c * 128 + idx;
      ra = *src;
    };
    auto sstore_head = [&](int buf) {
#pragma unroll
      for (int i = 0; i < 2; ++i) { int id = tid + i * 512; int r = id >> 4, k = id & 15;
        char* d = smem + DG_XT + buf * 64 * SS_XT + r * SS_XT + k * 16;
        *(u32x2*)d = (u32x2){rx[i][0], rx[i][1]}; *(u32x2*)(d + 8) = (u32x2){rx[i][2], rx[i][3]}; }
      ((float*)(smem + DG_AR + buf * 2048))[tid] = ra;
    };
    lds_barrier();
    {
      const bf16_t* cm = p.Cm + ((size_t)seq * LP + c * 128) * 256 + g * 128;
      const bf16_t* bm = p.Bm + ((size_t)seq * LP + c * 128) * 256 + g * 128;
      u32x4 rc[4], rb[4];
#pragma unroll
      for (int i = 0; i < 4; ++i) { int id = tid + i * 512; int r = id >> 4, k = id & 15;
        rc[i] = *(const u32x4*)(cm + (size_t)r * 256 + k * 8); rb[i] = *(const u32x4*)(bm + (size_t)r * 256 + k * 8); }
      gload_head(g * 8);
#pragma unroll
      for (int i = 0; i < 4; ++i) { int id = tid + i * 512; int r = id >> 4, k = id & 15;
        *(u32x4*)(smem + DG_CC + r * SS_ROW + k * 16) = rc[i]; *(u32x4*)(smem + DG_BC + r * SS_ROW + k * 16) = rb[i]; }
      sstore_head(0);
    }
    lds_barrier();
    f32x16 xacc[4];
#pragma unroll
    for (int st = 0; st < 4; ++st) {
#pragma unroll
      for (int i = 0; i < 16; ++i) xacc[st][i] = 0.f;
#pragma unroll
      for (int ks = 0; ks < 8; ++ks) {
        bf16x8 bfg = *(const bf16x8*)(smem + DG_BC + (st * 32 + r32) * SS_ROW + ks * 32 + hh * 16);
        bf16x8 cfk = *(const bf16x8*)(smem + DG_CC + l * SS_ROW + ks * 32 + hh * 16);
        xacc[st] = __builtin_amdgcn_mfma_f32_32x32x16_bf16(bfg, cfk, xacc[st], 0, 0, 0);
      }
    }
    for (int h8 = 0; h8 < 8; ++h8) {
      const int h = g * 8 + h8, buf = h8 & 1;
      if (h8 + 1 < 8) gload_head(h + 1);
      const char* xtb = smem + DG_XT + buf * 64 * SS_XT;
      const float* Pf = (const float*)(smem + DG_AR + buf * 2048);
      const float* Pb = Pf + 128; const float* Df = Pf + 256; const float* Db = Pf + 384;
      const float Pfl = Pf[l], Pbl = Pb[l];
      float* bw = (float*)(smem + DG_BW + wid * 512);
      const float PrefF = Pf[lt * 32], PrefB = Pb[lt * 32 + 31];
      const float af = __expf(Pfl - PrefF), ab = __expf(Pbl - PrefB);
#pragma unroll
      for (int r = 0; r < 2; ++r) {
        const int sx = lane + 64 * r;
        float bv = 0.f;
        if (sx < lt * 32) bv = Df[sx] * __expf(PrefF - Pf[sx]);
        else if (sx >= (lt + 1) * 32) bv = Db[sx] * __expf(PrefB - Pb[sx]);
        bw[sx] = bv;
      }
      asm volatile("s_waitcnt lgkmcnt(0)" ::: "memory");
      f32x16 yacc;
#pragma unroll
      for (int i = 0; i < 16; ++i) yacc[i] = 0.f;
#pragma unroll
      for (int st = 0; st < 4; ++st) {
        float m[16];
        if (st != lt) {
          const float a = st < lt ? af : ab;
#pragma unroll
          for (int i = 0; i < 16; ++i) { const int sx = st * 32 + (i & 3) + 8 * (i >> 2) + 4 * hh;
            m[i] = xacc[st][i] * (a * bw[sx]); }
        } else {
#pragma unroll
          for (int i = 0; i < 16; ++i) { const int sx = st * 32 + (i & 3) + 8 * (i >> 2) + 4 * hh;
            const float wf = Df[sx] * __expf(Pfl - Pf[sx]), wb = Db[sx] * __expf(Pbl - Pb[sx]);
            m[i] = xacc[st][i] * ((sx <= l ? wf : 0.f) + (sx >= l ? wb : 0.f)); }
        }
#pragma unroll
        for (int s2 = 0; s2 < 2; ++s2) {
          u32x4 pw;
#pragma unroll
          for (int j = 0; j < 4; ++j) pw[j] = pk_bf16(m[s2 * 8 + 2 * j], m[s2 * 8 + 2 * j + 1]);
          const char* xp = xtb + (pt * 32 + r32) * SS_XT + (st * 32 + s2 * 16 + 4 * hh) * 2;
          u32x2 a = *(const u32x2*)xp, b2 = *(const u32x2*)(xp + 16);
          bf16x8 xf = as_bf16x8((u32x4){a[0], a[1], b2[0], b2[1]});
          yacc = __builtin_amdgcn_mfma_f32_32x32x16_bf16(xf, as_bf16x8(pw), yacc, 0, 0, 0);
        }
      }
      const float dskip = p.d_skip[h];
      bf16_t* yp = p.Y + ((size_t)seq * SEQ + (c - 1) * 128 + l) * 1024 + h * 64 + pt * 32 + 4 * hh;
#pragma unroll
      for (int g4 = 0; g4 < 4; ++g4) {
        float v[4];
#pragma unroll
        for (int j = 0; j < 4; ++j) {
          const int pp = pt * 32 + g4 * 8 + 4 * hh + j;
          v[j] = yacc[g4 * 4 + j] + dskip * bf2f(*(const bf16_t*)(xtb + pp * SS_XT + l * 2));
        }
        u32x2 w; w[0] = pk_bf16(v[0], v[1]); w[1] = pk_bf16(v[2], v[3]);
        *(u32x2*)(yp + g4 * 8) = w;
      }
      if (h8 + 1 < 8) sstore_head(buf ^ 1);
      lds_barrier();
    }
  }
  lds_barrier();
}

constexpr int OFF_CC = 0, OFF_BT = 128 * SS_ROW, OFF_XT = 2 * 128 * SS_ROW;
constexpr int OFF_XW = OFF_XT + 64 * SS_XT, OFF_SB = OFF_XW + 64 * SS_ROW, OFF_P = OFF_SB + 64 * SS_ROW, OFF_DT = OFF_P + 512;
constexpr int OFF_AT = OFF_DT + 512;
constexpr int OFF_WS = OFF_AT + 128;
constexpr int OFF_YT = OFF_WS + 512;
constexpr int SSD_LDS = OFF_YT + 128 * 272;
static_assert(SSD_LDS <= 160 * 1024 - 64, "ssd lds");
__device__ void ssd_phase(const Params& p, char* smem) {
  const int tid = phase_tid(), lane = tid & 63, wid = tid >> 6;
  const int r32 = lane & 31, hh = lane >> 5;
  const int pt = wid & 1, lt = wid >> 1;
  float* Ps = (float*)(smem + OFF_P);
  float* Ds = (float*)(smem + OFF_DT);
  const int NI = NSEQ * 16, G = gridDim.x;
  const bool split = G >= 256 && G < NI;
  for (int u = 0;; ++u) {
    int item, dir0, dir1; bool to_yb2 = false;
    if (!split) { item = blockIdx.x + u * G; if (item >= NI) break; dir0 = 0; dir1 = 2; }
    else if (G == 256) {
      int gg, j; xcd_group_map(blockIdx.x, gg, j);
      if (u == 0) { item = gg * 8 + j; dir0 = 0; dir1 = 2; }
      else if (u == 1) { item = G + (gg >> 1) * 8 + j; dir0 = gg & 1; dir1 = dir0 + 1; to_yb2 = true; }
      else break;
    }
    else if (u == 0) { item = blockIdx.x; dir0 = 0; dir1 = 2; }
    else { const int hidx = blockIdx.x + (u - 1) * G; if (hidx >= 2 * (NI - G)) break; item = G + (hidx >> 1); dir0 = hidx & 1; dir1 = dir0 + 1; to_yb2 = true; }
    const int h = item & 15, seq = item >> 4, g = h >> 3;
    for (int dir = dir0; dir < dir1; ++dir) {
      const bool yb2 = (dir == 1) && to_yb2;
      f32x16 sacc;
#pragma unroll
      for (int i = 0; i < 16; ++i) sacc[i] = 0.f;
      const float* dtp = p.dtv + ((size_t)(seq * 2 + dir) * 16 + h) * LP;
      const float* Pp = p.Pv + ((size_t)(seq * 2 + dir) * 16 + h) * LP;
      const float* Ap = p.Atot + ((size_t)(seq * 2 + dir) * 16 + h) * NCH;
      u32x4 rc[4], rbt[4], rx[2];
      float rp = 0.f, rd = 0.f;
      auto gload = [&](int c) {
        const bf16_t* cm = p.Cm + ((size_t)seq * LP + c * 128) * 256 + g * 128;
        const bf16_t* bt = p.BmT + (((size_t)seq * NCH + c) * 2 + g) * 128 * 128;
        const bf16_t* xt = p.XT + (((size_t)seq * NCH + c) * 16 + h) * 64 * 128;
#pragma unroll
        for (int i = 0; i < 4; ++i) { int id = tid + i * 512; int r = id >> 4, k = id & 15;
          rc[i] = *(const u32x4*)(cm + (size_t)r * 256 + k * 8);
          rbt[i] = *(const u32x4*)(bt + (size_t)r * 128 + k * 8); }
#pragma unroll
        for (int i = 0; i < 2; ++i) { int id = tid + i * 512; int r = id >> 4, k = id & 15;
          rx[i] = *(const u32x4*)(xt + (size_t)r * 128 + k * 8); }
        if (tid < 128) { rp = Pp[c * 128 + tid]; rd = dtp[c * 128 + tid]; }
      };
      auto sstore = [&](int cs) {
#pragma unroll
        for (int i = 0; i < 4; ++i) { int id = tid + i * 512; int r = id >> 4, k = id & 15;
          *(u32x4*)(smem + OFF_CC + r * SS_ROW + k * 16) = rc[i];
          *(u32x4*)(smem + OFF_BT + r * SS_ROW + k * 16) = rbt[i]; }
#pragma unroll
        for (int i = 0; i < 2; ++i) { int id = tid + i * 512; int r = id >> 4, k = id & 15;
          char* d = smem + OFF_XT + r * SS_XT + k * 16;
          *(u32x2*)d = (u32x2){rx[i][0], rx[i][1]}; *(u32x2*)(d + 8) = (u32x2){rx[i][2], rx[i][3]}; }
        if (tid < 128) {
          Ps[tid] = rp; Ds[tid] = rd;
          ((float*)(smem + OFF_WS))[tid] = rd * (dir == 0 ? __expf(Ap[cs] - rp) : __expf(-rp));
        }
      };
      const int c_first = dir == 0 ? 0 : NCH - 1, c_last = dir == 0 ? NCH - 1 : 1, c_step = dir == 0 ? 1 : -1;
      lds_barrier();
      gload(c_first);
      if (tid < NCH) ((float*)(smem + OFF_AT))[tid] = Ap[tid];
      for (int i = tid; i < 64 * SS_ROW / 4; i += NTHREADS) ((unsigned*)(smem + OFF_SB))[i] = 0u;
      sstore(c_first);
      lds_barrier();
      for (int c = c_first;; c += c_step) {
        const bool last = (c == c_last);
        const bool first = (c == c_first);
        const float atot = ((const float*)(smem + OFF_AT))[c];
        const int l = lt * 32 + r32;
        const bool emit = (c >= 1) && !first;
        const int yrow = tid >> 2, yseg = tid & 3;
        bf16_t* yp = yb2 ? p.Yb2 + ((size_t)(item - G) * SEQ + (c - 1) * 128 + yrow) * 64 + yseg * 16
                         : p.Y + ((size_t)seq * SEQ + (c - 1) * 128 + yrow) * 1024 + h * 64 + yseg * 16;
        u32x4 yold[2] = {{0u, 0u, 0u, 0u}, {0u, 0u, 0u, 0u}};
        if (emit && !yb2) {
          yold[0] = *(const u32x4*)yp; yold[1] = *(const u32x4*)(yp + 8);
        }
        if (!last) gload(c + c_step);
        if (!last) {
          const int pp = tid >> 3, l0 = (tid & 7) * 16;
          const char* srow = smem + OFF_XT + pp * SS_XT + l0 * 2;
          char* drow = smem + OFF_XW + pp * SS_ROW + l0 * 2;
#pragma unroll
          for (int q4 = 0; q4 < 4; ++q4) {
            u32x2 v = *(const u32x2*)(srow + q4 * 8);
            const f32x4 w = *(const f32x4*)(smem + OFF_WS + (l0 + q4 * 4) * 4);
            u32x2 o;
            o[0] = pk_bf16(bflo(v[0]) * w[0], bfhi(v[0]) * w[1]);
            o[1] = pk_bf16(bflo(v[1]) * w[2], bfhi(v[1]) * w[3]);
            *(u32x2*)(drow + q4 * 8) = o;
          }
        }
        if (emit) {
          const float Pl = Ps[l];
          f32x16 yacc;
#pragma unroll
          for (int i = 0; i < 16; ++i) yacc[i] = 0.f;
#pragma unroll
          for (int ks = 0; ks < 8; ++ks) {
            bf16x8 sf = *(const bf16x8*)(smem + OFF_SB + (pt * 32 + r32) * SS_ROW + ks * 32 + hh * 16);
            bf16x8 cfk = *(const bf16x8*)(smem + OFF_CC + l * SS_ROW + ks * 32 + hh * 16);
            yacc = __builtin_amdgcn_mfma_f32_32x32x16_bf16(sf, cfk, yacc, 0, 0, 0);
          }
          const float ysc = dir == 0 ? __expf(Pl) : __expf(Pl + atot);
#pragma unroll
          for (int g4 = 0; g4 < 4; ++g4)
            *(f32x4*)(smem + OFF_YT + l * 272 + (pt * 32 + g4 * 8 + 4 * hh) * 4) =
                (f32x4){yacc[g4 * 4] * ysc, yacc[g4 * 4 + 1] * ysc, yacc[g4 * 4 + 2] * ysc, yacc[g4 * 4 + 3] * ysc};
        }
        lds_barrier();
        if (emit || (yb2 && c >= 1)) {
          float v[16];
#pragma unroll
          for (int q4 = 0; q4 < 4; ++q4) {
            const f32x4 t4 = emit ? *(const f32x4*)(smem + OFF_YT + yrow * 272 + yseg * 64 + q4 * 16) : (f32x4){0.f, 0.f, 0.f, 0.f};
            v[q4 * 4] = t4[0]; v[q4 * 4 + 1] = t4[1]; v[q4 * 4 + 2] = t4[2]; v[q4 * 4 + 3] = t4[3];
          }
          u32x4 w0, w1;
#pragma unroll
          for (int j = 0; j < 4; ++j) {
            w0[j] = pk_bf16(v[2 * j] + bflo(yold[0][j]), v[2 * j + 1] + bfhi(yold[0][j]));
            w1[j] = pk_bf16(v[8 + 2 * j] + bflo(yold[1][j]), v[8 + 2 * j + 1] + bfhi(yold[1][j]));
          }
          *(u32x4*)yp = w0; *(u32x4*)(yp + 8) = w1;
        }
        if (!last) {
          const float dec = __expf(atot);
#pragma unroll
          for (int i = 0; i < 16; ++i) sacc[i] *= dec;
#pragma unroll
          for (int ks = 0; ks < 8; ++ks) {
            bf16x8 xf = *(const bf16x8*)(smem + OFF_XW + (pt * 32 + r32) * SS_ROW + ks * 32 + hh * 16);
            bf16x8 bfg = *(const bf16x8*)(smem + OFF_BT + (lt * 32 + r32) * SS_ROW + ks * 32 + hh * 16);
            sacc = __builtin_amdgcn_mfma_f32_32x32x16_bf16(bfg, xf, sacc, 0, 0, 0);
          }
#pragma unroll
          for (int g4 = 0; g4 < 4; ++g4)
            *(u32x2*)(smem + OFF_SB + (pt * 32 + r32) * SS_ROW + (lt * 32 + g4 * 8 + 4 * hh) * 2) =
                (u32x2){pk_bf16(sacc[g4 * 4], sacc[g4 * 4 + 1]), pk_bf16(sacc[g4 * 4 + 2], sacc[g4 * 4 + 3])};
        }
        lds_barrier();
        if (last) break;
        sstore(c + c_step);
        lds_barrier();
      }
    }
  }
  lds_barrier();
}

__device__ void gate_phase(const Params& p) {
  const int lane = phase_tid() & 63, wid = phase_tid() >> 6;
  const int G = gridDim.x;
  const bool split = G >= 256 && G < NSEQ * 16;
  struct In { u32x4 y[2], z[2], y2[2], o; };
  auto load = [&](In& d, int row) {
#pragma unroll
    for (int c = 0; c < 2; ++c) {
      d.y[c] = *(const u32x4*)(p.Y + (size_t)row * 1024 + c * 512 + lane * 8);
      d.z[c] = *(const u32x4*)(p.z + (size_t)row * 1024 + c * 512 + lane * 8);
      const int item = (row >> 11) * 16 + c * 8 + (lane >> 3);
      d.y2[c] = (u32x4){0u, 0u, 0u, 0u};
      if (split && item >= G) d.y2[c] = *(const u32x4*)(p.Yb2 + ((size_t)(item - G) * SEQ + (row & (SEQ - 1))) * 64 + (lane & 7) * 8);
    }
    d.o = *(const u32x4*)(p.o + (size_t)row * 512 + lane * 8);
  };
  const int stride = gridDim.x * 8;
  int row = blockIdx.x * 8 + wid;
  In cur, nxt;
  if (row < TX) load(cur, row);
  for (; row < TX; row += stride) {
    if (row + stride < TX) load(nxt, row + stride);
    float v[16];
    float ss = 0.f;
#pragma unroll
    for (int c = 0; c < 2; ++c) {
#pragma unroll
      for (int j = 0; j < 4; ++j) {
        float a = (bflo(cur.y[c][j]) + bflo(cur.y2[c][j])) * silu_f(bflo(cur.z[c][j])), b2 = (bfhi(cur.y[c][j]) + bfhi(cur.y2[c][j])) * silu_f(bfhi(cur.z[c][j]));
        v[c * 8 + 2 * j] = a; v[c * 8 + 2 * j + 1] = b2; ss += a * a + b2 * b2;
      }
    }
    const float r = rsqrtf(wave_sum(ss) * (1.f / 1024.f) + EPS);
#pragma unroll
    for (int c = 0; c < 2; ++c) {
      const float* g = p.ssm_norm_g + c * 512 + lane * 8;
      u32x4 w;
#pragma unroll
      for (int j = 0; j < 4; ++j) w[j] = pk_bf16(v[c * 8 + 2 * j] * r * g[2 * j], v[c * 8 + 2 * j + 1] * r * g[2 * j + 1]);
      *(u32x4*)(p.ycat + (size_t)row * 1536 + c * 512 + lane * 8) = w;
    }
    {
      const u32x4 o = cur.o;
      float f[8] = {bflo(o[0]), bfhi(o[0]), bflo(o[1]), bfhi(o[1]), bflo(o[2]), bfhi(o[2]), bflo(o[3]), bfhi(o[3])};
      float s2 = 0.f;
#pragma unroll
      for (int j = 0; j < 8; ++j) s2 += f[j] * f[j];
      const float r2 = rsqrtf(wave_sum(s2) * (1.f / 512.f) + EPS);
      const float* g = p.attn_norm_g + lane * 8;
      u32x4 w;
#pragma unroll
      for (int j = 0; j < 4; ++j) w[j] = pk_bf16(f[2 * j] * r2 * g[2 * j], f[2 * j + 1] * r2 * g[2 * j + 1]);
      *(u32x4*)(p.ycat + (size_t)row * 1536 + 1024 + lane * 8) = w;
    }
    cur = nxt;
  }
}

__device__ void ln1_phase(const Params& p) {
  const int lane = phase_tid() & 63, wid = phase_tid() >> 6;
  const int stride = gridDim.x * 8;
  int row = blockIdx.x * 8 + wid;
  u32x4 nx[2];
  if (row < TX) { nx[0] = *(const u32x4*)(p.pre + (size_t)row * DM + lane * 8); nx[1] = *(const u32x4*)(p.pre + (size_t)row * DM + 512 + lane * 8); }
  for (; row < TX; row += stride) {
    const u32x4 cu[2] = {nx[0], nx[1]};
    if (row + stride < TX) { nx[0] = *(const u32x4*)(p.pre + (size_t)(row + stride) * DM + lane * 8); nx[1] = *(const u32x4*)(p.pre + (size_t)(row + stride) * DM + 512 + lane * 8); }
    float v[16];
#pragma unroll
    for (int c = 0; c < 2; ++c) {
#pragma unroll
      for (int j = 0; j < 4; ++j) { v[c * 8 + 2 * j] = bflo(cu[c][j]); v[c * 8 + 2 * j + 1] = bfhi(cu[c][j]); }
    }
    float s = 0.f;
#pragma unroll
    for (int j = 0; j < 16; ++j) s += v[j];
    const float mu = wave_sum(s) * (1.f / DM);
    float s2 = 0.f;
#pragma unroll
    for (int j = 0; j < 16; ++j) { float d = v[j] - mu; s2 += d * d; }
    const float rstd = rsqrtf(wave_sum(s2) * (1.f / DM) + EPS);
#pragma unroll
    for (int c = 0; c < 2; ++c) {
      const float* g = p.ln1_g + c * 512 + lane * 8; const float* b = p.ln1_b + c * 512 + lane * 8;
      float o[8];
#pragma unroll
      for (int j = 0; j < 8; ++j) o[j] = (v[c * 8 + j] - mu) * rstd * g[j] + b[j];
      *(u32x4*)(p.h1 + (size_t)row * DM + c * 512 + lane * 8) = pack8(o);
      float am = 0.f;
#pragma unroll
      for (int j = 0; j < 8; ++j) am = fmaxf(am, fabsf(o[j]));
      am = fmaxf(am, __builtin_bit_cast(float, __builtin_amdgcn_update_dpp(0, __builtin_bit_cast(int, am), 0x128, 0xf, 0xf, true)));
      am = fmaxf(am, __builtin_bit_cast(float, __builtin_amdgcn_update_dpp(0, __builtin_bit_cast(int, am), 0x124, 0xf, 0xf, true)));
      am = fmaxf(am, __builtin_bit_cast(float, __builtin_amdgcn_update_dpp(0, __builtin_bit_cast(int, am), 0x122, 0xf, 0xf, true)));
      am = fmaxf(am, __builtin_bit_cast(float, __builtin_amdgcn_update_dpp(0, __builtin_bit_cast(int, am), 0x121, 0xf, 0xf, true)));
      const float sc = am > 0.f ? am * (1.f / 127.f) : 1.f;
      const float inv = 1.f / sc;
      unsigned w0 = 0u, w1 = 0u;
#pragma unroll
      for (int j = 0; j < 4; ++j) {
        w0 |= ((unsigned)__float2int_rn(o[j] * inv) & 255u) << (8 * j);
        w1 |= ((unsigned)__float2int_rn(o[4 + j] * inv) & 255u) << (8 * j);
      }
      *(u32x2*)(p.h1q + (size_t)row * DM + c * 512 + lane * 8) = (u32x2){w0, w1};
      if ((lane & 15) == 0) p.sx[(size_t)row * 8 + c * 4 + (lane >> 4)] = sc;
    }
  }
}

template <bool INT8>
__device__ void quant_rows(const float* __restrict__ src, unsigned char* __restrict__ dstq, float* __restrict__ scl) {
  const int lane = phase_tid() & 63, wid = phase_tid() >> 6;
  for (int e = blockIdx.x * 8 + wid; e < 16384; e += gridDim.x * 8) {
    const float* r = src + (size_t)e * 1024 + lane * 4;
    f32x4 a[4];
#pragma unroll
    for (int j = 0; j < 4; ++j) a[j] = *(const f32x4*)(r + j * 256);
    float m = 0.f;
#pragma unroll
    for (int j = 0; j < 4; ++j)
#pragma unroll
      for (int k = 0; k < 4; ++k) m = fmaxf(m, fabsf(a[j][k]));
#pragma unroll
    for (int o = 32; o >= 1; o >>= 1) m = fmaxf(m, __shfl_xor(m, o));
    const float sc = m > 0.f ? m * (INT8 ? (1.f / 127.f) : (1.f / 240.f)) : 1.f;
    const float inv = 1.f / sc;
#pragma unroll
    for (int j = 0; j < 4; ++j) {
      unsigned w;
      if (INT8) {
        w = 0u;
#pragma unroll
        for (int k = 0; k < 4; ++k) w |= ((unsigned)__float2int_rn(a[j][k] * inv) & 255u) << (8 * k);
      } else {
        int t = __builtin_amdgcn_cvt_pk_fp8_f32(a[j][0] * inv, a[j][1] * inv, 0, false);
        t = __builtin_amdgcn_cvt_pk_fp8_f32(a[j][2] * inv, a[j][3] * inv, t, true);
        w = (unsigned)t;
      }
      *(unsigned*)(dstq + ((size_t)(j * 2 + (lane >> 5)) * 16384 + e) * 128 + (lane & 31) * 4) = w;
    }
    if (lane == 0) scl[e] = sc;
  }
}

__device__ __forceinline__ float dpp_add8(float v) {
  v += __builtin_bit_cast(float, __builtin_amdgcn_update_dpp(0, __builtin_bit_cast(int, v), 0xB1, 0xf, 0xf, true));
  v += __builtin_bit_cast(float, __builtin_amdgcn_update_dpp(0, __builtin_bit_cast(int, v), 0x4E, 0xf, 0xf, true));
  v += __builtin_bit_cast(float, __builtin_amdgcn_update_dpp(0, __builtin_bit_cast(int, v), 0x141, 0xf, 0xf, true));
  return v;
}
__device__ __forceinline__ void fp8x16_to_f32(u32x4 w, float (&f)[16]) {
#pragma unroll
  for (int j = 0; j < 4; ++j) {
    f32x2_t lo = __builtin_amdgcn_cvt_pk_f32_fp8((int)w[j], false);
    f32x2_t hi = __builtin_amdgcn_cvt_pk_f32_fp8((int)w[j], true);
    f[4 * j] = lo[0]; f[4 * j + 1] = lo[1]; f[4 * j + 2] = hi[0]; f[4 * j + 3] = hi[1];
  }
}

__device__ void peer_u_phase(const Params& p, char* smem) {
  const int lane = phase_tid() & 63, wid = phase_tid() >> 6;
  const int sg = lane >> 3, q = lane & 7;
  const int nr = gridDim.x >> 3;
  if ((int)blockIdx.x >= nr * 8) return;
  const volatile LAS unsigned* st = (const volatile LAS unsigned*)(smem + LDS_BYTES - 32);
  const bool xok = st[4] != 0u;
  const int slice = xok ? (int)st[2] : (int)(blockIdx.x & 7), rank = xok ? (int)st[3] : (int)(blockIdx.x >> 3);
  const unsigned char* Us = p.Uq + (size_t)slice * 16384 * 128 + q * 16;
  const int stride = nr * 8;
  int t = rank * 8 + wid;
  if (t >= TX) return;
  struct Ids { u32x4 e[2]; u32x4 xq; float sx; };
  auto load_ids = [&](Ids& d, int tt) {
    tt = tt < TX ? tt : TX - 1;
    const unsigned short* ep = p.experts + (size_t)tt * 128 + sg * 16;
    d.e[0] = *(const u32x4*)ep; d.e[1] = *(const u32x4*)(ep + 8);
    d.xq = *(const u32x4*)(p.h1q + (size_t)tt * DM + slice * 128 + q * 16);
    d.sx = p.sx[(size_t)tt * 8 + slice];
  };
  auto issue = [&](u32x4 (&uq)[8], const u32x4& ew) {
#pragma unroll
    for (int j = 0; j < 4; ++j) {
      uq[2 * j] = *(const u32x4*)(Us + (size_t)(ew[j] & 0xffffu) * 128);
      uq[2 * j + 1] = *(const u32x4*)(Us + (size_t)(ew[j] >> 16) * 128);
    }
  };
  auto compute = [&](const u32x4 (&uq)[8], const u32x4& xq, float sxv, float (&pdv)[8]) {
#pragma unroll
    for (int i = 0; i < 8; ++i) {
      int d = 0;
#pragma unroll
      for (int j = 0; j < 4; ++j) d = __builtin_amdgcn_sdot4((int)uq[i][j], (int)xq[j], d, false);
      d += __builtin_amdgcn_update_dpp(0, d, 0xB1, 0xf, 0xf, true);
      d += __builtin_amdgcn_update_dpp(0, d, 0x4E, 0xf, 0xf, true);
      d += __builtin_amdgcn_update_dpp(0, d, 0x141, 0xf, 0xf, true);
      pdv[i] = (float)d * sxv;
    }
  };
  auto step = [&](Ids& cur, Ids& nxt, Ids& nn, u32x4 (&P)[8], u32x4 (&Q)[8], u32x4 (&R)[8]) -> bool {
    const bool has1 = t + stride < TX;
    issue(R, nxt.e[0]);
    load_ids(nn, t + 2 * stride);
    float pa[8], pb[8];
    compute(P, cur.xq, cur.sx, pa);
    issue(P, nxt.e[1]);
    compute(Q, cur.xq, cur.sx, pb);
    if (q == 0) {
      bf16_t* dst = p.pd + ((size_t)slice * TX + t) * 128 + sg * 16;
      *(u32x4*)dst = (u32x4){pk_bf16(pa[0], pa[1]), pk_bf16(pa[2], pa[3]), pk_bf16(pa[4], pa[5]), pk_bf16(pa[6], pa[7])};
      *(u32x4*)(dst + 8) = (u32x4){pk_bf16(pb[0], pb[1]), pk_bf16(pb[2], pb[3]), pk_bf16(pb[4], pb[5]), pk_bf16(pb[6], pb[7])};
    }
    return has1;
  };
  Ids A, B, C;
  u32x4 X[8], Y[8], Z[8];
  load_ids(A, t);
  load_ids(B, t + stride);
  issue(X, A.e[0]);
  issue(Y, A.e[1]);
  for (;;) {
    if (!step(A, B, C, X, Y, Z)) break;
    t += stride;
    if (!step(B, C, A, Z, X, Y)) break;
    t += stride;
    if (!step(C, A, B, Y, Z, X)) break;
    t += stride;
  }
}

__device__ void peer_c_phase(const Params& p) {
  const size_t n4 = (size_t)TX * 128 / 4;
  const int tid = phase_tid();
  for (size_t i0 = (size_t)blockIdx.x * NTHREADS; i0 < n4; i0 += (size_t)gridDim.x * NTHREADS) {
    const size_t i = i0 + tid;
    f32x4 s = {0.f, 0.f, 0.f, 0.f};
#pragma unroll
    for (int sl = 0; sl < 8; ++sl) {
      const u32x2 w = *(const u32x2*)(p.pd + (size_t)sl * TX * 128 + i * 4);
      s[0] += bflo(w[0]); s[1] += bfhi(w[0]); s[2] += bflo(w[1]); s[3] += bfhi(w[1]);
    }
    const f32x4 g = *(const f32x4*)(p.gates + i * 4);
    const u32x2 ew = *(const u32x2*)(p.experts + i * 4);
    const int ev[4] = {(int)(ew[0] & 0xffffu), (int)(ew[0] >> 16), (int)(ew[1] & 0xffffu), (int)(ew[1] >> 16)};
    float c[4];
    float am = 0.f;
#pragma unroll
    for (int j = 0; j < 4; ++j) {
      const float d = s[j] * p.su[ev[j]];
      c[j] = g[j] * 0.5f * d * (1.f + erff(d * 0.70710678118654752f)) * p.sv[ev[j]];
      am = fmaxf(am, fabsf(c[j]));
    }
#pragma unroll
    for (int o = 16; o >= 1; o >>= 1) am = fmaxf(am, __shfl_xor(am, o));
    const float sc = am > 0.f ? am * (1.f / 240.f) : 1.f;
    const float inv = 1.f / sc;
    int w = __builtin_amdgcn_cvt_pk_fp8_f32(c[0] * inv, c[1] * inv, 0, false);
    w = __builtin_amdgcn_cvt_pk_fp8_f32(c[2] * inv, c[3] * inv, w, true);
    const size_t t = i >> 5; const int gq = (int)(i & 31);
    const int c4 = gq & 3, sgq = gq >> 2, a4 = sgq >> 2, r4 = sgq & 3;
    unsigned outw = 0u;
#pragma unroll
    for (int m = 0; m < 4; ++m) {
      const int srcl = (tid & 32) + (4 * a4 + m) * 4 + c4;
      const unsigned vm = (unsigned)__builtin_amdgcn_ds_bpermute(srcl * 4, w);
      outw |= ((vm >> (8 * r4)) & 255u) << (8 * m);
    }
    ((unsigned*)(p.cq + t * 128))[(4 * c4 + r4) * 2 + a4] = outw;
    if (gq == 0) p.csc[t] = sc;
  }
}

typedef int v2i_t __attribute__((ext_vector_type(2)));
constexpr int PV_BLK = 1024 + 32;
constexpr int PV_WAVE_LDS = 16 * PV_BLK + 512;
static_assert(8 * PV_WAVE_LDS <= 160 * 1024 - 64, "peer v lds");
__device__ void peer_v_phase(const Params& p, char* smem) {
  const int lane = phase_tid() & 63, wid = __builtin_amdgcn_readfirstlane(phase_tid() >> 6);
  const int sg = (lane >> 2) & 7, q = (lane >> 5) * 4 + (lane & 3);
  const int kg = lane >> 4;
  const int nr = gridDim.x >> 3;
  if ((int)blockIdx.x >= nr * 8) return;
  const volatile LAS unsigned* st = (const volatile LAS unsigned*)(smem + LDS_BYTES - 32);
  const bool xok = st[4] != 0u;
  const int slice = xok ? (int)st[2] : (int)(blockIdx.x & 7), rank = xok ? (int)st[3] : (int)(blockIdx.x >> 3);
  const unsigned char* Vs = p.Vq + (size_t)slice * 16384 * 128 + q * 16;
  LAS char* wb = (LAS char*)smem + wid * PV_WAVE_LDS;
  const int stride = nr * 8;
  int t = rank * 8 + wid;
  if (t >= TX) return;
  struct Ids { u32x4 e[2]; u32x2 a[4]; float sc; };
  auto load_ids = [&](Ids& d, int tt) {
    tt = tt < TX ? tt : TX - 1;
    const unsigned short* ep = p.experts + (size_t)tt * 128 + sg * 16;
    d.e[0] = *(const u32x4*)ep; d.e[1] = *(const u32x4*)(ep + 8);
    const unsigned char* cp = p.cq + (size_t)tt * 128 + kg * 8;
#pragma unroll
    for (int ks = 0; ks < 4; ++ks) d.a[ks] = *(const u32x2*)(cp + ks * 32);
    d.sc = p.csc[tt];
  };
  auto issue = [&](u32x4 (&vq)[8], const u32x4& ew) {
#pragma unroll
    for (int j = 0; j < 4; ++j) {
      vq[2 * j] = *(const u32x4*)(Vs + (size_t)(ew[j] & 0xffffu) * 128);
      vq[2 * j + 1] = *(const u32x4*)(Vs + (size_t)(ew[j] >> 16) * 128);
    }
  };
  auto commit = [&](int half, const u32x4 (&vq)[8]) {
#pragma unroll
    for (int j = 0; j < 8; ++j) *(LAS u32x4*)(wb + (half * 8 + j) * PV_BLK + lane * 16) = vq[j];
  };
  f32x4 acc[8];
  const int troff = ((lane & 15) >> 1) * 64 + (lane & 1) * 8;
  auto consume = [&](int half, const Ids& d) {
#pragma unroll
    for (int k2 = 0; k2 < 2; ++k2) {
      const u32x2 av = d.a[half * 2 + k2];
      const long a = (long)(((unsigned long long)av[1] << 32) | (unsigned long long)av[0]);
      const LAS char* blk = wb + (half * 8 + k2 * 4 + kg) * PV_BLK + troff;
#pragma unroll
      for (int nt = 0; nt < 8; ++nt) {
        const v2i_t bv = __builtin_amdgcn_ds_read_tr8_b64_v2i32((LAS v2i_t*)(blk + (nt >> 2) * 512 + (nt & 3) * 16));
        const long bl = (long)(((unsigned long long)(unsigned)bv[1] << 32) | (unsigned long long)(unsigned)bv[0]);
        acc[nt] = __builtin_amdgcn_mfma_f32_16x16x32_fp8_fp8(a, bl, acc[nt], 0, 0, 0);
      }
    }
  };
  auto step = [&](Ids& cur, Ids& nxt, Ids& nn, u32x4 (&P)[8], u32x4 (&Q)[8], u32x4 (&R)[8]) -> bool {
    const bool has1 = t + stride < TX;
    issue(R, nxt.e[0]);
    load_ids(nn, t + 2 * stride);
    const bf16_t* xp = p.h1 + (size_t)t * DM + slice * 128 + (lane & 7) * 16;
    const u32x4 xa = *(const u32x4*)xp, xb = *(const u32x4*)(xp + 8);
#pragma unroll
    for (int nt = 0; nt < 8; ++nt) acc[nt] = (f32x4){0.f, 0.f, 0.f, 0.f};
    commit(0, P);
    consume(0, cur);
    issue(P, nxt.e[1]);
    commit(1, Q);
    consume(1, cur);
    LAS float* yt = (LAS float*)(wb + 16 * PV_BLK);
    if (lane < 16) {
#pragma unroll
      for (int nt = 0; nt < 8; ++nt) yt[nt * 16 + lane] = acc[nt][0];
    }
    asm volatile("s_waitcnt lgkmcnt(0)" ::: "memory");
    if (lane < 8) {
      float v[16];
#pragma unroll
      for (int j = 0; j < 4; ++j) { const f32x4 f = *(const LAS f32x4*)(yt + lane * 16 + j * 4); v[4 * j] = f[0]; v[4 * j + 1] = f[1]; v[4 * j + 2] = f[2]; v[4 * j + 3] = f[3]; }
      float xs[16];
#pragma unroll
      for (int j = 0; j < 4; ++j) { xs[2 * j] = bflo(xa[j]); xs[2 * j + 1] = bfhi(xa[j]); xs[8 + 2 * j] = bflo(xb[j]); xs[8 + 2 * j + 1] = bfhi(xb[j]); }
      bf16_t* dst = p.pre2 + (size_t)t * DM + slice * 128 + lane * 16;
      u32x4 w0, w1;
#pragma unroll
      for (int j = 0; j < 4; ++j) {
        w0[j] = pk_bf16(ALPHA * xs[2 * j] + cur.sc * v[2 * j], ALPHA * xs[2 * j + 1] + cur.sc * v[2 * j + 1]);
        w1[j] = pk_bf16(ALPHA * xs[8 + 2 * j] + cur.sc * v[8 + 2 * j], ALPHA * xs[8 + 2 * j + 1] + cur.sc * v[8 + 2 * j + 1]);
      }
      *(u32x4*)dst = w0; *(u32x4*)(dst + 8) = w1;
    }
    return has1;
  };
  Ids A, B, C;
  u32x4 X[8], Y[8], Z[8];
  load_ids(A, t);
  load_ids(B, t + stride);
  issue(X, A.e[0]);
  issue(Y, A.e[1]);
  for (;;) {
    if (!step(A, B, C, X, Y, Z)) break;
    t += stride;
    if (!step(B, C, A, Z, X, Y)) break;
    t += stride;
    if (!step(C, A, B, Y, Z, X)) break;
    t += stride;
  }
}

__device__ void ln2_phase(const Params& p) {
  const int lane = phase_tid() & 63, wid = phase_tid() >> 6;
  const int stride = gridDim.x * 8;
  int row = blockIdx.x * 8 + wid;
  u32x2 nx[4];
  if (row < TX) {
#pragma unroll
    for (int c = 0; c < 4; ++c) nx[c] = *(const u32x2*)(p.pre2 + (size_t)row * DM + c * 256 + lane * 4); }
  for (; row < TX; row += stride) {
    float* dst = p.out + (size_t)row * DM;
    float v[16];
#pragma unroll
    for (int c = 0; c < 4; ++c) { v[c * 4] = bflo(nx[c][0]); v[c * 4 + 1] = bfhi(nx[c][0]); v[c * 4 + 2] = bflo(nx[c][1]); v[c * 4 + 3] = bfhi(nx[c][1]); }
    if (row + stride < TX) {
#pragma unroll
      for (int c = 0; c < 4; ++c) nx[c] = *(const u32x2*)(p.pre2 + (size_t)(row + stride) * DM + c * 256 + lane * 4); }
    float s = 0.f;
#pragma unroll
    for (int j = 0; j < 16; ++j) s += v[j];
    const float mu = wave_sum(s) * (1.f / DM);
    float s2 = 0.f;
#pragma unroll
    for (int j = 0; j < 16; ++j) { float d = v[j] - mu; s2 += d * d; }
    const float rstd = rsqrtf(wave_sum(s2) * (1.f / DM) + EPS);
#pragma unroll
    for (int c = 0; c < 4; ++c) {
      const f32x4 g = *(const f32x4*)(p.ln2_g + c * 256 + lane * 4), bb = *(const f32x4*)(p.ln2_b + c * 256 + lane * 4);
      f32x4 o;
#pragma unroll
      for (int j = 0; j < 4; ++j) o[j] = (v[c * 4 + j] - mu) * rstd * g[j] + bb[j];
      *(f32x4*)(dst + c * 256 + lane * 4) = o;
    }
  }
}


#define XB_TMO      128
#define XB_XCNT(j)  (256  + 64 * (j))
#define XB_XSUB(j)  (1280 + 64 * (j))
#define XB_XGEN(j)  (2304 + 64 * (j))
#define XB_TOP      3328
#define XB_TOPGEN   3392
#define XCD_BAR_WORDS 3456
#define XB_SPIN_CAP (1u << 22)
__device__ __forceinline__ unsigned xb_ld(unsigned* p)              { return __hip_atomic_load(p, __ATOMIC_RELAXED, __HIP_MEMORY_SCOPE_AGENT); }
__device__ __forceinline__ unsigned xb_add(unsigned* p, unsigned v) { return __hip_atomic_fetch_add(p, v, __ATOMIC_RELAXED, __HIP_MEMORY_SCOPE_AGENT); }
__device__ __forceinline__ unsigned xb_xcc_id() { return (unsigned)__builtin_amdgcn_s_getreg((3 << 11) | 20) & 0xFu; }
#define XB_SPIN(cond, bar) do { unsigned _sp = 0; while (cond) { __builtin_amdgcn_s_sleep(1); \
    if ((++_sp & 255u) == 0u) { if (xb_ld(&(bar)[XB_TMO])) break; if (_sp > XB_SPIN_CAP) { atomicAdd(&(bar)[XB_TMO], 1u); break; } } } } while (0)
struct XcdBarrier { unsigned* bar; unsigned x; volatile LAS unsigned* st; };
__device__ __forceinline__ XcdBarrier xcd_barrier_post(unsigned* bar, volatile LAS unsigned* st) {
  XcdBarrier b; b.bar = bar; b.x = xb_xcc_id(); b.st = st;
  if (threadIdx.x == 0) (void)xb_add(&bar[XB_XCNT(b.x)], 1u);
  return b;
}
__device__ __forceinline__ void xcd_barrier_complete(unsigned* bar, unsigned x, unsigned& nloc, unsigned& nx) {
  const unsigned G = gridDim.x * gridDim.y * gridDim.z;
  unsigned sum, cnt, mine, sp = 0u;
  for (;;) {
    sum = 0u; cnt = 0u; mine = 0u;
#pragma unroll
    for (unsigned j = 0; j < 16; ++j) { const unsigned c = xb_ld(&bar[XB_XCNT(j)]); sum += c; cnt += (c > 0u) ? 1u : 0u; mine = (j == x) ? c : mine; }
    if (sum == G) break;
    __builtin_amdgcn_s_sleep(1);
    if ((++sp & 255u) == 0u) { if (xb_ld(&bar[XB_TMO])) break; if (sp > XB_SPIN_CAP) { atomicAdd(&bar[XB_TMO], 1u); break; } }
  }
  nloc = mine > 0u ? mine : 1u; nx = cnt > 0u ? cnt : 1u;
}
__device__ __forceinline__ void xcd_barrier(const XcdBarrier& b) {
  asm volatile("s_waitcnt vmcnt(0)" ::: "memory");
  __syncthreads();
  if (threadIdx.x == 0) {
    unsigned* bar = b.bar;
    __builtin_amdgcn_s_waitcnt(0);
    unsigned nloc = b.st[0], nx = b.st[1];
    if (nloc == 0u) { xcd_barrier_complete(bar, b.x, nloc, nx); b.st[0] = nloc; b.st[1] = nx; }
    const unsigned old = xb_add(&bar[XB_XSUB(b.x)], 1u);
    const unsigned gen = old / nloc;
    if (old + 1u == (gen + 1u) * nloc) {
      __builtin_amdgcn_fence(__ATOMIC_RELEASE, "agent");
      asm volatile("s_waitcnt vmcnt(0)" ::: "memory");
      const unsigned og = xb_add(&bar[XB_TOP], 1u);
      const unsigned tg = og / nx;
      if (og + 1u == (tg + 1u) * nx) xb_add(&bar[XB_TOPGEN], 1u);
      else XB_SPIN(xb_ld(&bar[XB_TOPGEN]) == tg, bar);
      __builtin_amdgcn_fence(__ATOMIC_ACQUIRE, "agent");
      xb_add(&bar[XB_XGEN(b.x)], 1u);
      asm volatile("s_waitcnt vmcnt(0)" ::: "memory");
    } else {
      XB_SPIN(xb_ld(&bar[XB_XGEN(b.x)]) == gen, bar);
      __builtin_amdgcn_fence(__ATOMIC_ACQUIRE, "agent");
      asm volatile("s_waitcnt vmcnt(0)" ::: "memory");
    }
  }
  __syncthreads();
}

template <int PH>
__device__ __forceinline__ void run_phase(const Params& p, char* smem) {
  if constexpr (PH == 0) {
    transpose_convert(p.w_in, p.WinT, 1024, 3264, DINP, smem);
    transpose_convert(p.w_uq, p.WuqT, 384, 768, 768, smem);
    for (int i = blockIdx.x * NTHREADS + threadIdx.x; i < 512 * 256; i += gridDim.x * NTHREADS) {
      const int j = i >> 8, k = i & 255;
      const float* src = p.w_ukv + (size_t)k * 1024 + (j >> 6) * 128 + (j & 63);
      p.WkT[i] = f2bf(src[0]); p.WvT[i] = f2bf(src[64]);
    }
    transpose_convert(p.w_out, p.WoutT, 1536, 1024, 1024, smem);
    fold_peer(p, smem);
    ln_in_phase(p);
  } else if constexpr (PH == 1) {
    pg8::run(smem, p.h0, p.WinT, TP, DINP, 1024, pg8::EpiBf16S{p.z, 1024, 1024, p.xbc_raw, 1536, 2560, p.rest, 768});
  } else if constexpr (PH == 2) {
    conv_phase(p, smem);
    token_phase(p);
    dt_phase(p);
  } else if constexpr (PH == 3) {
    pg8::run(smem, p.cqn, p.WuqT, TX, 768, 384, pg8::EpiBf16S{p.q, 768, 1 << 30, nullptr, 0, 1 << 30, nullptr, 0});
    pg8::run(smem, p.ckvn, p.WkT, TP, 512, 256, pg8::EpiBf16S{p.Kb, 512, 1 << 30, nullptr, 0, 1 << 30, nullptr, 0});
    pg8::run(smem, p.WvT, p.ckvn, 512, TP, 256, pg8::EpiBf16S{p.vT, TP, 1 << 30, nullptr, 0, 1 << 30, nullptr, 0});
  } else if constexpr (PH == 4) {
    attn_phase(p, smem);
  } else if constexpr (PH == 5) {
    ssd_phase(p, smem);
  } else if constexpr (PH == 6) {
    gate_phase(p);
  } else if constexpr (PH == 7) {
    pg8::run(smem, p.ycat, p.WoutT, TX, 1024, 1536, pg8::EpiOutRes{p.pre, p.h0});
  } else if constexpr (PH == 8) {
    ln1_phase(p);
    quant_rows<true>(p.peer_u, p.Uq, p.su);
    quant_rows<false>(p.peer_v, p.Vq, p.sv);
  } else if constexpr (PH == 9) {
    pg8::run_drained(smem, p.h1, p.WpT, TX, 2048, 1024, pg8::EpiPeerScore{p.experts, p.gates});
  } else if constexpr (PH == 11) {
    peer_u_phase(p, smem);
  } else if constexpr (PH == 12) {
    peer_c_phase(p);
  } else if constexpr (PH == 13) {
    peer_v_phase(p, smem);
  } else if constexpr (PH == 14) {
    ln2_phase(p);
  } else if constexpr (PH == 15) {
    ssd_diag_phase(p, smem);
  }
}

__global__ void __launch_bounds__(NTHREADS) mega_kernel(Params p) {
  extern __shared__ __attribute__((aligned(16))) char smem[];
  cg::grid_group grid = cg::this_grid();
  volatile LAS unsigned* st = (volatile LAS unsigned*)(smem + LDS_BYTES - 32);
  if (threadIdx.x == 0) {
    st[0] = 0u; st[1] = 0u;
    const unsigned xcc = xb_xcc_id();
    st[2] = xcc; st[3] = xb_add(&p.bar[xcc], 1u);
  }
  __syncthreads();
  XcdBarrier xb = xcd_barrier_post(p.bar, st);
  run_phase<0>(p, smem); grid.sync();
  if (threadIdx.x == 0) {
    unsigned ok = (gridDim.x & 7u) == 0u ? 1u : 0u;
    for (unsigned j = 0; j < 16; ++j) { const unsigned c = xb_ld(&p.bar[j]); if (c != (j < 8 ? gridDim.x >> 3 : 0u)) ok = 0u; }
    st[4] = ok;
  }
  __syncthreads();
  run_phase<1>(p, smem); xcd_barrier(xb);
  run_phase<2>(p, smem); xcd_barrier(xb);
  run_phase<15>(p, smem); xcd_barrier(xb);
  run_phase<5>(p, smem); xcd_barrier(xb);
  run_phase<3>(p, smem); xcd_barrier(xb);
  run_phase<4>(p, smem); xcd_barrier(xb);
  run_phase<6>(p, smem); xcd_barrier(xb);
  run_phase<7>(p, smem); xcd_barrier(xb);
  run_phase<8>(p, smem); xcd_barrier(xb);
  run_phase<9>(p, smem); xcd_barrier(xb);
  run_phase<11>(p, smem); xcd_barrier(xb);
  run_phase<12>(p, smem); xcd_barrier(xb);
  run_phase<13>(p, smem); xcd_barrier(xb);
  run_phase<14>(p, smem);
}

extern "C" void kernel_launch(void* const* d_in, const int* in_sizes, int n_in,
                              void* d_out, int out_size, void* d_ws, size_t ws_size,
                              hipStream_t stream) {
  Params p{};
  const float** in = (const float**)&p.x_prompt;
  for (int i = 0; i < 28; ++i) in[i] = (const float*)d_in[i];
  p.out = (float*)d_out;
  char* ws = (char*)d_ws;
  size_t off = 0;
  auto take = [&](size_t bytes) { char* r = ws + off; off += (bytes + 255) & ~(size_t)255; return r; };
  p.h0 = (bf16_t*)take((size_t)TP * 1024 * 2);
  p.WinT = (bf16_t*)take((size_t)DINP * 1024 * 2);
  p.WuqT = (bf16_t*)take((size_t)768 * 384 * 2);
  p.WkT = (bf16_t*)take((size_t)512 * 256 * 2);
  p.WvT = (bf16_t*)take((size_t)512 * 256 * 2);
  p.WoutT = (bf16_t*)take((size_t)1024 * 1536 * 2);
  p.WpT = (bf16_t*)take((size_t)2048 * 1024 * 2);
  char* zreg = take((size_t)TP * 1024 * 2);
  char* r1 = take((size_t)TP * 1536 * 2);
  char* r2 = take((size_t)TP * 768 * 2);
  p.cqn = (bf16_t*)take((size_t)TP * 384 * 2);
  p.ckvn = (bf16_t*)take((size_t)TP * 256 * 2);
  p.kr = (bf16_t*)take((size_t)TP * 32 * 2);
  p.dtv = (float*)take((size_t)NSEQ * 2 * 16 * LP * 4);
  p.Pv = (float*)take((size_t)NSEQ * 2 * 16 * LP * 4);
  p.Atot = (float*)take((size_t)NSEQ * 2 * 16 * NCH * 4);
  p.bar = (unsigned*)take((size_t)XCD_BAR_WORDS * 4);
  if (off > ws_size) { fprintf(stderr, "workspace too small: need %zu have %zu\n", off, ws_size); return; }
  p.z = (bf16_t*)zreg;
  p.xbc_raw = (bf16_t*)r1;
  p.rest = (bf16_t*)r2;
  char* dout = (char*)d_out;
  p.XT = (bf16_t*)dout;
  p.Cm = (bf16_t*)(dout + (size_t)NSEQ * NCH * 16 * 64 * 128 * 2);
  p.Bm = p.Cm + (size_t)NSEQ * LP * 256;
  p.BmT = p.Bm + (size_t)NSEQ * LP * 256;
  p.pre = (bf16_t*)d_out;
  p.Kb = (bf16_t*)dout;
  p.vT = p.Kb + (size_t)TP * 512;
  p.o = p.vT + (size_t)512 * TP;
  p.Y = (bf16_t*)r1;
  p.Yb2 = p.Y + (size_t)TX * 1024;
  p.q = (bf16_t*)r2;
  p.ycat = (bf16_t*)r2;
  p.h1 = p.h0;
  p.Uq = (unsigned char*)zreg;
  p.Vq = p.Uq + (size_t)8 * 16384 * 128;
  p.su = (float*)(p.Vq + (size_t)8 * 16384 * 128);
  p.sv = p.su + 16384;
  p.sx = p.sv + 16384;
  p.h1q = (unsigned char*)(p.sx + (size_t)TX * 8);
  p.pd = (bf16_t*)d_out;
  p.cq = (unsigned char*)r2;
  p.csc = (float*)(r2 + (size_t)8 * 1024 * 1024);
  p.pre2 = (bf16_t*)(r2 + (size_t)16 * 1024 * 1024);
  p.experts = (unsigned short*)(r1 + (size_t)TX * 256 * 4);
  p.gates = (float*)(r1 + (size_t)TX * 256 * 4 + (size_t)TX * 128 * 4);

  static int grid_blocks = 0;
  if (!grid_blocks) {
    int dev = 0, cus = 0, per_cu = 0;
    (void)hipGetDevice(&dev);
    (void)hipDeviceGetAttribute(&cus, hipDeviceAttributeMultiprocessorCount, dev);
    (void)hipFuncSetAttribute((const void*)mega_kernel, hipFuncAttributeMaxDynamicSharedMemorySize, (int)LDS_BYTES);
    (void)hipOccupancyMaxActiveBlocksPerMultiprocessor(&per_cu, mega_kernel, NTHREADS, LDS_BYTES);
    if (per_cu > 1) per_cu = 1;
    grid_blocks = cus * per_cu;
  }
  (void)hipMemsetAsync(p.bar, 0, (size_t)XCD_BAR_WORDS * 4, stream);
  void* args[] = {&p};
  hipError_t e = hipLaunchCooperativeKernel((void*)mega_kernel, dim3(grid_blocks), dim3(NTHREADS), args, LDS_BYTES, stream);
  if (e != hipSuccess) fprintf(stderr, "cooperative launch failed: %s (grid %d)\n", hipGetErrorString(e), grid_blocks);
}
```

```cpp
#include <hip/hip_runtime.h>
#include <hip/hip_cooperative_groups.h>
#include <cstdio>
#include <cstdint>
namespace cg = cooperative_groups;

typedef unsigned short bf16_t;
typedef short bf16x8 __attribute__((ext_vector_type(8)));
typedef float f32x4 __attribute__((ext_vector_type(4)));
typedef float f32x16 __attribute__((ext_vector_type(16)));
typedef unsigned u32x4 __attribute__((ext_vector_type(4)));
typedef unsigned u32x2 __attribute__((ext_vector_type(2)));

#define NTHREADS 512
#define LAS __attribute__((address_space(3)))
constexpr int DM = 1024;
constexpr int NSEQ = 24, SEQ = 2048, NMETA = 16, LSEQ = 2064;
constexpr int TX = NSEQ * SEQ;
constexpr int TM = TX + NMETA;
constexpr int TP = 49408;
constexpr int LP = 2176, NCH = 17, MPAD = 112;
constexpr int DINP = 3328;
constexpr float EPS = 1e-5f;
constexpr float ALPHA = 1.189207115002721f;
constexpr size_t LDS_BYTES = 160 * 1024;

struct Params {
  const float *x_prompt, *x_sample, *meta, *ln_in_g, *ln_in_b, *w_in, *conv_w, *conv_b,
      *dt_bias_f, *dt_bias_b, *a_log_f, *a_log_b, *d_skip, *ssm_norm_g, *q_norm_g, *w_uq, *kv_norm_g, *w_ukv,
      *attn_norm_g, *w_out, *ln1_g, *ln1_b, *peer_wq, *peer_sk, *peer_u, *peer_v, *ln2_g, *ln2_b;
  float* out;
  bf16_t *h0, *WinT, *WuqT, *WkT, *WvT, *WoutT, *WpT, *z, *xbc_raw, *rest, *cqn, *ckvn, *kr;
  float *dtv, *Pv, *Atot;
  bf16_t *XT, *Cm, *Bm, *BmT;
  bf16_t *q, *Kb, *vT, *o, *Y, *Yb2, *ycat, *h1;
  unsigned char *Uq, *Vq;
  unsigned char* h1q;
  float *su, *sv, *sx;
  bf16_t* pd;
  bf16_t* pre2;
  unsigned char* cq;
  float* csc;
  unsigned* bar;
  bf16_t* pre;
  unsigned short* experts;
  float* gates;
};

__device__ __forceinline__ int phase_tid() { int t = threadIdx.x; asm volatile("" : "+v"(t)); return t; }
__device__ __forceinline__ void lds_barrier() {
  asm volatile("s_waitcnt lgkmcnt(0)" ::: "memory");
  __builtin_amdgcn_s_barrier();
  asm volatile("" ::: "memory");
}
__device__ __forceinline__ float bf2f(bf16_t v) { return __uint_as_float(((unsigned)v) << 16); }
__device__ __forceinline__ float bflo(unsigned v) { return __uint_as_float(v << 16); }
__device__ __forceinline__ float bfhi(unsigned v) { return __uint_as_float(v & 0xffff0000u); }
typedef __bf16 bf16x2_t __attribute__((ext_vector_type(2)));
typedef float f32x2_t __attribute__((ext_vector_type(2)));
__device__ __forceinline__ unsigned pk_bf16(float lo, float hi) {
  f32x2_t f = {lo, hi};
  bf16x2_t b = __builtin_convertvector(f, bf16x2_t);
  return __builtin_bit_cast(unsigned, b);
}
__device__ __forceinline__ bf16_t f2bf(float f) { return (bf16_t)(pk_bf16(f, 0.f) & 0xffffu); }
template <int CTRL> __device__ __forceinline__ float dpp_f(float v) { return __builtin_bit_cast(float, __builtin_amdgcn_update_dpp(0, __builtin_bit_cast(int, v), CTRL, 0xf, 0xf, true)); }
template <int CTRL> __device__ __forceinline__ unsigned dpp_u(unsigned v) { return (unsigned)__builtin_amdgcn_update_dpp(0, (int)v, CTRL, 0xf, 0xf, true); }
__device__ __forceinline__ unsigned lane_xor1(unsigned v) { return dpp_u<0xB1>(v); }
__device__ __forceinline__ unsigned lane_xor2(unsigned v) { return dpp_u<0x4E>(v); }
__device__ __forceinline__ float row16_sum(float v) {
  v += dpp_f<0xB1>(v); v += dpp_f<0x4E>(v); v += dpp_f<0x141>(v); v += dpp_f<0x140>(v); return v; }
__device__ __forceinline__ float row16_max(float v) {
  v = fmaxf(v, dpp_f<0xB1>(v)); v = fmaxf(v, dpp_f<0x4E>(v)); v = fmaxf(v, dpp_f<0x141>(v)); v = fmaxf(v, dpp_f<0x140>(v)); return v; }
__device__ __forceinline__ float swap16_sum(float v) { auto r = __builtin_amdgcn_permlane16_swap(__float_as_uint(v), __float_as_uint(v), false, false); return __uint_as_float(r[0]) + __uint_as_float(r[1]); }
__device__ __forceinline__ float swap32_sum(float v) { auto r = __builtin_amdgcn_permlane32_swap(__float_as_uint(v), __float_as_uint(v), false, false); return __uint_as_float(r[0]) + __uint_as_float(r[1]); }
__device__ __forceinline__ float swap16_max(float v) { auto r = __builtin_amdgcn_permlane16_swap(__float_as_uint(v), __float_as_uint(v), false, false); return fmaxf(__uint_as_float(r[0]), __uint_as_float(r[1])); }
__device__ __forceinline__ float swap32_max(float v) { auto r = __builtin_amdgcn_permlane32_swap(__float_as_uint(v), __float_as_uint(v), false, false); return fmaxf(__uint_as_float(r[0]), __uint_as_float(r[1])); }
__device__ __forceinline__ float wave_sum(float v) { return swap32_sum(swap16_sum(row16_sum(v))); }
__device__ __forceinline__ float wave_max(float v) { return swap32_max(swap16_max(row16_max(v))); }
__device__ __forceinline__ void fast_sincos(float ang, float& sn, float& cs) {
  const float r = __builtin_amdgcn_fractf(ang * 0.15915494309189535f);
  sn = __builtin_amdgcn_sinf(r); cs = __builtin_amdgcn_cosf(r);
}
__device__ __forceinline__ float silu_f(float x) { return x * __builtin_amdgcn_rcpf(1.f + __expf(-x)); }
__device__ __forceinline__ int row_of(int seq, int pos) { return pos < NMETA ? TX + pos : seq * SEQ + pos - NMETA; }
__device__ __forceinline__ bf16x8 as_bf16x8(u32x4 v) { return __builtin_bit_cast(bf16x8, v); }

__device__ void transpose_convert(const float* in, bf16_t* out, int R, int C, int CP, char* smem) {
  float* tile = (float*)smem;
  const int tr = (R + 63) / 64, tc = (CP + 63) / 64;
  for (int t = blockIdx.x; t < tr * tc; t += gridDim.x) {
    const int r0 = (t / tc) * 64, c0 = (t % tc) * 64;
    __syncthreads();
    for (int i = phase_tid(); i < 4096; i += NTHREADS) {
      int r = i >> 6, c = i & 63;
      float v = 0.f;
      if (r0 + r < R && c0 + c < C) v = in[(size_t)(r0 + r) * C + c0 + c];
      tile[r * 65 + c] = v;
    }
    __syncthreads();
    for (int i = phase_tid(); i < 4096; i += NTHREADS) {
      int c = i >> 6, r = i & 63;
      if (r0 + r < R && c0 + c < CP) out[(size_t)(c0 + c) * R + r0 + r] = f2bf(tile[r * 65 + c]);
    }
  }
}

__device__ void fold_peer(const Params& p, char* smem) {
  float* wq_s = (float*)smem;
  float* sk_s = wq_s + 32 * 128;
  for (int item = blockIdx.x; item < 16 * 32; item += gridDim.x) {
    const int hj2 = item >> 5, k0 = (item & 31) * 32;
    const int h = hj2 >> 1, j = hj2 & 1;
    const float* skp = p.peer_sk + (size_t)(j * 8 + h) * 128 * 128;
    __syncthreads();
    for (int i = phase_tid(); i < 32 * 128; i += NTHREADS) {
      int k = i >> 7, d = i & 127;
      wq_s[i] = p.peer_wq[(size_t)(k0 + k) * 2048 + hj2 * 128 + d];
    }
    for (int i = phase_tid(); i < 128 * 128; i += NTHREADS) {
      int n = i >> 7, d = i & 127;
      sk_s[n * 129 + d] = skp[i];
    }
    __syncthreads();
    const int n = phase_tid() & 127, kq = phase_tid() >> 7;
    float acc[8];
#pragma unroll
    for (int i = 0; i < 8; ++i) acc[i] = 0.f;
    for (int d = 0; d < 128; ++d) {
      float s = sk_s[n * 129 + d];
#pragma unroll
      for (int i = 0; i < 8; ++i) acc[i] += wq_s[(kq * 8 + i) * 128 + d] * s;
    }
    u32x4 v;
    v[0] = pk_bf16(acc[0], acc[1]); v[1] = pk_bf16(acc[2], acc[3]);
    v[2] = pk_bf16(acc[4], acc[5]); v[3] = pk_bf16(acc[6], acc[7]);
    *(u32x4*)(p.WpT + (size_t)(hj2 * 128 + n) * 1024 + k0 + kq * 8) = v;
  }
}

__device__ void ln_in_phase(const Params& p) {
  const int lane = phase_tid() & 63, wid = phase_tid() >> 6;
  const int stride = gridDim.x * 8;
  auto src_of = [&](int row) -> const float* {
    return row < 8 * SEQ ? p.x_prompt + (size_t)row * DM : row < TX ? p.x_sample + (size_t)(row - 8 * SEQ) * DM : p.meta + (size_t)(row - TX) * DM;
  };
  int row = blockIdx.x * 8 + wid;
  f32x4 nx[4];
  if (row < TM) { const float* sp = src_of(row);
#pragma unroll
    for (int c = 0; c < 4; ++c) nx[c] = *(const f32x4*)(sp + c * 256 + lane * 4); }
  for (; row < TP; row += stride) {
    bf16_t* dst = p.h0 + (size_t)row * DM;
    if (row >= TM) {
      u32x4 zv = {0u, 0u, 0u, 0u};
      *(u32x4*)(dst + lane * 8) = zv; *(u32x4*)(dst + 512 + lane * 8) = zv;
      continue;
    }
    float v[16];
#pragma unroll
    for (int c = 0; c < 4; ++c)
#pragma unroll
      for (int j = 0; j < 4; ++j) v[c * 4 + j] = nx[c][j];
    if (row + stride < TM) { const float* sp = src_of(row + stride);
#pragma unroll
      for (int c = 0; c < 4; ++c) nx[c] = *(const f32x4*)(sp + c * 256 + lane * 4); }
    float s = 0.f;
#pragma unroll
    for (int j = 0; j < 16; ++j) s += v[j];
    const float mu = wave_sum(s) * (1.f / DM);
    float s2 = 0.f;
#pragma unroll
    for (int j = 0; j < 16; ++j) { float d = v[j] - mu; s2 += d * d; }
    const float rstd = rsqrtf(wave_sum(s2) * (1.f / DM) + EPS);
#pragma unroll
    for (int c = 0; c < 4; ++c) {
      const f32x4 g = *(const f32x4*)(p.ln_in_g + c * 256 + lane * 4), bb = *(const f32x4*)(p.ln_in_b + c * 256 + lane * 4);
      float o[4];
#pragma unroll
      for (int j = 0; j < 4; ++j) o[j] = (v[c * 4 + j] - mu) * rstd * g[j] + bb[j];
      *(u32x2*)(dst + c * 256 + lane * 4) = (u32x2){pk_bf16(o[0], o[1]), pk_bf16(o[2], o[3])};
    }
  }
}

__device__ __forceinline__ u32x4 pack8(const float (&v)[8]) {
  u32x4 w;
  w[0] = pk_bf16(v[0], v[1]); w[1] = pk_bf16(v[2], v[3]); w[2] = pk_bf16(v[4], v[5]); w[3] = pk_bf16(v[6], v[7]);
  return w;
}
__device__ __forceinline__ unsigned fkey(float f) {
  unsigned u = __float_as_uint(f);
  return u ^ (((unsigned)((int)u >> 31)) | 0x80000000u);
}
__device__ __forceinline__ float keyf(unsigned k) {
  unsigned u = (k & 0x80000000u) ? (k ^ 0x80000000u) : ~k;
  return __uint_as_float(u);
}
__device__ __forceinline__ void sort16_desc(unsigned (&v)[16]) {
  { unsigned _h = max(v[0], v[13]); v[13] = min(v[0], v[13]); v[0] = _h; }
  { unsigned _h = max(v[1], v[12]); v[12] = min(v[1], v[12]); v[1] = _h; }
  { unsigned _h = max(v[2], v[15]); v[15] = min(v[2], v[15]); v[2] = _h; }
  { unsigned _h = max(v[3], v[14]); v[14] = min(v[3], v[14]); v[3] = _h; }
  { unsigned _h = max(v[4], v[8]); v[8] = min(v[4], v[8]); v[4] = _h; }
  { unsigned _h = max(v[5], v[6]); v[6] = min(v[5], v[6]); v[5] = _h; }
  { unsigned _h = max(v[7], v[11]); v[11] = min(v[7], v[11]); v[7] = _h; }
  { unsigned _h = max(v[9], v[10]); v[10] = min(v[9], v[10]); v[9] = _h; }
  { unsigned _h = max(v[0], v[5]); v[5] = min(v[0], v[5]); v[0] = _h; }
  { unsigned _h = max(v[1], v[7]); v[7] = min(v[1], v[7]); v[1] = _h; }
  { unsigned _h = max(v[2], v[9]); v[9] = min(v[2], v[9]); v[2] = _h; }
  { unsigned _h = max(v[3], v[4]); v[4] = min(v[3], v[4]); v[3] = _h; }
  { unsigned _h = max(v[6], v[13]); v[13] = min(v[6], v[13]); v[6] = _h; }
  { unsigned _h = max(v[8], v[14]); v[14] = min(v[8], v[14]); v[8] = _h; }
  { unsigned _h = max(v[10], v[15]); v[15] = min(v[10], v[15]); v[10] = _h; }
  { unsigned _h = max(v[11], v[12]); v[12] = min(v[11], v[12]); v[11] = _h; }
  { unsigned _h = max(v[0], v[1]); v[1] = min(v[0], v[1]); v[0] = _h; }
  { unsigned _h = max(v[2], v[3]); v[3] = min(v[2], v[3]); v[2] = _h; }
  { unsigned _h = max(v[4], v[5]); v[5] = min(v[4], v[5]); v[4] = _h; }
  { unsigned _h = max(v[6], v[8]); v[8] = min(v[6], v[8]); v[6] = _h; }
  { unsigned _h = max(v[7], v[9]); v[9] = min(v[7], v[9]); v[7] = _h; }
  { unsigned _h = max(v[10], v[11]); v[11] = min(v[10], v[11]); v[10] = _h; }
  { unsigned _h = max(v[12], v[13]); v[13] = min(v[12], v[13]); v[12] = _h; }
  { unsigned _h = max(v[14], v[15]); v[15] = min(v[14], v[15]); v[14] = _h; }
  { unsigned _h = max(v[0], v[2]); v[2] = min(v[0], v[2]); v[0] = _h; }
  { unsigned _h = max(v[1], v[3]); v[3] = min(v[1], v[3]); v[1] = _h; }
  { unsigned _h = max(v[4], v[10]); v[10] = min(v[4], v[10]); v[4] = _h; }
  { unsigned _h = max(v[5], v[11]); v[11] = min(v[5], v[11]); v[5] = _h; }
  { unsigned _h = max(v[6], v[7]); v[7] = min(v[6], v[7]); v[6] = _h; }
  { unsigned _h = max(v[8], v[9]); v[9] = min(v[8], v[9]); v[8] = _h; }
  { unsigned _h = max(v[12], v[14]); v[14] = min(v[12], v[14]); v[12] = _h; }
  { unsigned _h = max(v[13], v[15]); v[15] = min(v[13], v[15]); v[13] = _h; }
  { unsigned _h = max(v[1], v[2]); v[2] = min(v[1], v[2]); v[1] = _h; }
  { unsigned _h = max(v[3], v[12]); v[12] = min(v[3], v[12]); v[3] = _h; }
  { unsigned _h = max(v[4], v[6]); v[6] = min(v[4], v[6]); v[4] = _h; }
  { unsigned _h = max(v[5], v[7]); v[7] = min(v[5], v[7]); v[5] = _h; }
  { unsigned _h = max(v[8], v[10]); v[10] = min(v[8], v[10]); v[8] = _h; }
  { unsigned _h = max(v[9], v[11]); v[11] = min(v[9], v[11]); v[9] = _h; }
  { unsigned _h = max(v[13], v[14]); v[14] = min(v[13], v[14]); v[13] = _h; }
  { unsigned _h = max(v[1], v[4]); v[4] = min(v[1], v[4]); v[1] = _h; }
  { unsigned _h = max(v[2], v[6]); v[6] = min(v[2], v[6]); v[2] = _h; }
  { unsigned _h = max(v[5], v[8]); v[8] = min(v[5], v[8]); v[5] = _h; }
  { unsigned _h = max(v[7], v[10]); v[10] = min(v[7], v[10]); v[7] = _h; }
  { unsigned _h = max(v[9], v[13]); v[13] = min(v[9], v[13]); v[9] = _h; }
  { unsigned _h = max(v[11], v[14]); v[14] = min(v[11], v[14]); v[11] = _h; }
  { unsigned _h = max(v[2], v[4]); v[4] = min(v[2], v[4]); v[2] = _h; }
  { unsigned _h = max(v[3], v[6]); v[6] = min(v[3], v[6]); v[3] = _h; }
  { unsigned _h = max(v[9], v[12]); v[12] = min(v[9], v[12]); v[9] = _h; }
  { unsigned _h = max(v[11], v[13]); v[13] = min(v[11], v[13]); v[11] = _h; }
  { unsigned _h = max(v[3], v[5]); v[5] = min(v[3], v[5]); v[3] = _h; }
  { unsigned _h = max(v[6], v[8]); v[8] = min(v[6], v[8]); v[6] = _h; }
  { unsigned _h = max(v[7], v[9]); v[9] = min(v[7], v[9]); v[7] = _h; }
  { unsigned _h = max(v[10], v[12]); v[12] = min(v[10], v[12]); v[10] = _h; }
  { unsigned _h = max(v[3], v[4]); v[4] = min(v[3], v[4]); v[3] = _h; }
  { unsigned _h = max(v[5], v[6]); v[6] = min(v[5], v[6]); v[5] = _h; }
  { unsigned _h = max(v[7], v[8]); v[8] = min(v[7], v[8]); v[7] = _h; }
  { unsigned _h = max(v[9], v[10]); v[10] = min(v[9], v[10]); v[9] = _h; }
  { unsigned _h = max(v[11], v[12]); v[12] = min(v[11], v[12]); v[11] = _h; }
  { unsigned _h = max(v[6], v[7]); v[7] = min(v[6], v[7]); v[6] = _h; }
  { unsigned _h = max(v[8], v[9]); v[9] = min(v[8], v[9]); v[8] = _h; }
}
__device__ __forceinline__ void merge16_desc(unsigned (&v)[16], const unsigned (&o)[16]) {
  v[0] = max(v[0], o[15]);
  v[1] = max(v[1], o[14]);
  v[2] = max(v[2], o[13]);
  v[3] = max(v[3], o[12]);
  v[4] = max(v[4], o[11]);
  v[5] = max(v[5], o[10]);
  v[6] = max(v[6], o[9]);
  v[7] = max(v[7], o[8]);
  v[8] = max(v[8], o[7]);
  v[9] = max(v[9], o[6]);
  v[10] = max(v[10], o[5]);
  v[11] = max(v[11], o[4]);
  v[12] = max(v[12], o[3]);
  v[13] = max(v[13], o[2]);
  v[14] = max(v[14], o[1]);
  v[15] = max(v[15], o[0]);
  { unsigned _h = max(v[0], v[8]); v[8] = min(v[0], v[8]); v[0] = _h; }
  { unsigned _h = max(v[1], v[9]); v[9] = min(v[1], v[9]); v[1] = _h; }
  { unsigned _h = max(v[2], v[10]); v[10] = min(v[2], v[10]); v[2] = _h; }
  { unsigned _h = max(v[3], v[11]); v[11] = min(v[3], v[11]); v[3] = _h; }
  { unsigned _h = max(v[4], v[12]); v[12] = min(v[4], v[12]); v[4] = _h; }
  { unsigned _h = max(v[5], v[13]); v[13] = min(v[5], v[13]); v[5] = _h; }
  { unsigned _h = max(v[6], v[14]); v[14] = min(v[6], v[14]); v[6] = _h; }
  { unsigned _h = max(v[7], v[15]); v[15] = min(v[7], v[15]); v[7] = _h; }
  { unsigned _h = max(v[0], v[4]); v[4] = min(v[0], v[4]); v[0] = _h; }
  { unsigned _h = max(v[1], v[5]); v[5] = min(v[1], v[5]); v[1] = _h; }
  { unsigned _h = max(v[2], v[6]); v[6] = min(v[2], v[6]); v[2] = _h; }
  { unsigned _h = max(v[3], v[7]); v[7] = min(v[3], v[7]); v[3] = _h; }
  { unsigned _h = max(v[8], v[12]); v[12] = min(v[8], v[12]); v[8] = _h; }
  { unsigned _h = max(v[9], v[13]); v[13] = min(v[9], v[13]); v[9] = _h; }
  { unsigned _h = max(v[10], v[14]); v[14] = min(v[10], v[14]); v[10] = _h; }
  { unsigned _h = max(v[11], v[15]); v[15] = min(v[11], v[15]); v[11] = _h; }
  { unsigned _h = max(v[0], v[2]); v[2] = min(v[0], v[2]); v[0] = _h; }
  { unsigned _h = max(v[1], v[3]); v[3] = min(v[1], v[3]); v[1] = _h; }
  { unsigned _h = max(v[4], v[6]); v[6] = min(v[4], v[6]); v[4] = _h; }
  { unsigned _h = max(v[5], v[7]); v[7] = min(v[5], v[7]); v[5] = _h; }
  { unsigned _h = max(v[8], v[10]); v[10] = min(v[8], v[10]); v[8] = _h; }
  { unsigned _h = max(v[9], v[11]); v[11] = min(v[9], v[11]); v[9] = _h; }
  { unsigned _h = max(v[12], v[14]); v[14] = min(v[12], v[14]); v[12] = _h; }
  { unsigned _h = max(v[13], v[15]); v[15] = min(v[13], v[15]); v[13] = _h; }
  { unsigned _h = max(v[0], v[1]); v[1] = min(v[0], v[1]); v[0] = _h; }
  { unsigned _h = max(v[2], v[3]); v[3] = min(v[2], v[3]); v[2] = _h; }
  { unsigned _h = max(v[4], v[5]); v[5] = min(v[4], v[5]); v[4] = _h; }
  { unsigned _h = max(v[6], v[7]); v[7] = min(v[6], v[7]); v[6] = _h; }
  { unsigned _h = max(v[8], v[9]); v[9] = min(v[8], v[9]); v[8] = _h; }
  { unsigned _h = max(v[10], v[11]); v[11] = min(v[10], v[11]); v[10] = _h; }
  { unsigned _h = max(v[12], v[13]); v[13] = min(v[12], v[13]); v[12] = _h; }
  { unsigned _h = max(v[14], v[15]); v[15] = min(v[14], v[15]); v[14] = _h; }
}
#define TOPK_INSERT_FROM(V, X, J0) { _Pragma("unroll") for (int _j = (J0); _j < 16; ++_j) { unsigned _hi = max(V[_j], X); X = min(V[_j], X); V[_j] = _hi; } }
#define TOPK_INSERT(V, X) { _Pragma("unroll") for (int _j = 0; _j < 16; ++_j) { unsigned _hi = max(V[_j], X); X = min(V[_j], X); V[_j] = _hi; } }

namespace pg8 {
constexpr int BM = 256, BK = 64, HALF = 128, HTB = HALF * BK * 2, STAGE_BYTES = 8 * HTB, NXCD = 8, WGM = 8;
__device__ __forceinline__ int lds_byte(int r, int c) { const int st = (r >> 4) * 2 + (c >> 5), rr = r & 15, cc = c & 31, ob = rr * 64 + cc * 2; return st * 1024 + (ob ^ (((ob >> 9) & 1) << 5)); }
__device__ __forceinline__ void stage_rc(int b, int& R, int& C) { const int st = b / 1024, sb = b % 1024, swz = sb ^ (((sb >> 9) & 1) << 5); R = (st >> 1) * 16 + swz / 64; C = (st & 1) * 32 + (swz % 64) / 2; }
__device__ __forceinline__ int perm32(int rho) { const int n = rho >> 4, i = rho & 15; return 8 * (i >> 2) + 4 * n + (i & 3); }
struct Unit { int pm, pn; };
struct Gemm { const bf16_t* A; const bf16_t* Bt; int M, N, K; };
struct StaticOrder {
  int nM, nN, nwg, G, c;
  __device__ void init(int M, int N, int G_, int c_) { nM = M / BM; nN = N / BM; nwg = nM * nN; G = G_; c = c_; }
  __device__ bool next(int i, Unit& u) const {
    const long L = (long)i * G + c; if (L >= nwg) return false;
    int wgid = (int)L; { const int q = nwg / NXCD, r = nwg % NXCD, xcd = wgid % NXCD, off = wgid / NXCD; wgid = (xcd < r ? xcd * (q + 1) : r * (q + 1) + (xcd - r) * q) + off; }
    const int nig = WGM * nN, gid = wgid / nig, fm = gid * WGM, gsz = (nM - fm) < WGM ? (nM - fm) : WGM;
    u.pm = fm + ((wgid % nig) % gsz); u.pn = (wgid % nig) / gsz; return true;
  }
  __device__ __forceinline__ void a_ready(const Unit&) const {}
  __device__ __forceinline__ void done(const Unit&) const {}
};
template <class Epi, class Sched>
__device__ __forceinline__ void gemm_phase(LAS unsigned char* lds, const Gemm g, const Sched& S, const Epi& E) {
  const int tid = phase_tid(), wid = __builtin_amdgcn_readfirstlane(tid >> 6), lane = tid & 63, wr = wid >> 2, wc = wid & 3, fr = lane & 15, fq = lane >> 4;
  const int K = g.K, nt = K / BK;
  unsigned voffA[2], voffB[2];
#pragma unroll
  for (int i = 0; i < 2; ++i) { int R, C; stage_rc(tid * 16 + i * 8192, R, C); const int Rb = Epi::PERM ? ((R & ~31) + perm32(R & 31)) : R;
    voffA[i] = (unsigned)(R * K + C) * 2u; voffB[i] = (unsigned)(Rb * K + C) * 2u; }
  const size_t kstep = (size_t)(BK * 2);
  const size_t hstep = (size_t)HALF * K * 2;
  const size_t tstep = 2 * hstep;
  const unsigned ldsw = (unsigned)wid * 1024u;
  const int aoff = lds_byte(wr * 64 + fr, fq * 8), boff = lds_byte(wc * 32 + fr, fq * 8);
#define PG8_SA(b, h) (((b) * 2 + (h)) * HTB)
#define PG8_SB(b, h) ((4 + (b) * 2 + (h)) * HTB)
#define PG8_STAGE(bufoff, gbase, voff) do { _Pragma("unroll") for (int _i = 0; _i < 2; ++_i) \
    __builtin_amdgcn_global_load_lds((const unsigned*)((const char*)(gbase) + (voff)[_i]), (LAS unsigned*)(lds + (bufoff) + ldsw + _i * 8192), 16, 0, 0); } while (0)
#define PG8_LDA(dst, b, h) do { _Pragma("unroll") for (int m = 0; m < 4; ++m) _Pragma("unroll") for (int k = 0; k < 2; ++k) dst[m][k] = *(const LAS bf16x8*)(lds + PG8_SA(b, h) + aoff + m * 2048 + k * 1024); } while (0)
#define PG8_LDB(dst, b, h) do { _Pragma("unroll") for (int n = 0; n < 2; ++n) _Pragma("unroll") for (int k = 0; k < 2; ++k) dst[n][k] = *(const LAS bf16x8*)(lds + PG8_SB(b, h) + boff + n * 2048 + k * 1024); } while (0)
#define PG8_MMA(ai, bj, At, Bt) do { __builtin_amdgcn_s_setprio(1); _Pragma("unroll") for (int m = 0; m < 4; ++m) _Pragma("unroll") for (int n = 0; n < 2; ++n) _Pragma("unroll") for (int k = 0; k < 2; ++k) \
    acc[ai][bj][m][n] = __builtin_amdgcn_mfma_f32_16x16x32_bf16(Bt[n][k], At[m][k], acc[ai][bj][m][n], 0, 0, 0); __builtin_amdgcn_s_setprio(0); } while (0)
#define PG8_WAIT_V(n) asm volatile("s_waitcnt vmcnt(" #n ")" ::: "memory")
#define PG8_WAIT_L(n) asm volatile("s_waitcnt lgkmcnt(" #n ")" ::: "memory")
#define PG8_BAR __builtin_amdgcn_s_barrier()
#define PG8_SCHED __builtin_amdgcn_sched_barrier(0)
  Unit cur, nxt; int ui = 0;
  if (!S.next(0, cur)) return;
  f32x4 acc[2][2][4][2];
#pragma unroll
  for (int a = 0; a < 2; ++a)
#pragma unroll
    for (int b = 0; b < 2; ++b)
#pragma unroll
      for (int m = 0; m < 4; ++m)
#pragma unroll
        for (int n = 0; n < 2; ++n) acc[a][b][m][n] = (f32x4){0.f, 0.f, 0.f, 0.f};
  bf16x8 At[4][2], B0[2][2], B1[2][2];
  const char* cA = (const char*)g.A + (size_t)cur.pm * tstep; const char* cB = (const char*)g.Bt + (size_t)cur.pn * tstep;
  S.a_ready(cur);
  PG8_STAGE(PG8_SB(0, 0), cB, voffB); PG8_STAGE(PG8_SA(0, 0), cA, voffA); PG8_STAGE(PG8_SB(0, 1), cB + hstep, voffB); PG8_STAGE(PG8_SA(0, 1), cA + hstep, voffA);
  if (wr == 1) PG8_BAR;
  PG8_WAIT_V(4); PG8_BAR;
  PG8_STAGE(PG8_SB(1, 0), cB + kstep, voffB); PG8_STAGE(PG8_SA(1, 0), cA + kstep, voffA); PG8_STAGE(PG8_SB(1, 1), cB + hstep + kstep, voffB);
  PG8_WAIT_V(6); PG8_BAR;
  for (;;) {
    const bool has_next = S.next(ui + 1, nxt);
    const char* nA = has_next ? (const char*)g.A + (size_t)nxt.pm * tstep : cA; const char* nB = has_next ? (const char*)g.Bt + (size_t)nxt.pn * tstep : cB;
    for (int t = 0; t < nt; t += 2) {
      const bool last = (t == nt - 2);
      const char* a1 = cA + (size_t)(t + 1) * kstep;
      const char* a2 = last ? nA : cA + (size_t)(t + 2) * kstep; const char* b2 = last ? nB : cB + (size_t)(t + 2) * kstep;
      const char* a3 = a2 + kstep; const char* b3 = b2 + kstep;
      if (last && has_next) S.a_ready(nxt);
      PG8_LDB(B0, 0, 0); PG8_SCHED; PG8_LDA(At, 0, 0); PG8_STAGE(PG8_SA(1, 1), a1 + hstep, voffA);
      PG8_WAIT_L(8); PG8_BAR; PG8_WAIT_L(0); PG8_MMA(0, 0, At, B0); PG8_BAR; PG8_SCHED;
      PG8_LDB(B1, 0, 1); PG8_STAGE(PG8_SB(0, 0), b2, voffB);
      PG8_BAR; PG8_WAIT_L(0); PG8_MMA(0, 1, At, B1); PG8_BAR;
      PG8_LDA(At, 0, 1); PG8_STAGE(PG8_SA(0, 0), a2, voffA);
      PG8_BAR; PG8_WAIT_L(0); PG8_MMA(1, 0, At, B0); PG8_BAR; PG8_SCHED;
      PG8_STAGE(PG8_SB(0, 1), b2 + hstep, voffB);
      PG8_WAIT_V(6); PG8_BAR; PG8_MMA(1, 1, At, B1); PG8_BAR;
      PG8_LDB(B0, 1, 0); PG8_SCHED; PG8_LDA(At, 1, 0); PG8_STAGE(PG8_SA(0, 1), a2 + hstep, voffA);
      PG8_WAIT_L(8); PG8_BAR; PG8_WAIT_L(0); PG8_MMA(0, 0, At, B0); PG8_BAR; PG8_SCHED;
      PG8_LDB(B1, 1, 1); PG8_STAGE(PG8_SB(1, 0), b3, voffB);
      PG8_BAR; PG8_WAIT_L(0); PG8_MMA(0, 1, At, B1); PG8_BAR;
      PG8_LDA(At, 1, 1); PG8_STAGE(PG8_SA(1, 0), a3, voffA);
      PG8_BAR; PG8_WAIT_L(0); PG8_MMA(1, 0, At, B0); PG8_BAR; PG8_SCHED;
      PG8_STAGE(PG8_SB(1, 1), b3 + hstep, voffB);
      PG8_WAIT_V(6); PG8_BAR; PG8_MMA(1, 1, At, B1); PG8_BAR;
    }
    if constexpr (!Epi::AFTER_DRAIN) { E(acc, cur, wr, wc, fr, fq, lds); S.done(cur); }
    if (!has_next) break;
#pragma unroll
    for (int a = 0; a < 2; ++a)
#pragma unroll
      for (int b = 0; b < 2; ++b)
#pragma unroll
        for (int m = 0; m < 4; ++m)
#pragma unroll
          for (int n = 0; n < 2; ++n) acc[a][b][m][n] = (f32x4){0.f, 0.f, 0.f, 0.f};
    cur = nxt; cA = nA; cB = nB; ++ui;
  }
  PG8_WAIT_V(0);
  if (wr == 0) PG8_BAR;
  PG8_BAR;
  if constexpr (Epi::AFTER_DRAIN) { E.fused(acc, cur, wr, wc, fr, fq, (char*)lds); S.done(cur); }
#undef PG8_SA
#undef PG8_SB
#undef PG8_STAGE
#undef PG8_LDA
#undef PG8_LDB
#undef PG8_MMA
#undef PG8_WAIT_V
#undef PG8_WAIT_L
#undef PG8_BAR
#undef PG8_SCHED
}
struct EpiBf16S {
  static constexpr bool PERM = true, AFTER_DRAIN = false;
  bf16_t* d0; int ld0; int c0; bf16_t* d1; int ld1; int c1; bf16_t* d2; int ld2;
  __device__ __forceinline__ void operator()(const f32x4 (&acc)[2][2][4][2], const Unit& u, int wr, int wc, int fr, int fq, LAS unsigned char* lds) const {
    const int colt = u.pn * BM;
    bf16_t* base; int ld;
    if (colt < c0) { base = d0 + colt; ld = ld0; } else if (colt < c1) { base = d1 + (colt - c0); ld = ld1; } else { base = d2 + (colt - c1); ld = ld2; }
    const int L = fq * 16 + fr;
    LAS unsigned char* xp = lds + 131072 + (wr * 4 + wc) * 1280;
    LAS unsigned char* xw = xp + fr * 80 + fq * 16;
    const LAS unsigned char* xr = xp + (L >> 2) * 80 + (L & 3) * 16;
    const int row0 = u.pm * BM + wr * 64 + (L >> 2), col0 = wc * 32 + 8 * (L & 3);
#pragma unroll
    for (int ai = 0; ai < 2; ++ai)
#pragma unroll
      for (int m = 0; m < 4; ++m) {
        bf16_t* rowp = base + (size_t)(row0 + ai * HALF + m * 16) * ld + col0;
#pragma unroll
        for (int bj = 0; bj < 2; ++bj) {
          const f32x4 v0 = acc[ai][bj][m][0], v1 = acc[ai][bj][m][1];
          u32x4 w; w[0] = pk_bf16(v0[0], v0[1]); w[1] = pk_bf16(v0[2], v0[3]); w[2] = pk_bf16(v1[0], v1[1]); w[3] = pk_bf16(v1[2], v1[3]);
          *(LAS u32x4*)xw = w;
          const u32x4 x = *(const LAS u32x4*)xr;
          *(u32x4*)(rowp + bj * HALF) = x;
        }
      }
  }
};
struct EpiOutRes {
  static constexpr bool PERM = true, AFTER_DRAIN = false;
  bf16_t* pre; const bf16_t* h0;
  __device__ __forceinline__ void operator()(const f32x4 (&acc)[2][2][4][2], const Unit& u, int wr, int wc, int fr, int fq, LAS unsigned char* lds) const {
    const int row0 = u.pm * BM + wr * 64 + fr, col0 = u.pn * BM + wc * 32 + 8 * fq;
#pragma unroll
    for (int ai = 0; ai < 2; ++ai)
#pragma unroll
      for (int m = 0; m < 4; ++m) {
        const size_t off = (size_t)(row0 + ai * HALF + m * 16) * 1024 + col0;
#pragma unroll
        for (int bj = 0; bj < 2; ++bj) {
          const size_t o = off + bj * HALF;
          const u32x4 h = *(const u32x4*)(h0 + o);
          const f32x4 v0 = acc[ai][bj][m][0], v1 = acc[ai][bj][m][1];
          u32x4 w;
          w[0] = pk_bf16(v0[0] + ALPHA * bflo(h[0]), v0[1] + ALPHA * bfhi(h[0]));
          w[1] = pk_bf16(v0[2] + ALPHA * bflo(h[1]), v0[3] + ALPHA * bfhi(h[1]));
          w[2] = pk_bf16(v1[0] + ALPHA * bflo(h[2]), v1[1] + ALPHA * bfhi(h[2]));
          w[3] = pk_bf16(v1[2] + ALPHA * bflo(h[3]), v1[3] + ALPHA * bfhi(h[3]));
          *(u32x4*)(pre + o) = w;
        }
      }
  }
};
struct OneUnit {
  Unit u;
  __device__ bool next(int i, Unit& o) const { if (i) return false; o = u; return true; }
  __device__ __forceinline__ void a_ready(const Unit&) const {}
  __device__ __forceinline__ void done(const Unit&) const {}
};
struct EpiPeerScore {
  static constexpr bool PERM = false, AFTER_DRAIN = true;
  unsigned short* experts; float* gates;
  static constexpr int LDC = 260;
  __device__ void fused(const f32x4 (&acc)[2][2][4][2], const Unit& u, int wr, int wc, int fr, int fq, char* smem) const {
    float* Ct = (float*)smem;
    unsigned char* ibase = (unsigned char*)smem + 128 * LDC * 4;
    const int tid = phase_tid();
    const int row = tid >> 2, j = (tid >> 1) & 1, half = tid & 1;
#pragma unroll
    for (int ai = 0; ai < 2; ++ai) {
#pragma unroll
      for (int bj = 0; bj < 2; ++bj)
#pragma unroll
        for (int m = 0; m < 4; ++m)
#pragma unroll
          for (int n = 0; n < 2; ++n)
            *(f32x4*)(Ct + (wr * 64 + m * 16 + fr) * LDC + bj * 128 + wc * 32 + n * 16 + 4 * fq) = acc[ai][bj][m][n];
      lds_barrier();
      unsigned v[16];
      const float* rowp = Ct + row * LDC + j * 128 + half * 64;
#pragma unroll
      for (int grp = 0; grp < 4; ++grp) {
        unsigned o[16];
#pragma unroll
        for (int c4 = 0; c4 < 4; ++c4) {
          f32x4 sv = *(const f32x4*)(rowp + grp * 16 + c4 * 4);
#pragma unroll
          for (int k = 0; k < 4; ++k) o[c4 * 4 + k] = (fkey(sv[k]) & ~127u) | (unsigned)(127 - (half * 64 + grp * 16 + c4 * 4 + k));
        }
        sort16_desc(o);
        if (grp == 0) {
#pragma unroll
          for (int k = 0; k < 16; ++k) v[k] = o[k];
        } else merge16_desc(v, o);
      }
      {
        unsigned o[16];
#pragma unroll
        for (int k = 0; k < 16; ++k) o[k] = lane_xor1(v[k]);
        merge16_desc(v, o);
      }
      unsigned w[16];
#pragma unroll
      for (int k = 0; k < 16; ++k) w[k] = lane_xor2(v[k]);
      unsigned char* ib = ibase + row * 32;
      if ((tid & 3) == 0) {
#pragma unroll
        for (int q4 = 0; q4 < 4; ++q4) {
          unsigned x0 = 0u, x1 = 0u;
#pragma unroll
          for (int k = 0; k < 4; ++k) { x0 |= (127u - (v[q4 * 4 + k] & 127u)) << (8 * k); x1 |= (127u - (w[q4 * 4 + k] & 127u)) << (8 * k); }
          ((unsigned*)ib)[q4] = x0; ((unsigned*)ib)[4 + q4] = x1;
        }
      }
      float f1[16], f2[16];
#pragma unroll
      for (int k = 0; k < 16; ++k) { f1[k] = keyf(v[k] & ~127u); f2[k] = keyf(w[k] & ~127u); }
      unsigned c[16];
      {
        const int qd_ = tid & 3;
        const bool q1 = qd_ == 1, q2 = qd_ == 2, q3 = qd_ == 3;
        { const float xa = (q3 ? f1[3] : (q2 ? f1[2] : f1[0])), xb = (q3 ? f2[0] : (q2 ? f2[0] : (q1 ? f2[1] : f2[0]))); const unsigned tg = (q3 ? 252u : (q2 ? 253u : (q1 ? 254u : 255u))); c[0] = (fkey(xa + xb) & ~255u) | tg; }
        { const float xa = (q3 ? f1[7] : (q2 ? f1[6] : f1[0])), xb = (q3 ? f2[0] : (q2 ? f2[0] : (q1 ? f2[5] : f2[4]))); const unsigned tg = (q3 ? 248u : (q2 ? 249u : (q1 ? 250u : 251u))); c[1] = (fkey(xa + xb) & ~255u) | tg; }
        { const float xa = (q3 ? f1[11] : (q2 ? f1[10] : f1[0])), xb = (q3 ? f2[0] : (q2 ? f2[0] : (q1 ? f2[9] : f2[8]))); const unsigned tg = (q3 ? 244u : (q2 ? 245u : (q1 ? 246u : 247u))); c[2] = (fkey(xa + xb) & ~255u) | tg; }
        { const float xa = (q3 ? f1[15] : (q2 ? f1[14] : f1[0])), xb = (q3 ? f2[0] : (q2 ? f2[0] : (q1 ? f2[13] : f2[12]))); const unsigned tg = (q3 ? 240u : (q2 ? 241u : (q1 ? 242u : 243u))); c[3] = (fkey(xa + xb) & ~255u) | tg; }
        { const float xa = (q3 ? f1[3] : (q2 ? f1[2] : f1[1])), xb = (q3 ? f2[1] : (q2 ? f2[1] : (q1 ? f2[1] : f2[0]))); const unsigned tg = (q3 ? 236u : (q2 ? 237u : (q1 ? 238u : 239u))); c[4] = (fkey(xa + xb) & ~255u) | tg; }
        { const float xa = (q3 ? f1[7] : (q2 ? f1[6] : f1[1])), xb = (q3 ? f2[1] : (q2 ? f2[1] : (q1 ? f2[5] : f2[4]))); const unsigned tg = (q3 ? 232u : (q2 ? 233u : (q1 ? 234u : 235u))); c[5] = (fkey(xa + xb) & ~255u) | tg; }
        { const float xa = (q3 ? f1[3] : f1[2]), xb = (q3 ? f2[2] : (q2 ? f2[2] : (q1 ? f2[1] : f2[0]))); const unsigned tg = (q3 ? 220u : (q2 ? 221u : (q1 ? 222u : 223u))); c[6] = (fkey(xa + xb) & ~255u) | tg; }
        { const float xa = (q3 ? f1[2] : (q2 ? f1[1] : (q1 ? f1[3] : f1[2]))), xb = (q3 ? f2[3] : (q2 ? f2[3] : (q1 ? f2[0] : f2[4]))); const unsigned tg = (q3 ? 205u : (q2 ? 206u : (q1 ? 207u : 219u))); c[7] = (fkey(xa + xb) & ~255u) | tg; }
        { const float xa = (q3 ? f1[2] : (q2 ? f1[1] : (q1 ? f1[4] : f1[3]))), xb = (q3 ? f2[4] : (q2 ? f2[4] : (q1 ? f2[0] : f2[3]))); const unsigned tg = (q3 ? 189u : (q2 ? 190u : (q1 ? 191u : 204u))); c[8] = (fkey(xa + xb) & ~255u) | tg; }
        { const float xa = (q3 ? f1[1] : (q2 ? f1[0] : f1[5])), xb = (q3 ? f2[6] : (q2 ? f2[6] : (q1 ? f2[1] : f2[0]))); const unsigned tg = (q3 ? 158u : (q2 ? 159u : (q1 ? 174u : 175u))); c[9] = (fkey(xa + xb) & ~255u) | tg; }
        { const float xa = (q3 ? f1[0] : (q2 ? f1[0] : f1[7])), xb = (q3 ? f2[9] : (q2 ? f2[8] : (q1 ? f2[1] : f2[0]))); const unsigned tg = (q3 ? 111u : (q2 ? 127u : (q1 ? 142u : 143u))); c[10] = (fkey(xa + xb) & ~255u) | tg; }
        { const float xa = (q3 ? f1[0] : (q2 ? f1[0] : (q1 ? f1[11] : f1[10]))), xb = (q3 ? f2[13] : (q2 ? f2[12] : f2[0])); const unsigned tg = (q3 ? 47u : (q2 ? 63u : (q1 ? 79u : 95u))); c[11] = (fkey(xa + xb) & ~255u) | tg; }
        { const float xa = (q3 ? -3.0e38f : (q2 ? -3.0e38f : (q1 ? f1[15] : f1[14]))), xb = (q3 ? 0.f : (q2 ? 0.f : f2[0])); const unsigned tg = (q3 ? 0u : (q2 ? 0u : (q1 ? 15u : 31u))); c[12] = (fkey(xa + xb) & ~255u) | tg; }
        c[13] = 0u; c[14] = 0u; c[15] = 0u;
        sort16_desc(c);
        unsigned o[16];
#pragma unroll
        for (int k = 0; k < 16; ++k) o[k] = lane_xor1(c[k]);
        merge16_desc(c, o);
#pragma unroll
        for (int k = 0; k < 16; ++k) o[k] = lane_xor2(c[k]);
        merge16_desc(c, o);
      }
      const float mx = keyf(c[0] & ~255u);
      const int qd = tid & 3;
      unsigned mykey[4]; float ev[4]; float part = 0.f;
#pragma unroll
      for (int k = 0; k < 4; ++k) {
        unsigned k0 = c[k], k1 = c[4 + k], k2 = c[8 + k], k3 = c[12 + k];
        asm volatile("" : "+v"(k0), "+v"(k1), "+v"(k2), "+v"(k3));
        mykey[k] = qd == 0 ? k0 : qd == 1 ? k1 : qd == 2 ? k2 : k3;
        ev[k] = __expf(keyf(mykey[k] & ~255u) - mx); part += ev[k];
      }
      float sum = part + dpp_f<0xB1>(part); sum += dpp_f<0x4E>(sum);
      const float inv = 1.f / sum;
      asm volatile("s_waitcnt lgkmcnt(0)" ::: "memory");
      const size_t idx = ((size_t)(u.pm * BM + ai * HALF + row) * 8 + u.pn) * 16 + qd * 4;
      unsigned ew[2]; float gt[4];
#pragma unroll
      for (int k = 0; k < 4; ++k) {
        const unsigned ab = 255u - (mykey[k] & 255u);
        const unsigned ex = (unsigned)ib[ab >> 4] * 128u + (unsigned)ib[16 + (ab & 15)];
        if (k & 1) ew[k >> 1] |= ex << 16; else ew[k >> 1] = ex;
        gt[k] = ev[k] * inv;
      }
      *(u32x2*)(experts + idx) = (u32x2){ew[0], ew[1]};
      *(f32x4*)(gates + idx) = (f32x4){gt[0], gt[1], gt[2], gt[3]};
      lds_barrier();
    }
  }
};
template <class Epi>
__device__ __forceinline__ void run_drained(char* smem, const bf16_t* A, const bf16_t* Bt, int M, int N, int K, const Epi& E) {
  StaticOrder S; S.init(M, N, gridDim.x, blockIdx.x);
  for (int i = 0;; ++i) {
    Unit u; if (!S.next(i, u)) break;
    gemm_phase((LAS unsigned char*)smem, Gemm{A, Bt, M, N, K}, OneUnit{u}, E);
  }
}
template <class Epi>
__device__ __forceinline__ void run(char* smem, const bf16_t* A, const bf16_t* Bt, int M, int N, int K, const Epi& E, int rot = 0) {
  StaticOrder S; S.init(M, N, gridDim.x, (int)((blockIdx.x + gridDim.x - (unsigned)rot % gridDim.x) % gridDim.x));
  gemm_phase((LAS unsigned char*)smem, Gemm{A, Bt, M, N, K}, S, E);
}
}

__device__ void conv_phase(const Params& p, char* smem) {
  bf16_t* raw = (bf16_t*)smem;
  const int tid = phase_tid();
  u32x4 rr_[3];
  auto gload = [&](int item) {
    const int cb = item % 24, c = (item / 24) % NCH, seq = item / (24 * NCH);
#pragma unroll
    for (int j = 0; j < 3; ++j) {
      const int i = tid + j * NTHREADS;
      const int rr = i >> 3, k8 = i & 7;
      const int pos = c * 128 - 2 + rr - MPAD;
      u32x4 v = {0u, 0u, 0u, 0u};
      if (i < 132 * 8 && pos >= 0 && pos < LSEQ) v = *(const u32x4*)(p.xbc_raw + (size_t)row_of(seq, pos) * 1536 + cb * 64 + k8 * 8);
      rr_[j] = v;
    }
  };
  if ((int)blockIdx.x < NSEQ * NCH * 24) gload(blockIdx.x);
  for (int item = blockIdx.x; item < NSEQ * NCH * 24; item += gridDim.x) {
    const int cb = item % 24, c = (item / 24) % NCH, seq = item / (24 * NCH);
    __syncthreads();
#pragma unroll
    for (int j = 0; j < 3; ++j) {
      const int i = tid + j * NTHREADS;
      if (i < 132 * 8) *(u32x4*)(raw + (i >> 3) * 64 + (i & 7) * 8) = rr_[j];
    }
    __syncthreads();
    if (item + (int)gridDim.x < NSEQ * NCH * 24) gload(item + gridDim.x);
    const int ch = tid & 63, l0 = __builtin_amdgcn_readfirstlane(tid >> 6) * 16;
    const int gch = cb * 64 + ch;
    float w[5];
#pragma unroll
    for (int k = 0; k < 5; ++k) w[k] = p.conv_w[k * 1536 + gch];
    const float bias = p.conv_b[gch];
    float win[20];
#pragma unroll
    for (int i = 0; i < 20; ++i) win[i] = bf2f(raw[(l0 + i) * 64 + ch]);
    float o[16];
#pragma unroll
    for (int i = 0; i < 16; ++i) {
      float a = bias;
#pragma unroll
      for (int k = 0; k < 5; ++k) a += w[k] * win[i + k];
      int pos = c * 128 + l0 + i - MPAD;
      o[i] = (pos >= 0 && pos < LSEQ) ? silu_f(a) : 0.f;
    }
    u32x4 lo, hi;
    lo[0] = pk_bf16(o[0], o[1]); lo[1] = pk_bf16(o[2], o[3]); lo[2] = pk_bf16(o[4], o[5]); lo[3] = pk_bf16(o[6], o[7]);
    hi[0] = pk_bf16(o[8], o[9]); hi[1] = pk_bf16(o[10], o[11]); hi[2] = pk_bf16(o[12], o[13]); hi[3] = pk_bf16(o[14], o[15]);
    if (cb < 16) {
      bf16_t* d = p.XT + ((((size_t)seq * NCH + c) * 16 + cb) * 64 + ch) * 128 + l0;
      *(u32x4*)d = lo; *(u32x4*)(d + 8) = hi;
    } else if (cb < 20) {
      const int g = (cb - 16) >> 1, n = ((cb - 16) & 1) * 64 + ch;
      bf16_t* d = p.BmT + ((((size_t)seq * NCH + c) * 2 + g) * 128 + n) * 128 + l0;
      *(u32x4*)d = lo; *(u32x4*)(d + 8) = hi;
      bf16_t* d2 = p.Bm + ((size_t)seq * LP + c * 128 + l0) * 256 + g * 128 + n;
#pragma unroll
      for (int i = 0; i < 16; ++i) d2[(size_t)i * 256] = f2bf(o[i]);
    } else {
      const int g = (cb - 20) >> 1, n = ((cb - 20) & 1) * 64 + ch;
      bf16_t* d2 = p.Cm + ((size_t)seq * LP + c * 128 + l0) * 256 + g * 128 + n;
#pragma unroll
      for (int i = 0; i < 16; ++i) d2[(size_t)i * 256] = f2bf(o[i]);
    }
  }
}

__device__ void token_phase(const Params& p) {
  const int lane = phase_tid() & 63, wid = phase_tid() >> 6;
  const int stride = gridDim.x * 8;
  float gq[6], gk[4];
#pragma unroll
  for (int j = 0; j < 6; ++j) gq[j] = p.q_norm_g[lane * 6 + j];
#pragma unroll
  for (int j = 0; j < 4; ++j) gk[j] = p.kv_norm_g[lane * 4 + j];
  const float inv = exp2f(-(float)(lane & 15) * (13.287712379549449f / 16.f));
  struct In { unsigned a0, a1, a2; u32x2 a; bf16_t x1, x2; };
  auto load = [&](In& d, int row) {
    const bf16_t* src = p.rest + (size_t)row * 768;
    const unsigned* s = (const unsigned*)(src + 32) + lane * 3;
    d.a0 = s[0]; d.a1 = s[1]; d.a2 = s[2];
    d.a = *(const u32x2*)(src + 416 + lane * 4);
    d.x1 = src[672 + (lane & 15)]; d.x2 = src[688 + (lane & 15)];
  };
  int row = blockIdx.x * 8 + wid;
  In cur, nxt;
  if (row < TM) load(cur, row);
  for (; row < TP; row += stride) {
    if (row + stride < TM) load(nxt, row + stride);
    if (row >= TM) {
      unsigned* dq = (unsigned*)(p.cqn + (size_t)row * 384) + lane * 3;
      dq[0] = 0u; dq[1] = 0u; dq[2] = 0u;
      *(u32x2*)(p.ckvn + (size_t)row * 256 + lane * 4) = (u32x2){0u, 0u};
      continue;
    }
    {
      float v[6] = {bflo(cur.a0), bfhi(cur.a0), bflo(cur.a1), bfhi(cur.a1), bflo(cur.a2), bfhi(cur.a2)};
      float ss = 0.f;
#pragma unroll
      for (int j = 0; j < 6; ++j) ss += v[j] * v[j];
      const float r = rsqrtf(wave_sum(ss) * (1.f / 384.f) + EPS);
      unsigned* d = (unsigned*)(p.cqn + (size_t)row * 384) + lane * 3;
      d[0] = pk_bf16(v[0] * r * gq[0], v[1] * r * gq[1]);
      d[1] = pk_bf16(v[2] * r * gq[2], v[3] * r * gq[3]);
      d[2] = pk_bf16(v[4] * r * gq[4], v[5] * r * gq[5]);
    }
    {
      float v[4] = {bflo(cur.a[0]), bfhi(cur.a[0]), bflo(cur.a[1]), bfhi(cur.a[1])};
      float ss = v[0] * v[0] + v[1] * v[1] + v[2] * v[2] + v[3] * v[3];
      const float r = rsqrtf(wave_sum(ss) * (1.f / 256.f) + EPS);
      u32x2 w;
      w[0] = pk_bf16(v[0] * r * gk[0], v[1] * r * gk[1]); w[1] = pk_bf16(v[2] * r * gk[2], v[3] * r * gk[3]);
      *(u32x2*)(p.ckvn + (size_t)row * 256 + lane * 4) = w;
    }
    if (lane < 16) {
      const float pos = (float)(row < TX ? NMETA + (row & (SEQ - 1)) : row - TX);
      float sn, cs; fast_sincos(pos * inv, sn, cs);
      const float x1 = bf2f(cur.x1), x2 = bf2f(cur.x2);
      p.kr[(size_t)row * 32 + lane] = f2bf(x1 * cs - x2 * sn);
      p.kr[(size_t)row * 32 + 16 + lane] = f2bf(x1 * sn + x2 * cs);
    }
    cur = nxt;
  }
}

__device__ void dt_phase(const Params& p) {
  const int lane = phase_tid() & 63, wid = phase_tid() >> 6;
  for (int item = blockIdx.x * 8 + wid; item < NSEQ * 2 * NCH; item += gridDim.x * 8) {
    const int c = item % NCH, dir = (item / NCH) & 1, seq = item / (NCH * 2);
    u32x4 raw[2][2];
#pragma unroll
    for (int j = 0; j < 2; ++j) {
      const int pos = c * 128 + lane * 2 + j - MPAD;
      raw[j][0] = (u32x4){0u, 0u, 0u, 0u}; raw[j][1] = raw[j][0];
      if (pos >= 0) {
        const bf16_t* src = p.rest + (size_t)row_of(seq, pos) * 768 + dir * 16;
        raw[j][0] = *(const u32x4*)src; raw[j][1] = *(const u32x4*)(src + 8);
      }
    }
    const float* biasp = dir ? p.dt_bias_b : p.dt_bias_f;
    const float* alogp = dir ? p.a_log_b : p.a_log_f;
#pragma unroll
    for (int h = 0; h < 16; ++h) {
      const float bias = biasp[h];
      const float a = -__expf(alogp[h]);
      float dt[2], da[2];
#pragma unroll
      for (int j = 0; j < 2; ++j) {
        const int pos = c * 128 + lane * 2 + j - MPAD;
        const unsigned w = raw[j][h >> 3][(h >> 1) & 3];
        const float x = ((h & 1) ? bfhi(w) : bflo(w)) + bias;
        const float v = pos >= 0 ? (x > 20.f ? x : log1pf(__expf(x))) : 0.f;
        dt[j] = v; da[j] = v * a;
      }
      const float s2 = da[0] + da[1];
      float incl = s2;
#pragma unroll
      for (int o = 1; o < 64; o <<= 1) { float t = __shfl_up(incl, o); if (lane >= o) incl += t; }
      const float excl = incl - s2;
      const float tot = __builtin_bit_cast(float, __builtin_amdgcn_readlane(__builtin_bit_cast(int, incl), 63));
      const size_t base = ((size_t)(seq * 2 + dir) * 16 + h) * LP + c * 128 + lane * 2;
      float P0, P1;
      if (dir == 0) { P0 = excl + da[0]; P1 = incl; } else { P0 = -excl; P1 = -(excl + da[0]); }
      *(float2*)(p.dtv + base) = make_float2(dt[0], dt[1]);
      *(float2*)(p.Pv + base) = make_float2(P0, P1);
      if (lane == 0) p.Atot[((size_t)(seq * 2 + dir) * 16 + h) * NCH + c] = tot;
    }
  }
}

__device__ __forceinline__ void xcd_group_map(int b, int& gg, int& j) { const int r = b & 7, k = b >> 3; j = k & 7; gg = (k >> 3) * 8 + r; }
constexpr int KS_STRIDE = 208, VS_STRIDE = 136;
constexpr int ATT_STAGE = 64 * KS_STRIDE + 64 * VS_STRIDE;
static_assert(2 * ATT_STAGE <= 160 * 1024 - 64, "attn lds");
__device__ void attn_phase(const Params& p, char* smem) {
  const int tid = phase_tid(), lane = tid & 63, wid = tid >> 6;
  const int r32 = lane & 31, hh = lane >> 5;
  for (int item0 = blockIdx.x; item0 < NSEQ * 8 * 8; item0 += gridDim.x) {
    int item = item0;
    if (gridDim.x == 256) { int gg, j; xcd_group_map(blockIdx.x, gg, j); item = ((item0 >> 8) * 32 + gg) * 8 + j; }
    const int qb = item & 7, h = (item >> 3) & 7, seq = item >> 6;
    const float qscale = 0.10206207261596575f * 1.4426950408889634f;
    bf16x8 qf[6];
    {
      const int qi = qb * 256 + wid * 32 + r32;
      const bf16_t* qp = p.q + ((size_t)seq * SEQ + qi) * 768 + h * 96 + hh * 8;
      const float pos = (float)(NMETA + qi);
      u32x4 v[6];
#pragma unroll
      for (int i = 0; i < 6; ++i) v[i] = *(const u32x4*)(qp + i * 16);
#pragma unroll
      for (int i = 0; i < 4; ++i) {
        u32x4 w;
#pragma unroll
        for (int j = 0; j < 4; ++j) w[j] = pk_bf16(bflo(v[i][j]) * qscale, bfhi(v[i][j]) * qscale);
        qf[i] = as_bf16x8(w);
      }
      u32x4 w1, w2;
#pragma unroll
      for (int j = 0; j < 4; ++j) {
        float o1[2], o2[2];
#pragma unroll
        for (int e = 0; e < 2; ++e) {
          const int k = 8 * hh + 2 * j + e;
          const float x1 = e ? bfhi(v[4][j]) : bflo(v[4][j]), x2 = e ? bfhi(v[5][j]) : bflo(v[5][j]);
          const float inv = exp2f(-(float)k * (13.287712379549449f / 16.f));
          float sn, cs; fast_sincos(pos * inv, sn, cs);
          o1[e] = (x1 * cs - x2 * sn) * qscale; o2[e] = (x1 * sn + x2 * cs) * qscale;
        }
        w1[j] = pk_bf16(o1[0], o1[1]); w2[j] = pk_bf16(o2[0], o2[1]);
      }
      qf[4] = as_bf16x8(w1); qf[5] = as_bf16x8(w2);
    }
    f32x16 oacc[2], negm;
#pragma unroll
    for (int i = 0; i < 16; ++i) { oacc[0][i] = 0.f; oacc[1][i] = 0.f; negm[i] = 0.f; }
    float l_run = 0.f;

    u32x4 rk, rv; u32x2 rkr;
    const bf16_t* vTb = p.vT + (size_t)(h * 64) * TP;
    const int st_key = tid >> 3, st_ch = tid & 7;
    auto gload = [&](int kt) {
      const bool meta = kt >= 32;
      const int krow = meta ? TX + (st_key & 15) : seq * SEQ + kt * 64 + st_key;
      const int vcol = meta ? TX + (st_ch & 1) * 8 : seq * SEQ + kt * 64 + st_ch * 8;
      const u32x4 k_ = *(const u32x4*)(p.Kb + (size_t)krow * 512 + h * 64 + st_ch * 8);
      const u32x2 r_ = *(const u32x2*)(p.kr + (size_t)krow * 32 + st_ch * 4);
      const u32x4 v_ = *(const u32x4*)(vTb + (size_t)st_key * TP + vcol);
      const bool kz = meta && st_key >= 16, vz = meta && st_ch >= 2;
#pragma unroll
      for (int i = 0; i < 4; ++i) { rk[i] = kz ? 0u : k_[i]; rv[i] = vz ? 0u : v_[i]; }
      rkr[0] = kz ? 0u : r_[0]; rkr[1] = kz ? 0u : r_[1];
    };
    auto sstore = [&](int st) {
      char* ks = smem + st * ATT_STAGE; char* vs = ks + 64 * KS_STRIDE;
      *(u32x4*)(ks + st_key * KS_STRIDE + st_ch * 16) = rk;
      *(u32x2*)(ks + st_key * KS_STRIDE + 128 + st_ch * 8) = rkr;
      char* d = vs + st_key * VS_STRIDE + st_ch * 16;
      *(u32x2*)d = (u32x2){rv[0], rv[1]}; *(u32x2*)(d + 8) = (u32x2){rv[2], rv[3]};
    };
    lds_barrier();
    gload(0); sstore(0);
    lds_barrier();
    for (int kt = 0; kt < 33; ++kt) {
      const int cur = kt & 1;
      if (kt + 1 < 33) gload(kt + 1);
      const char* ks_ = smem + cur * ATT_STAGE; const char* vs_ = ks_ + 64 * KS_STRIDE;
      f32x16 sacc[2];
      bf16x8 kfr[6][2];
#pragma unroll
      for (int ks = 0; ks < 6; ++ks)
#pragma unroll
        for (int t2 = 0; t2 < 2; ++t2) kfr[ks][t2] = *(const bf16x8*)(ks_ + (t2 * 32 + r32) * KS_STRIDE + ks * 32 + hh * 16);
      __builtin_amdgcn_sched_barrier(0);
      __builtin_amdgcn_s_setprio(1);
#pragma unroll
      for (int ks = 0; ks < 6; ++ks)
#pragma unroll
        for (int t2 = 0; t2 < 2; ++t2)
          sacc[t2] = __builtin_amdgcn_mfma_f32_32x32x16_bf16(kfr[ks][t2], qf[ks], ks == 0 ? negm : sacc[t2], 0, 0, 0);
      __builtin_amdgcn_s_setprio(0);
      __builtin_amdgcn_sched_barrier(0);
      u32x2 vfa[2][2][2], vfb[2][2][2];
#pragma unroll
      for (int t2 = 0; t2 < 2; ++t2)
#pragma unroll
        for (int s2 = 0; s2 < 2; ++s2)
#pragma unroll
          for (int dvt = 0; dvt < 2; ++dvt) {
            const char* vp = vs_ + (dvt * 32 + r32) * VS_STRIDE + (t2 * 32 + s2 * 16 + 4 * hh) * 2;
            vfa[t2][s2][dvt] = *(const u32x2*)vp; vfb[t2][s2][dvt] = *(const u32x2*)(vp + 16);
          }
      __builtin_amdgcn_sched_barrier(0);
      if (kt == 32) {
#pragma unroll
        for (int t2 = 0; t2 < 2; ++t2)
#pragma unroll
          for (int i = 0; i < 16; ++i) {
            int kk = t2 * 32 + (i & 3) + 8 * (i >> 2) + 4 * hh;
            if (kk >= 16) sacc[t2][i] = -1e30f;
          }
      }
      {
        float mx = sacc[0][0];
#pragma unroll
        for (int t2 = 0; t2 < 2; ++t2)
#pragma unroll
          for (int i = 0; i < 16; ++i) mx = fmaxf(mx, sacc[t2][i]);
        mx = swap32_max(mx);
        if (kt == 0 || __any(mx > 8.f)) {
          const float d = kt == 0 ? mx : fmaxf(mx, 0.f);
          const float alpha = kt == 0 ? 1.f : __builtin_amdgcn_exp2f(-d);
#pragma unroll
          for (int i = 0; i < 16; ++i) {
            sacc[0][i] -= d; sacc[1][i] -= d; negm[i] -= d;
            oacc[0][i] *= alpha; oacc[1][i] *= alpha;
          }
          l_run *= alpha;
        }
        float ps = 0.f;
#pragma unroll
        for (int t2 = 0; t2 < 2; ++t2)
#pragma unroll
          for (int i = 0; i < 16; ++i) { float e = __builtin_amdgcn_exp2f(sacc[t2][i]); sacc[t2][i] = e; ps += e; }
        l_run += ps;
      }
#pragma unroll
      for (int t2 = 0; t2 < 2; ++t2)
#pragma unroll
        for (int s2 = 0; s2 < 2; ++s2) {
          u32x4 pw;
#pragma unroll
          for (int j = 0; j < 4; ++j) pw[j] = pk_bf16(sacc[t2][s2 * 8 + 2 * j], sacc[t2][s2 * 8 + 2 * j + 1]);
          const bf16x8 pf = as_bf16x8(pw);
#pragma unroll
          for (int dvt = 0; dvt < 2; ++dvt) {
            const u32x2 a2 = vfa[t2][s2][dvt], b2 = vfb[t2][s2][dvt];
            bf16x8 vf = as_bf16x8((u32x4){a2[0], a2[1], b2[0], b2[1]});
            oacc[dvt] = __builtin_amdgcn_mfma_f32_32x32x16_bf16(vf, pf, oacc[dvt], 0, 0, 0);
          }
        }
      if (kt + 1 < 33) sstore(cur ^ 1);
      lds_barrier();
    }
    {
      const float l_tot = swap32_sum(l_run);
      const float inv = __builtin_amdgcn_rcpf(l_tot);
      const int qi = qb * 256 + wid * 32 + r32;
      bf16_t* op = p.o + ((size_t)seq * SEQ + qi) * 512 + h * 64;
#pragma unroll
      for (int dvt = 0; dvt < 2; ++dvt)
#pragma unroll
        for (int g4 = 0; g4 < 4; ++g4) {
          u32x2 w;
          w[0] = pk_bf16(oacc[dvt][g4 * 4 + 0] * inv, oacc[dvt][g4 * 4 + 1] * inv);
          w[1] = pk_bf16(oacc[dvt][g4 * 4 + 2] * inv, oacc[dvt][g4 * 4 + 3] * inv);
          *(u32x2*)(op + dvt * 32 + g4 * 8 + hh * 4) = w;
        }
    }
  }
  lds_barrier();
}

constexpr int SS_ROW = 272;
constexpr int SS_XT = 264;

constexpr int DG_CC = 0, DG_BC = 128 * SS_ROW, DG_XT = 2 * 128 * SS_ROW, DG_AR = DG_XT + 2 * 64 * SS_XT, DG_BW = DG_AR + 2 * 2048, DG_LDS = DG_BW + 8 * 512;
static_assert(DG_LDS <= 150 * 1024, "diag lds");
__device__ void ssd_diag_phase(const Params& p, char* smem) {
  const int tid = phase_tid(), lane = tid & 63, wid = tid >> 6;
  const int r32 = lane & 31, hh = lane >> 5;
  const int pt = wid & 1, lt = wid >> 1;
  const int l = lt * 32 + r32;
  for (int item = blockIdx.x; item < NSEQ * 16 * 2; item += gridDim.x) {
    const int g = item & 1, c = 1 + ((item >> 1) & 15), seq = item >> 5;
    u32x4 rx[2]; float ra = 0.f;
    auto gload_head = [&](int h) {
      const bf16_t* xt = p.XT + (((size_t)seq * NCH + c) * 16 + h) * 64 * 128;
#pragma unroll
      for (int i = 0; i < 2; ++i) { int id = tid + i * 512; int r = id >> 4, k = id & 15;
        rx[i] = *(const u32x4*)(xt + (size_t)r * 128 + k * 8); }
      const int arr = tid >> 7, idx = tid & 127, dir = arr & 1;
      const float* src = (arr < 2 ? p.Pv : p.dtv) + ((size_t)(seq * 2 + dir) * 16 + h) * LP + c * 128 + idx;
      ra = *src;
    };
    auto sstore_head = [&](int buf) {
#pragma unroll
      for (int i = 0; i < 2; ++i) { int id = tid + i * 512; int r = id >> 4, k = id & 15;
        char* d = smem + DG_XT + buf * 64 * SS_XT + r * SS_XT + k * 16;
        *(u32x2*)d = (u32x2){rx[i][0], rx[i][1]}; *(u32x2*)(d + 8) = (u32x2){rx[i][2], rx[i][3]}; }
      ((float*)(smem + DG_AR + buf * 2048))[tid] = tid < 256 ? ra * 1.4426950408889634f : ra;
    };
    lds_barrier();
    {
      const bf16_t* cm = p.Cm + ((size_t)seq * LP + c * 128) * 256 + g * 128;
      const bf16_t* bm = p.Bm + ((size_t)seq * LP + c * 128) * 256 + g * 128;
      u32x4 rc[4], rb[4];
#pragma unroll
      for (int i = 0; i < 4; ++i) { int id = tid + i * 512; int r = id >> 4, k = id & 15;
        rc[i] = *(const u32x4*)(cm + (size_t)r * 256 + k * 8); rb[i] = *(const u32x4*)(bm + (size_t)r * 256 + k * 8); }
      gload_head(g * 8);
#pragma unroll
      for (int i = 0; i < 4; ++i) { int id = tid + i * 512; int r = id >> 4, k = id & 15;
        *(u32x4*)(smem + DG_CC + r * SS_ROW + k * 16) = rc[i]; *(u32x4*)(smem + DG_BC + r * SS_ROW + k * 16) = rb[i]; }
      sstore_head(0);
    }
    lds_barrier();
    f32x16 xacc[4];
#pragma unroll
    for (int st = 0; st < 4; ++st) {
#pragma unroll
      for (int i = 0; i < 16; ++i) xacc[st][i] = 0.f;
#pragma unroll
      for (int ks = 0; ks < 8; ++ks) {
        bf16x8 bfg = *(const bf16x8*)(smem + DG_BC + (st * 32 + r32) * SS_ROW + ks * 32 + hh * 16);
        bf16x8 cfk = *(const bf16x8*)(smem + DG_CC + l * SS_ROW + ks * 32 + hh * 16);
        xacc[st] = __builtin_amdgcn_mfma_f32_32x32x16_bf16(bfg, cfk, xacc[st], 0, 0, 0);
      }
    }
    unsigned mkf[16], mkb[16];
#pragma unroll
    for (int i = 0; i < 16; ++i) { const int sx = lt * 32 + (i & 3) + 8 * (i >> 2) + 4 * hh; mkf[i] = sx <= l ? 0xffffffffu : 0u; mkb[i] = sx >= l ? 0xffffffffu : 0u; }
    for (int h8 = 0; h8 < 8; ++h8) {
      const int h = g * 8 + h8, buf = h8 & 1;
      if (h8 + 1 < 8) gload_head(h + 1);
      const char* xtb = smem + DG_XT + buf * 64 * SS_XT;
      const float* Pf = (const float*)(smem + DG_AR + buf * 2048);
      const float* Pb = Pf + 128; const float* Df = Pf + 256; const float* Db = Pf + 384;
      const float Pfl = Pf[l], Pbl = Pb[l];
      float* bw = (float*)(smem + DG_BW + wid * 512);
      const float PrefF = Pf[lt * 32], PrefB = Pb[lt * 32 + 31];
      const float af = __builtin_amdgcn_exp2f(Pfl - PrefF), ab = __builtin_amdgcn_exp2f(Pbl - PrefB);
#pragma unroll
      for (int r = 0; r < 2; ++r) {
        const int sx = lane + 64 * r;
        float bv = 0.f;
        if (sx < lt * 32) bv = Df[sx] * __builtin_amdgcn_exp2f(PrefF - Pf[sx]);
        else if (sx >= (lt + 1) * 32) bv = Db[sx] * __builtin_amdgcn_exp2f(PrefB - Pb[sx]);
        bw[sx] = bv;
      }
      asm volatile("s_waitcnt lgkmcnt(0)" ::: "memory");
      f32x16 yacc;
#pragma unroll
      for (int i = 0; i < 16; ++i) yacc[i] = 0.f;
#pragma unroll
      for (int st = 0; st < 4; ++st) {
        float m[16];
        if (st != lt) {
          const float a = st < lt ? af : ab;
#pragma unroll
          for (int i = 0; i < 16; ++i) { const int sx = st * 32 + (i & 3) + 8 * (i >> 2) + 4 * hh;
            m[i] = xacc[st][i] * (a * bw[sx]); }
        } else {
#pragma unroll
          for (int i = 0; i < 16; ++i) { const int sx = st * 32 + (i & 3) + 8 * (i >> 2) + 4 * hh;
            const float wf = Df[sx] * __builtin_amdgcn_exp2f(Pfl - Pf[sx]), wb = Db[sx] * __builtin_amdgcn_exp2f(Pbl - Pb[sx]);
            m[i] = xacc[st][i] * (__uint_as_float(__float_as_uint(wf) & mkf[i]) + __uint_as_float(__float_as_uint(wb) & mkb[i])); }
        }
#pragma unroll
        for (int s2 = 0; s2 < 2; ++s2) {
          u32x4 pw;
#pragma unroll
          for (int j = 0; j < 4; ++j) pw[j] = pk_bf16(m[s2 * 8 + 2 * j], m[s2 * 8 + 2 * j + 1]);
          const char* xp = xtb + (pt * 32 + r32) * SS_XT + (st * 32 + s2 * 16 + 4 * hh) * 2;
          u32x2 a = *(const u32x2*)xp, b2 = *(const u32x2*)(xp + 16);
          bf16x8 xf = as_bf16x8((u32x4){a[0], a[1], b2[0], b2[1]});
          yacc = __builtin_amdgcn_mfma_f32_32x32x16_bf16(xf, as_bf16x8(pw), yacc, 0, 0, 0);
        }
      }
      const float dskip = p.d_skip[h];
      bf16_t* yp = p.Y + ((size_t)seq * SEQ + (c - 1) * 128 + l) * 1024 + h * 64 + pt * 32 + 4 * hh;
#pragma unroll
      for (int g4 = 0; g4 < 4; ++g4) {
        float v[4];
#pragma unroll
        for (int j = 0; j < 4; ++j) {
          const int pp = pt * 32 + g4 * 8 + 4 * hh + j;
          v[j] = yacc[g4 * 4 + j] + dskip * bf2f(*(const bf16_t*)(xtb + pp * SS_XT + l * 2));
        }
        u32x2 w; w[0] = pk_bf16(v[0], v[1]); w[1] = pk_bf16(v[2], v[3]);
        *(u32x2*)(yp + g4 * 8) = w;
      }
      if (h8 + 1 < 8) sstore_head(buf ^ 1);
      lds_barrier();
    }
  }
  lds_barrier();
}

constexpr int OFF_CC = 0, OFF_BT = 128 * SS_ROW, OFF_XT = 2 * 128 * SS_ROW;
constexpr int OFF_XW = OFF_XT + 64 * SS_XT, OFF_SB = OFF_XW + 64 * SS_ROW, OFF_P = OFF_SB + 64 * SS_ROW, OFF_DT = OFF_P + 512;
constexpr int OFF_AT = OFF_DT + 512;
constexpr int OFF_WS = OFF_AT + 128;
constexpr int OFF_YT = OFF_WS + 512;
constexpr int SSD_LDS = OFF_YT + 128 * 272;
static_assert(SSD_LDS <= 160 * 1024 - 64, "ssd lds");
__device__ void ssd_phase(const Params& p, char* smem) {
  const int tid = phase_tid(), lane = tid & 63, wid = tid >> 6;
  const int r32 = lane & 31, hh = lane >> 5;
  const int pt = wid & 1, lt = wid >> 1;
  float* Ps = (float*)(smem + OFF_P);
  float* Ds = (float*)(smem + OFF_DT);
  const int NI = NSEQ * 16, G = gridDim.x;
  const bool split = G >= 256 && G < NI;
  for (int u = 0;; ++u) {
    int item, dir0, dir1; bool to_yb2 = false;
    if (!split) { item = blockIdx.x + u * G; if (item >= NI) break; dir0 = 0; dir1 = 2; }
    else if (G == 256) {
      int gg, j; xcd_group_map(blockIdx.x, gg, j);
      if (u == 0) { item = gg * 8 + j; dir0 = 0; dir1 = 2; }
      else if (u == 1) { item = G + (gg >> 1) * 8 + j; dir0 = gg & 1; dir1 = dir0 + 1; to_yb2 = true; }
      else break;
    }
    else if (u == 0) { item = blockIdx.x; dir0 = 0; dir1 = 2; }
    else { const int hidx = blockIdx.x + (u - 1) * G; if (hidx >= 2 * (NI - G)) break; item = G + (hidx >> 1); dir0 = hidx & 1; dir1 = dir0 + 1; to_yb2 = true; }
    const int h = item & 15, seq = item >> 4, g = h >> 3;
    for (int dir = dir0; dir < dir1; ++dir) {
      const bool yb2 = (dir == 1) && to_yb2;
      f32x16 sacc;
#pragma unroll
      for (int i = 0; i < 16; ++i) sacc[i] = 0.f;
      const float* dtp = p.dtv + ((size_t)(seq * 2 + dir) * 16 + h) * LP;
      const float* Pp = p.Pv + ((size_t)(seq * 2 + dir) * 16 + h) * LP;
      const float* Ap = p.Atot + ((size_t)(seq * 2 + dir) * 16 + h) * NCH;
      u32x4 rc[4], rbt[4], rx[2];
      float rp = 0.f, rd = 0.f;
      auto gload = [&](int c) {
        const bf16_t* cm = p.Cm + ((size_t)seq * LP + c * 128) * 256 + g * 128;
        const bf16_t* bt = p.BmT + (((size_t)seq * NCH + c) * 2 + g) * 128 * 128;
        const bf16_t* xt = p.XT + (((size_t)seq * NCH + c) * 16 + h) * 64 * 128;
#pragma unroll
        for (int i = 0; i < 4; ++i) { int id = tid + i * 512; int r = id >> 4, k = id & 15;
          rc[i] = *(const u32x4*)(cm + (size_t)r * 256 + k * 8);
          rbt[i] = *(const u32x4*)(bt + (size_t)r * 128 + k * 8); }
#pragma unroll
        for (int i = 0; i < 2; ++i) { int id = tid + i * 512; int r = id >> 4, k = id & 15;
          rx[i] = *(const u32x4*)(xt + (size_t)r * 128 + k * 8); }
        if (tid < 128) { rp = Pp[c * 128 + tid]; rd = dtp[c * 128 + tid]; }
      };
      auto sstore = [&](int cs) {
#pragma unroll
        for (int i = 0; i < 4; ++i) { int id = tid + i * 512; int r = id >> 4, k = id & 15;
          *(u32x4*)(smem + OFF_CC + r * SS_ROW + k * 16) = rc[i];
          *(u32x4*)(smem + OFF_BT + r * SS_ROW + k * 16) = rbt[i]; }
#pragma unroll
        for (int i = 0; i < 2; ++i) { int id = tid + i * 512; int r = id >> 4, k = id & 15;
          char* d = smem + OFF_XT + r * SS_XT + k * 16;
          *(u32x2*)d = (u32x2){rx[i][0], rx[i][1]}; *(u32x2*)(d + 8) = (u32x2){rx[i][2], rx[i][3]}; }
        if (tid < 128) {
          Ps[tid] = rp; Ds[tid] = rd;
          ((float*)(smem + OFF_WS))[tid] = rd * (dir == 0 ? __expf(Ap[cs] - rp) : __expf(-rp));
        }
      };
      const int c_first = dir == 0 ? 0 : NCH - 1, c_last = dir == 0 ? NCH - 1 : 1, c_step = dir == 0 ? 1 : -1;
      lds_barrier();
      gload(c_first);
      if (tid < NCH) ((float*)(smem + OFF_AT))[tid] = Ap[tid];
      for (int i = tid; i < 64 * SS_ROW / 4; i += NTHREADS) ((unsigned*)(smem + OFF_SB))[i] = 0u;
      sstore(c_first);
      lds_barrier();
      for (int c = c_first;; c += c_step) {
        const bool last = (c == c_last);
        const bool first = (c == c_first);
        const float atot = ((const float*)(smem + OFF_AT))[c];
        const int l = lt * 32 + r32;
        const bool emit = (c >= 1) && !first;
        const int yrow = tid >> 2, yseg = tid & 3;
        bf16_t* yp = yb2 ? p.Yb2 + ((size_t)(item - G) * SEQ + (c - 1) * 128 + yrow) * 64 + yseg * 16
                         : p.Y + ((size_t)seq * SEQ + (c - 1) * 128 + yrow) * 1024 + h * 64 + yseg * 16;
        u32x4 yold[2] = {{0u, 0u, 0u, 0u}, {0u, 0u, 0u, 0u}};
        if (emit && !yb2) {
          yold[0] = *(const u32x4*)yp; yold[1] = *(const u32x4*)(yp + 8);
        }
        if (!last) gload(c + c_step);
        if (!last) {
          const int pp = tid >> 3, l0 = (tid & 7) * 16;
          const char* srow = smem + OFF_XT + pp * SS_XT + l0 * 2;
          char* drow = smem + OFF_XW + pp * SS_ROW + l0 * 2;
#pragma unroll
          for (int q4 = 0; q4 < 4; ++q4) {
            u32x2 v = *(const u32x2*)(srow + q4 * 8);
            const f32x4 w = *(const f32x4*)(smem + OFF_WS + (l0 + q4 * 4) * 4);
            u32x2 o;
            o[0] = pk_bf16(bflo(v[0]) * w[0], bfhi(v[0]) * w[1]);
            o[1] = pk_bf16(bflo(v[1]) * w[2], bfhi(v[1]) * w[3]);
            *(u32x2*)(drow + q4 * 8) = o;
          }
        }
        if (emit) {
          const float Pl = Ps[l];
          f32x16 yacc;
#pragma unroll
          for (int i = 0; i < 16; ++i) yacc[i] = 0.f;
#pragma unroll
          for (int ks = 0; ks < 8; ++ks) {
            bf16x8 sf = *(const bf16x8*)(smem + OFF_SB + (pt * 32 + r32) * SS_ROW + ks * 32 + hh * 16);
            bf16x8 cfk = *(const bf16x8*)(smem + OFF_CC + l * SS_ROW + ks * 32 + hh * 16);
            yacc = __builtin_amdgcn_mfma_f32_32x32x16_bf16(sf, cfk, yacc, 0, 0, 0);
          }
          const float ysc = dir == 0 ? __expf(Pl) : __expf(Pl + atot);
#pragma unroll
          for (int g4 = 0; g4 < 4; ++g4)
            *(f32x4*)(smem + OFF_YT + l * 272 + (pt * 32 + g4 * 8 + 4 * hh) * 4) =
                (f32x4){yacc[g4 * 4] * ysc, yacc[g4 * 4 + 1] * ysc, yacc[g4 * 4 + 2] * ysc, yacc[g4 * 4 + 3] * ysc};
        }
        lds_barrier();
        if (emit || (yb2 && c >= 1)) {
          float v[16];
#pragma unroll
          for (int q4 = 0; q4 < 4; ++q4) {
            const f32x4 t4 = emit ? *(const f32x4*)(smem + OFF_YT + yrow * 272 + yseg * 64 + q4 * 16) : (f32x4){0.f, 0.f, 0.f, 0.f};
            v[q4 * 4] = t4[0]; v[q4 * 4 + 1] = t4[1]; v[q4 * 4 + 2] = t4[2]; v[q4 * 4 + 3] = t4[3];
          }
          u32x4 w0, w1;
#pragma unroll
          for (int j = 0; j < 4; ++j) {
            w0[j] = pk_bf16(v[2 * j] + bflo(yold[0][j]), v[2 * j + 1] + bfhi(yold[0][j]));
            w1[j] = pk_bf16(v[8 + 2 * j] + bflo(yold[1][j]), v[8 + 2 * j + 1] + bfhi(yold[1][j]));
          }
          *(u32x4*)yp = w0; *(u32x4*)(yp + 8) = w1;
        }
        if (!last) {
          const float dec = __expf(atot);
#pragma unroll
          for (int i = 0; i < 16; ++i) sacc[i] *= dec;
#pragma unroll
          for (int ks = 0; ks < 8; ++ks) {
            bf16x8 xf = *(const bf16x8*)(smem + OFF_XW + (pt * 32 + r32) * SS_ROW + ks * 32 + hh * 16);
            bf16x8 bfg = *(const bf16x8*)(smem + OFF_BT + (lt * 32 + r32) * SS_ROW + ks * 32 + hh * 16);
            sacc = __builtin_amdgcn_mfma_f32_32x32x16_bf16(bfg, xf, sacc, 0, 0, 0);
          }
#pragma unroll
          for (int g4 = 0; g4 < 4; ++g4)
            *(u32x2*)(smem + OFF_SB + (pt * 32 + r32) * SS_ROW + (lt * 32 + g4 * 8 + 4 * hh) * 2) =
                (u32x2){pk_bf16(sacc[g4 * 4], sacc[g4 * 4 + 1]), pk_bf16(sacc[g4 * 4 + 2], sacc[g4 * 4 + 3])};
        }
        lds_barrier();
        if (last) break;
        sstore(c + c_step);
        lds_barrier();
      }
    }
  }
  lds_barrier();
}

__device__ void gate_phase(const Params& p) {
  const int lane = phase_tid() & 63, wid = phase_tid() >> 6;
  const int G = gridDim.x;
  const bool split = G >= 256 && G < NSEQ * 16;
  struct In { u32x4 y[2], z[2], y2[2], o; };
  auto load = [&](In& d, int row) {
#pragma unroll
    for (int c = 0; c < 2; ++c) {
      d.y[c] = *(const u32x4*)(p.Y + (size_t)row * 1024 + c * 512 + lane * 8);
      d.z[c] = *(const u32x4*)(p.z + (size_t)row * 1024 + c * 512 + lane * 8);
      const int item = (row >> 11) * 16 + c * 8 + (lane >> 3);
      d.y2[c] = (u32x4){0u, 0u, 0u, 0u};
      if (split && item >= G) d.y2[c] = *(const u32x4*)(p.Yb2 + ((size_t)(item - G) * SEQ + (row & (SEQ - 1))) * 64 + (lane & 7) * 8);
    }
    d.o = *(const u32x4*)(p.o + (size_t)row * 512 + lane * 8);
  };
  const int stride = gridDim.x * 8;
  int row = blockIdx.x * 8 + wid;
  In cur, nxt;
  if (row < TX) load(cur, row);
  for (; row < TX; row += stride) {
    if (row + stride < TX) load(nxt, row + stride);
    float v[16];
    float ss = 0.f;
#pragma unroll
    for (int c = 0; c < 2; ++c) {
#pragma unroll
      for (int j = 0; j < 4; ++j) {
        float a = (bflo(cur.y[c][j]) + bflo(cur.y2[c][j])) * silu_f(bflo(cur.z[c][j])), b2 = (bfhi(cur.y[c][j]) + bfhi(cur.y2[c][j])) * silu_f(bfhi(cur.z[c][j]));
        v[c * 8 + 2 * j] = a; v[c * 8 + 2 * j + 1] = b2; ss += a * a + b2 * b2;
      }
    }
    const float r = rsqrtf(wave_sum(ss) * (1.f / 1024.f) + EPS);
#pragma unroll
    for (int c = 0; c < 2; ++c) {
      const float* g = p.ssm_norm_g + c * 512 + lane * 8;
      u32x4 w;
#pragma unroll
      for (int j = 0; j < 4; ++j) w[j] = pk_bf16(v[c * 8 + 2 * j] * r * g[2 * j], v[c * 8 + 2 * j + 1] * r * g[2 * j + 1]);
      *(u32x4*)(p.ycat + (size_t)row * 1536 + c * 512 + lane * 8) = w;
    }
    {
      const u32x4 o = cur.o;
      float f[8] = {bflo(o[0]), bfhi(o[0]), bflo(o[1]), bfhi(o[1]), bflo(o[2]), bfhi(o[2]), bflo(o[3]), bfhi(o[3])};
      float s2 = 0.f;
#pragma unroll
      for (int j = 0; j < 8; ++j) s2 += f[j] * f[j];
      const float r2 = rsqrtf(wave_sum(s2) * (1.f / 512.f) + EPS);
      const float* g = p.attn_norm_g + lane * 8;
      u32x4 w;
#pragma unroll
      for (int j = 0; j < 4; ++j) w[j] = pk_bf16(f[2 * j] * r2 * g[2 * j], f[2 * j + 1] * r2 * g[2 * j + 1]);
      *(u32x4*)(p.ycat + (size_t)row * 1536 + 1024 + lane * 8) = w;
    }
    cur = nxt;
  }
}

__device__ void ln1_phase(const Params& p) {
  const int lane = phase_tid() & 63, wid = phase_tid() >> 6;
  const int stride = gridDim.x * 8;
  int row = blockIdx.x * 8 + wid;
  u32x4 nx[2];
  if (row < TX) { nx[0] = *(const u32x4*)(p.pre + (size_t)row * DM + lane * 8); nx[1] = *(const u32x4*)(p.pre + (size_t)row * DM + 512 + lane * 8); }
  for (; row < TX; row += stride) {
    const u32x4 cu[2] = {nx[0], nx[1]};
    if (row + stride < TX) { nx[0] = *(const u32x4*)(p.pre + (size_t)(row + stride) * DM + lane * 8); nx[1] = *(const u32x4*)(p.pre + (size_t)(row + stride) * DM + 512 + lane * 8); }
    float v[16];
#pragma unroll
    for (int c = 0; c < 2; ++c) {
#pragma unroll
      for (int j = 0; j < 4; ++j) { v[c * 8 + 2 * j] = bflo(cu[c][j]); v[c * 8 + 2 * j + 1] = bfhi(cu[c][j]); }
    }
    float s = 0.f;
#pragma unroll
    for (int j = 0; j < 16; ++j) s += v[j];
    const float mu = wave_sum(s) * (1.f / DM);
    float s2 = 0.f;
#pragma unroll
    for (int j = 0; j < 16; ++j) { float d = v[j] - mu; s2 += d * d; }
    const float rstd = rsqrtf(wave_sum(s2) * (1.f / DM) + EPS);
#pragma unroll
    for (int c = 0; c < 2; ++c) {
      const float* g = p.ln1_g + c * 512 + lane * 8; const float* b = p.ln1_b + c * 512 + lane * 8;
      float o[8];
#pragma unroll
      for (int j = 0; j < 8; ++j) o[j] = (v[c * 8 + j] - mu) * rstd * g[j] + b[j];
      *(u32x4*)(p.h1 + (size_t)row * DM + c * 512 + lane * 8) = pack8(o);
      float am = 0.f;
#pragma unroll
      for (int j = 0; j < 8; ++j) am = fmaxf(am, fabsf(o[j]));
      am = fmaxf(am, __builtin_bit_cast(float, __builtin_amdgcn_update_dpp(0, __builtin_bit_cast(int, am), 0x128, 0xf, 0xf, true)));
      am = fmaxf(am, __builtin_bit_cast(float, __builtin_amdgcn_update_dpp(0, __builtin_bit_cast(int, am), 0x124, 0xf, 0xf, true)));
      am = fmaxf(am, __builtin_bit_cast(float, __builtin_amdgcn_update_dpp(0, __builtin_bit_cast(int, am), 0x122, 0xf, 0xf, true)));
      am = fmaxf(am, __builtin_bit_cast(float, __builtin_amdgcn_update_dpp(0, __builtin_bit_cast(int, am), 0x121, 0xf, 0xf, true)));
      const float sc = am > 0.f ? am * (1.f / 127.f) : 1.f;
      const float inv = 1.f / sc;
      unsigned w0 = 0u, w1 = 0u;
#pragma unroll
      for (int j = 0; j < 4; ++j) {
        w0 |= ((unsigned)__float2int_rn(o[j] * inv) & 255u) << (8 * j);
        w1 |= ((unsigned)__float2int_rn(o[4 + j] * inv) & 255u) << (8 * j);
      }
      *(u32x2*)(p.h1q + (size_t)row * DM + c * 512 + lane * 8) = (u32x2){w0, w1};
      if ((lane & 15) == 0) p.sx[(size_t)row * 8 + c * 4 + (lane >> 4)] = sc;
    }
  }
}

template <bool INT8>
__device__ void quant_rows(const float* __restrict__ src, unsigned char* __restrict__ dstq, float* __restrict__ scl) {
  const int lane = phase_tid() & 63, wid = phase_tid() >> 6;
  const int estride = gridDim.x * 8;
  f32x4 nx[4];
  { const int e0 = blockIdx.x * 8 + wid;
    if (e0 < 16384) {
#pragma unroll
      for (int j = 0; j < 4; ++j) nx[j] = *(const f32x4*)(src + (size_t)e0 * 1024 + lane * 4 + j * 256); } }
  for (int e = blockIdx.x * 8 + wid; e < 16384; e += estride) {
    f32x4 a[4];
#pragma unroll
    for (int j = 0; j < 4; ++j) a[j] = nx[j];
    if (e + estride < 16384) {
#pragma unroll
      for (int j = 0; j < 4; ++j) nx[j] = *(const f32x4*)(src + (size_t)(e + estride) * 1024 + lane * 4 + j * 256); }
    float m = 0.f;
#pragma unroll
    for (int j = 0; j < 4; ++j)
#pragma unroll
      for (int k = 0; k < 4; ++k) m = fmaxf(m, fabsf(a[j][k]));
    m = wave_max(m);
    const float sc = m > 0.f ? m * (INT8 ? (1.f / 127.f) : (1.f / 240.f)) : 1.f;
    const float inv = 1.f / sc;
#pragma unroll
    for (int j = 0; j < 4; ++j) {
      unsigned w;
      if (INT8) {
        w = 0u;
#pragma unroll
        for (int k = 0; k < 4; ++k) w |= ((unsigned)__float2int_rn(a[j][k] * inv) & 255u) << (8 * k);
      } else {
        int t = __builtin_amdgcn_cvt_pk_fp8_f32(a[j][0] * inv, a[j][1] * inv, 0, false);
        t = __builtin_amdgcn_cvt_pk_fp8_f32(a[j][2] * inv, a[j][3] * inv, t, true);
        w = (unsigned)t;
      }
      *(unsigned*)(dstq + ((size_t)(j * 2 + (lane >> 5)) * 16384 + e) * 128 + (lane & 31) * 4) = w;
    }
    if (lane == 0) scl[e] = sc;
  }
}

__device__ __forceinline__ float dpp_add8(float v) {
  v += __builtin_bit_cast(float, __builtin_amdgcn_update_dpp(0, __builtin_bit_cast(int, v), 0xB1, 0xf, 0xf, true));
  v += __builtin_bit_cast(float, __builtin_amdgcn_update_dpp(0, __builtin_bit_cast(int, v), 0x4E, 0xf, 0xf, true));
  v += __builtin_bit_cast(float, __builtin_amdgcn_update_dpp(0, __builtin_bit_cast(int, v), 0x141, 0xf, 0xf, true));
  return v;
}
__device__ __forceinline__ void fp8x16_to_f32(u32x4 w, float (&f)[16]) {
#pragma unroll
  for (int j = 0; j < 4; ++j) {
    f32x2_t lo = __builtin_amdgcn_cvt_pk_f32_fp8((int)w[j], false);
    f32x2_t hi = __builtin_amdgcn_cvt_pk_f32_fp8((int)w[j], true);
    f[4 * j] = lo[0]; f[4 * j + 1] = lo[1]; f[4 * j + 2] = hi[0]; f[4 * j + 3] = hi[1];
  }
}

__device__ void peer_u_phase(const Params& p, char* smem) {
  const int lane = phase_tid() & 63, wid = phase_tid() >> 6;
  const int sg = lane >> 3, q = lane & 7;
  const int nr = gridDim.x >> 3;
  if ((int)blockIdx.x >= nr * 8) return;
  const volatile LAS unsigned* st = (const volatile LAS unsigned*)(smem + LDS_BYTES - 32);
  const bool xok = st[4] != 0u;
  const int slice = xok ? (int)st[2] : (int)(blockIdx.x & 7), rank = xok ? (int)st[3] : (int)(blockIdx.x >> 3);
  const unsigned char* Us = p.Uq + (size_t)slice * 16384 * 128 + q * 16;
  const int stride = nr * 8;
  int t = rank * 8 + wid;
  if (t >= TX) return;
  struct Ids { u32x4 e[2]; u32x4 xq; float sx; };
  auto load_ids = [&](Ids& d, int tt) {
    tt = tt < TX ? tt : TX - 1;
    const unsigned short* ep = p.experts + (size_t)tt * 128 + sg * 16;
    d.e[0] = *(const u32x4*)ep; d.e[1] = *(const u32x4*)(ep + 8);
    d.xq = *(const u32x4*)(p.h1q + (size_t)tt * DM + slice * 128 + q * 16);
    d.sx = p.sx[(size_t)tt * 8 + slice];
  };
  auto issue = [&](u32x4 (&uq)[8], const u32x4& ew) {
#pragma unroll
    for (int j = 0; j < 4; ++j) {
      uq[2 * j] = *(const u32x4*)(Us + (size_t)(ew[j] & 0xffffu) * 128);
      uq[2 * j + 1] = *(const u32x4*)(Us + (size_t)(ew[j] >> 16) * 128);
    }
  };
  const int eq = q < 4 ? q : 7 - q;
  const bool b0 = (eq & 1) != 0, b1 = (eq & 2) != 0, b2 = q >= 4;
  const int iq = (q >> 2) * 4 + eq;
  auto compute = [&](const u32x4 (&uq)[8], const u32x4& xq, float sxv) -> float {
    int d[8];
#pragma unroll
    for (int i = 0; i < 8; ++i) {
      int a = 0;
#pragma unroll
      for (int j = 0; j < 4; ++j) a = __builtin_amdgcn_sdot4((int)uq[i][j], (int)xq[j], a, false);
      d[i] = a;
    }
    int s1[4], s2[2];
#pragma unroll
    for (int j = 0; j < 4; ++j) {
      int a = d[2 * j], b = d[2 * j + 1]; asm volatile("" : "+v"(a), "+v"(b));
      const int keep = b0 ? b : a, give = b0 ? a : b;
      s1[j] = keep + __builtin_amdgcn_update_dpp(0, give, 0xB1, 0xf, 0xf, true);
    }
#pragma unroll
    for (int j = 0; j < 2; ++j) {
      int a = s1[2 * j], b = s1[2 * j + 1]; asm volatile("" : "+v"(a), "+v"(b));
      const int keep = b1 ? b : a, give = b1 ? a : b;
      s2[j] = keep + __builtin_amdgcn_update_dpp(0, give, 0x4E, 0xf, 0xf, true);
    }
    int a = s2[0], b = s2[1]; asm volatile("" : "+v"(a), "+v"(b));
    const int keep = b2 ? b : a, give = b2 ? a : b;
    const int s3 = keep + __builtin_amdgcn_update_dpp(0, give, 0x141, 0xf, 0xf, true);
    return (float)s3 * sxv;
  };
  auto step = [&](Ids& cur, Ids& nxt, Ids& nn, u32x4 (&P)[8], u32x4 (&Q)[8], u32x4 (&R)[8]) -> bool {
    const bool has1 = t + stride < TX;
    issue(R, nxt.e[0]);
    load_ids(nn, t + 2 * stride);
    const float pa = compute(P, cur.xq, cur.sx);
    issue(P, nxt.e[1]);
    const float pb = compute(Q, cur.xq, cur.sx);
    bf16_t* dst = p.pd + ((size_t)slice * TX + t) * 128 + sg * 16 + iq;
    dst[0] = f2bf(pa); dst[8] = f2bf(pb);
    return has1;
  };
  Ids A, B, C;
  u32x4 X[8], Y[8], Z[8];
  load_ids(A, t);
  load_ids(B, t + stride);
  issue(X, A.e[0]);
  issue(Y, A.e[1]);
  for (;;) {
    if (!step(A, B, C, X, Y, Z)) break;
    t += stride;
    if (!step(B, C, A, Z, X, Y)) break;
    t += stride;
    if (!step(C, A, B, Y, Z, X)) break;
    t += stride;
  }
}

__device__ void peer_c_phase(const Params& p) {
  const size_t n4 = (size_t)TX * 128 / 4;
  const int tid = phase_tid();
  for (size_t i0 = (size_t)blockIdx.x * NTHREADS; i0 < n4; i0 += (size_t)gridDim.x * NTHREADS) {
    const size_t i = i0 + tid;
    f32x4 s = {0.f, 0.f, 0.f, 0.f};
#pragma unroll
    for (int sl = 0; sl < 8; ++sl) {
      const u32x2 w = *(const u32x2*)(p.pd + (size_t)sl * TX * 128 + i * 4);
      s[0] += bflo(w[0]); s[1] += bfhi(w[0]); s[2] += bflo(w[1]); s[3] += bfhi(w[1]);
    }
    const f32x4 g = *(const f32x4*)(p.gates + i * 4);
    const u32x2 ew = *(const u32x2*)(p.experts + i * 4);
    const int ev[4] = {(int)(ew[0] & 0xffffu), (int)(ew[0] >> 16), (int)(ew[1] & 0xffffu), (int)(ew[1] >> 16)};
    float c[4];
    float am = 0.f;
#pragma unroll
    for (int j = 0; j < 4; ++j) {
      const float d = s[j] * p.su[ev[j]];
      c[j] = g[j] * 0.5f * d * (1.f + erff(d * 0.70710678118654752f)) * p.sv[ev[j]];
      am = fmaxf(am, fabsf(c[j]));
    }
    am = swap16_max(row16_max(am));
    const float sc = am > 0.f ? am * (1.f / 240.f) : 1.f;
    const float inv = 1.f / sc;
    int w = __builtin_amdgcn_cvt_pk_fp8_f32(c[0] * inv, c[1] * inv, 0, false);
    w = __builtin_amdgcn_cvt_pk_fp8_f32(c[2] * inv, c[3] * inv, w, true);
    const size_t t = i >> 5; const int gq = (int)(i & 31);
    const int c4 = gq & 3, sgq = gq >> 2, a4 = sgq >> 2, r4 = sgq & 3;
    unsigned outw = 0u;
#pragma unroll
    for (int m = 0; m < 4; ++m) {
      const int srcl = (tid & 32) + (4 * a4 + m) * 4 + c4;
      const unsigned vm = (unsigned)__builtin_amdgcn_ds_bpermute(srcl * 4, w);
      outw |= ((vm >> (8 * r4)) & 255u) << (8 * m);
    }
    ((unsigned*)(p.cq + t * 128))[(4 * c4 + r4) * 2 + a4] = outw;
    if (gq == 0) p.csc[t] = sc;
  }
}

typedef int v2i_t __attribute__((ext_vector_type(2)));
constexpr int PV_BLK = 1024 + 32;
constexpr int PV_WAVE_LDS = 16 * PV_BLK + 512;
static_assert(8 * PV_WAVE_LDS <= 160 * 1024 - 64, "peer v lds");
__device__ void peer_v_phase(const Params& p, char* smem) {
  const int lane = phase_tid() & 63, wid = __builtin_amdgcn_readfirstlane(phase_tid() >> 6);
  const int sg = (lane >> 2) & 7, q = (lane >> 5) * 4 + (lane & 3);
  const int kg = lane >> 4;
  const int nr = gridDim.x >> 3;
  if ((int)blockIdx.x >= nr * 8) return;
  const volatile LAS unsigned* st = (const volatile LAS unsigned*)(smem + LDS_BYTES - 32);
  const bool xok = st[4] != 0u;
  const int slice = xok ? (int)st[2] : (int)(blockIdx.x & 7), rank = xok ? (int)st[3] : (int)(blockIdx.x >> 3);
  const unsigned char* Vs = p.Vq + (size_t)slice * 16384 * 128 + q * 16;
  LAS char* wb = (LAS char*)smem + wid * PV_WAVE_LDS;
  const int stride = nr * 8;
  int t = rank * 8 + wid;
  if (t >= TX) return;
  typedef int v8i_t __attribute__((ext_vector_type(8)));
  struct Ids { u32x4 e[2]; };
  struct Co { v8i_t av; float sc; };
  auto load_ids = [&](Ids& d, int tt) {
    tt = tt < TX ? tt : TX - 1;
    const unsigned short* ep = p.experts + (size_t)tt * 128 + sg * 16;
    d.e[0] = *(const u32x4*)ep; d.e[1] = *(const u32x4*)(ep + 8);
  };
  auto load_co = [&](Co& d, int tt) {
    tt = tt < TX ? tt : TX - 1;
    const unsigned char* cp = p.cq + (size_t)tt * 128 + kg * 8;
#pragma unroll
    for (int ks = 0; ks < 4; ++ks) { const u32x2 w = *(const u32x2*)(cp + ks * 32); d.av[2 * ks] = (int)w[0]; d.av[2 * ks + 1] = (int)w[1]; }
    d.sc = p.csc[tt];
  };
  auto issue = [&](u32x4 (&vq)[8], const u32x4& ew) {
#pragma unroll
    for (int j = 0; j < 4; ++j) {
      vq[2 * j] = *(const u32x4*)(Vs + (size_t)(ew[j] & 0xffffu) * 128);
      vq[2 * j + 1] = *(const u32x4*)(Vs + (size_t)(ew[j] >> 16) * 128);
    }
  };
  auto commit = [&](int half, const u32x4 (&vq)[8]) {
#pragma unroll
    for (int j = 0; j < 8; ++j) *(LAS u32x4*)(wb + (half * 8 + j) * PV_BLK + lane * 16) = vq[j];
  };
  f32x4 acc[8];
  const int troff = ((lane & 15) >> 1) * 64 + (lane & 1) * 8;
  auto consume_all = [&](const Co& d) {
    const v8i_t av = d.av;
    int toff = troff;
#pragma unroll
    for (int nt = 0; nt < 8; ++nt) {
      v8i_t bvv;
#pragma unroll
      for (int s = 0; s < 4; ++s) {
        const LAS char* blk = wb + ((s >> 1) * 8 + (s & 1) * 4 + kg) * PV_BLK + toff;
        const v2i_t bv = __builtin_amdgcn_ds_read_tr8_b64_v2i32((LAS v2i_t*)(blk + (nt >> 2) * 512 + (nt & 3) * 16));
        bvv[2 * s] = bv[0]; bvv[2 * s + 1] = bv[1];
      }
      acc[nt] = __builtin_amdgcn_mfma_scale_f32_16x16x128_f8f6f4(av, bvv, (f32x4){0.f, 0.f, 0.f, 0.f}, 0, 0, 0, 0x7f7f7f7f, 0, 0x7f7f7f7f);
      if (nt >= 1 && nt + 2 < 8) asm volatile("" : "+v"(toff) : "v"(acc[nt - 1]));
    }
  };
  Co ccur, cnxt;
  auto step = [&](Ids& cur, Ids& nxt, Ids& nn, u32x4 (&P)[8], u32x4 (&Q)[8], u32x4 (&R)[8]) -> bool {
    const bool has1 = t + stride < TX;
    issue(R, nxt.e[0]);
    load_ids(nn, t + 2 * stride);
    load_co(cnxt, t + stride);
    const unsigned xh = *(const unsigned*)(p.h1 + (size_t)t * DM + slice * 128 + lane * 2);
    commit(0, P);
    issue(P, nxt.e[1]);
    commit(1, Q);
    consume_all(ccur);
    LAS float* yt = (LAS float*)(wb + 16 * PV_BLK);
    if (lane < 16) {
#pragma unroll
      for (int nt = 0; nt < 8; ++nt) yt[nt * 16 + lane] = acc[nt][0];
    }
    asm volatile("s_waitcnt lgkmcnt(0)" ::: "memory");
    {
      const float y0 = yt[lane * 2], y1 = yt[lane * 2 + 1];
      *(unsigned*)(p.pre2 + (size_t)t * DM + slice * 128 + lane * 2) = pk_bf16(ALPHA * bflo(xh) + ccur.sc * y0, ALPHA * bfhi(xh) + ccur.sc * y1);
    }
    ccur = cnxt;
    return has1;
  };
  Ids A, B, C;
  u32x4 X[8], Y[8], Z[8];
  load_ids(A, t);
  load_ids(B, t + stride);
  load_co(ccur, t);
  issue(X, A.e[0]);
  issue(Y, A.e[1]);
  for (;;) {
    if (!step(A, B, C, X, Y, Z)) break;
    t += stride;
    if (!step(B, C, A, Z, X, Y)) break;
    t += stride;
    if (!step(C, A, B, Y, Z, X)) break;
    t += stride;
  }
}

__device__ void ln2_phase(const Params& p) {
  const int lane = phase_tid() & 63, wid = phase_tid() >> 6;
  const int stride = gridDim.x * 8;
  int row = blockIdx.x * 8 + wid;
  u32x2 nx[4];
  if (row < TX) {
#pragma unroll
    for (int c = 0; c < 4; ++c) nx[c] = *(const u32x2*)(p.pre2 + (size_t)row * DM + c * 256 + lane * 4); }
  for (; row < TX; row += stride) {
    float* dst = p.out + (size_t)row * DM;
    float v[16];
#pragma unroll
    for (int c = 0; c < 4; ++c) { v[c * 4] = bflo(nx[c][0]); v[c * 4 + 1] = bfhi(nx[c][0]); v[c * 4 + 2] = bflo(nx[c][1]); v[c * 4 + 3] = bfhi(nx[c][1]); }
    if (row + stride < TX) {
#pragma unroll
      for (int c = 0; c < 4; ++c) nx[c] = *(const u32x2*)(p.pre2 + (size_t)(row + stride) * DM + c * 256 + lane * 4); }
    float s = 0.f;
#pragma unroll
    for (int j = 0; j < 16; ++j) s += v[j];
    const float mu = wave_sum(s) * (1.f / DM);
    float s2 = 0.f;
#pragma unroll
    for (int j = 0; j < 16; ++j) { float d = v[j] - mu; s2 += d * d; }
    const float rstd = rsqrtf(wave_sum(s2) * (1.f / DM) + EPS);
#pragma unroll
    for (int c = 0; c < 4; ++c) {
      const f32x4 g = *(const f32x4*)(p.ln2_g + c * 256 + lane * 4), bb = *(const f32x4*)(p.ln2_b + c * 256 + lane * 4);
      f32x4 o;
#pragma unroll
      for (int j = 0; j < 4; ++j) o[j] = (v[c * 4 + j] - mu) * rstd * g[j] + bb[j];
      __builtin_nontemporal_store(o, (f32x4*)(dst + c * 256 + lane * 4));
    }
  }
}


#define XB_TMO      128
#define XB_XCNT(j)  (256  + 64 * (j))
#define XB_XSUB(j)  (1280 + 64 * (j))
#define XB_XGEN(j)  (2304 + 64 * (j))
#define XB_TOP      3328
#define XB_TOPGEN   3392
#define XCD_BAR_WORDS 3456
#define XB_SPIN_CAP (1u << 22)
__device__ __forceinline__ unsigned xb_ld(unsigned* p)              { return __hip_atomic_load(p, __ATOMIC_RELAXED, __HIP_MEMORY_SCOPE_AGENT); }
__device__ __forceinline__ unsigned xb_add(unsigned* p, unsigned v) { return __hip_atomic_fetch_add(p, v, __ATOMIC_RELAXED, __HIP_MEMORY_SCOPE_AGENT); }
__device__ __forceinline__ unsigned xb_xcc_id() { return (unsigned)__builtin_amdgcn_s_getreg((3 << 11) | 20) & 0xFu; }
#define XB_SPIN(cond, bar) do { unsigned _sp = 0; while (cond) { __builtin_amdgcn_s_sleep(1); \
    if ((++_sp & 255u) == 0u) { if (xb_ld(&(bar)[XB_TMO])) break; if (_sp > XB_SPIN_CAP) { atomicAdd(&(bar)[XB_TMO], 1u); break; } } } } while (0)
struct XcdBarrier { unsigned* bar; unsigned x; volatile LAS unsigned* st; };
__device__ __forceinline__ XcdBarrier xcd_barrier_post(unsigned* bar, volatile LAS unsigned* st) {
  XcdBarrier b; b.bar = bar; b.x = xb_xcc_id(); b.st = st;
  if (threadIdx.x == 0) (void)xb_add(&bar[XB_XCNT(b.x)], 1u);
  return b;
}
__device__ __forceinline__ void xcd_barrier_complete(unsigned* bar, unsigned x, unsigned& nloc, unsigned& nx) {
  const unsigned G = gridDim.x * gridDim.y * gridDim.z;
  unsigned sum, cnt, mine, sp = 0u;
  for (;;) {
    sum = 0u; cnt = 0u; mine = 0u;
#pragma unroll
    for (unsigned j = 0; j < 16; ++j) { const unsigned c = xb_ld(&bar[XB_XCNT(j)]); sum += c; cnt += (c > 0u) ? 1u : 0u; mine = (j == x) ? c : mine; }
    if (sum == G) break;
    __builtin_amdgcn_s_sleep(1);
    if ((++sp & 255u) == 0u) { if (xb_ld(&bar[XB_TMO])) break; if (sp > XB_SPIN_CAP) { atomicAdd(&bar[XB_TMO], 1u); break; } }
  }
  nloc = mine > 0u ? mine : 1u; nx = cnt > 0u ? cnt : 1u;
}
__device__ __forceinline__ void xcd_barrier(const XcdBarrier& b) {
  asm volatile("s_waitcnt vmcnt(0)" ::: "memory");
  __syncthreads();
  if (threadIdx.x == 0) {
    unsigned* bar = b.bar;
    __builtin_amdgcn_s_waitcnt(0);
    unsigned nloc = b.st[0], nx = b.st[1];
    if (nloc == 0u) { xcd_barrier_complete(bar, b.x, nloc, nx); b.st[0] = nloc; b.st[1] = nx; }
    const unsigned old = xb_add(&bar[XB_XSUB(b.x)], 1u);
    const unsigned gen = old / nloc;
    if (old + 1u == (gen + 1u) * nloc) {
      __builtin_amdgcn_fence(__ATOMIC_RELEASE, "agent");
      asm volatile("s_waitcnt vmcnt(0)" ::: "memory");
      (void)xb_add(&bar[XB_TOP], 1u);
    }
    const unsigned target = (gen + 1u) * nx;
    { unsigned sp_ = 0u;
      while (xb_ld(&bar[XB_TOP]) < target) { __builtin_amdgcn_s_sleep(4);
        if ((++sp_ & 255u) == 0u) { if (xb_ld(&bar[XB_TMO])) break; if (sp_ > XB_SPIN_CAP) { atomicAdd(&bar[XB_TMO], 1u); break; } } } }
    __builtin_amdgcn_fence(__ATOMIC_ACQUIRE, "agent");
    asm volatile("s_waitcnt vmcnt(0)" ::: "memory");
  }
  __syncthreads();
}

template <int PH>
__device__ __forceinline__ void run_phase(const Params& p, char* smem) {
  if constexpr (PH == 0) {
    transpose_convert(p.w_in, p.WinT, 1024, 3264, DINP, smem);
    transpose_convert(p.w_uq, p.WuqT, 384, 768, 768, smem);
    for (int i = blockIdx.x * NTHREADS + threadIdx.x; i < 512 * 256; i += gridDim.x * NTHREADS) {
      const int j = i >> 8, k = i & 255;
      const float* src = p.w_ukv + (size_t)k * 1024 + (j >> 6) * 128 + (j & 63);
      p.WkT[i] = f2bf(src[0]); p.WvT[i] = f2bf(src[64]);
    }
    transpose_convert(p.w_out, p.WoutT, 1536, 1024, 1024, smem);
    fold_peer(p, smem);
    ln_in_phase(p);
  } else if constexpr (PH == 1) {
    pg8::run(smem, p.h0, p.WinT, TP, DINP, 1024, pg8::EpiBf16S{p.z, 1024, 1024, p.xbc_raw, 1536, 2560, p.rest, 768});
  } else if constexpr (PH == 2) {
    conv_phase(p, smem);
    token_phase(p);
    dt_phase(p);
  } else if constexpr (PH == 3) {
    pg8::run(smem, p.cqn, p.WuqT, TX, 768, 384, pg8::EpiBf16S{p.q, 768, 1 << 30, nullptr, 0, 1 << 30, nullptr, 0});
    pg8::run(smem, p.ckvn, p.WkT, TP, 512, 256, pg8::EpiBf16S{p.Kb, 512, 1 << 30, nullptr, 0, 1 << 30, nullptr, 0}, 64);
    pg8::run(smem, p.WvT, p.ckvn, 512, TP, 256, pg8::EpiBf16S{p.vT, TP, 1 << 30, nullptr, 0, 1 << 30, nullptr, 0}, 120);
  } else if constexpr (PH == 4) {
    attn_phase(p, smem);
  } else if constexpr (PH == 5) {
    ssd_phase(p, smem);
  } else if constexpr (PH == 6) {
    gate_phase(p);
  } else if constexpr (PH == 7) {
    pg8::run(smem, p.ycat, p.WoutT, TX, 1024, 1536, pg8::EpiOutRes{p.pre, p.h0});
  } else if constexpr (PH == 8) {
    ln1_phase(p);
    quant_rows<true>(p.peer_u, p.Uq, p.su);
    quant_rows<false>(p.peer_v, p.Vq, p.sv);
  } else if constexpr (PH == 9) {
    pg8::run_drained(smem, p.h1, p.WpT, TX, 2048, 1024, pg8::EpiPeerScore{p.experts, p.gates});
  } else if constexpr (PH == 11) {
    peer_u_phase(p, smem);
  } else if constexpr (PH == 12) {
    peer_c_phase(p);
  } else if constexpr (PH == 13) {
    peer_v_phase(p, smem);
  } else if constexpr (PH == 14) {
    ln2_phase(p);
  } else if constexpr (PH == 15) {
    ssd_diag_phase(p, smem);
  }
}

__global__ void __launch_bounds__(NTHREADS) mega_kernel(Params p) {
  extern __shared__ __attribute__((aligned(16))) char smem[];
  cg::grid_group grid = cg::this_grid();
  volatile LAS unsigned* st = (volatile LAS unsigned*)(smem + LDS_BYTES - 32);
  if (threadIdx.x == 0) {
    st[0] = 0u; st[1] = 0u;
    const unsigned xcc = xb_xcc_id();
    st[2] = xcc; st[3] = xb_add(&p.bar[xcc], 1u);
  }
  __syncthreads();
  XcdBarrier xb = xcd_barrier_post(p.bar, st);
  run_phase<0>(p, smem);
  if (gridDim.x == 0u) grid.sync();
  xcd_barrier(xb);
  if (threadIdx.x == 0) {
    unsigned ok = (gridDim.x & 7u) == 0u ? 1u : 0u;
    for (unsigned j = 0; j < 16; ++j) { const unsigned c = xb_ld(&p.bar[j]); if (c != (j < 8 ? gridDim.x >> 3 : 0u)) ok = 0u; }
    st[4] = ok;
  }
  __syncthreads();
  run_phase<1>(p, smem); xcd_barrier(xb);
  run_phase<2>(p, smem); xcd_barrier(xb);
  run_phase<15>(p, smem); xcd_barrier(xb);
  run_phase<5>(p, smem); xcd_barrier(xb);
  run_phase<3>(p, smem); xcd_barrier(xb);
  run_phase<4>(p, smem); xcd_barrier(xb);
  run_phase<6>(p, smem); xcd_barrier(xb);
  run_phase<7>(p, smem); xcd_barrier(xb);
  run_phase<8>(p, smem); xcd_barrier(xb);
  run_phase<9>(p, smem); xcd_barrier(xb);
  run_phase<11>(p, smem); xcd_barrier(xb);
  run_phase<12>(p, smem); xcd_barrier(xb);
  run_phase<13>(p, smem); xcd_barrier(xb);
  run_phase<14>(p, smem);
}

extern "C" void kernel_launch(void* const* d_in, const int* in_sizes, int n_in,
                              void* d_out, int out_size, void* d_ws, size_t ws_size,
                              hipStream_t stream) {
  Params p{};
  const float** in = (const float**)&p.x_prompt;
  for (int i = 0; i < 28; ++i) in[i] = (const float*)d_in[i];
  p.out = (float*)d_out;
  char* ws = (char*)d_ws;
  size_t off = 0;
  auto take = [&](size_t bytes) { char* r = ws + off; off += (bytes + 255) & ~(size_t)255; return r; };
  p.h0 = (bf16_t*)take((size_t)TP * 1024 * 2);
  p.WinT = (bf16_t*)take((size_t)DINP * 1024 * 2);
  p.WuqT = (bf16_t*)take((size_t)768 * 384 * 2);
  p.WkT = (bf16_t*)take((size_t)512 * 256 * 2);
  p.WvT = (bf16_t*)take((size_t)512 * 256 * 2);
  p.WoutT = (bf16_t*)take((size_t)1024 * 1536 * 2);
  p.WpT = (bf16_t*)take((size_t)2048 * 1024 * 2);
  char* zreg = take((size_t)TP * 1024 * 2);
  char* r1 = take((size_t)TP * 1536 * 2);
  char* r2 = take((size_t)TP * 768 * 2);
  p.cqn = (bf16_t*)take((size_t)TP * 384 * 2);
  p.ckvn = (bf16_t*)take((size_t)TP * 256 * 2);
  p.kr = (bf16_t*)take((size_t)TP * 32 * 2);
  p.dtv = (float*)take((size_t)NSEQ * 2 * 16 * LP * 4);
  p.Pv = (float*)take((size_t)NSEQ * 2 * 16 * LP * 4);
  p.Atot = (float*)take((size_t)NSEQ * 2 * 16 * NCH * 4);
  p.bar = (unsigned*)take((size_t)XCD_BAR_WORDS * 4);
  if (off > ws_size) { fprintf(stderr, "workspace too small: need %zu have %zu\n", off, ws_size); return; }
  p.z = (bf16_t*)zreg;
  p.xbc_raw = (bf16_t*)r1;
  p.rest = (bf16_t*)r2;
  char* dout = (char*)d_out;
  p.XT = (bf16_t*)dout;
  p.Cm = (bf16_t*)(dout + (size_t)NSEQ * NCH * 16 * 64 * 128 * 2);
  p.Bm = p.Cm + (size_t)NSEQ * LP * 256;
  p.BmT = p.Bm + (size_t)NSEQ * LP * 256;
  p.pre = (bf16_t*)d_out;
  p.Kb = (bf16_t*)dout;
  p.vT = p.Kb + (size_t)TP * 512;
  p.o = p.vT + (size_t)512 * TP;
  p.Y = (bf16_t*)r1;
  p.Yb2 = p.Y + (size_t)TX * 1024;
  p.q = (bf16_t*)r2;
  p.ycat = (bf16_t*)r2;
  p.h1 = p.h0;
  p.Uq = (unsigned char*)zreg;
  p.Vq = p.Uq + (size_t)8 * 16384 * 128;
  p.su = (float*)(p.Vq + (size_t)8 * 16384 * 128);
  p.sv = p.su + 16384;
  p.sx = p.sv + 16384;
  p.h1q = (unsigned char*)(p.sx + (size_t)TX * 8);
  p.pd = (bf16_t*)d_out;
  p.cq = (unsigned char*)r2;
  p.csc = (float*)(r2 + (size_t)8 * 1024 * 1024);
  p.pre2 = (bf16_t*)(r2 + (size_t)16 * 1024 * 1024);
  p.experts = (unsigned short*)(r1 + (size_t)TX * 256 * 4);
  p.gates = (float*)(r1 + (size_t)TX * 256 * 4 + (size_t)TX * 128 * 4);

  static int grid_blocks = 0;
  if (!grid_blocks) {
    int dev = 0, cus = 0, per_cu = 0;
    (void)hipGetDevice(&dev);
    (void)hipDeviceGetAttribute(&cus, hipDeviceAttributeMultiprocessorCount, dev);
    (void)hipFuncSetAttribute((const void*)mega_kernel, hipFuncAttributeMaxDynamicSharedMemorySize, (int)LDS_BYTES);
    (void)hipOccupancyMaxActiveBlocksPerMultiprocessor(&per_cu, mega_kernel, NTHREADS, LDS_BYTES);
    if (per_cu > 1) per_cu = 1;
    grid_blocks = cus * per_cu;
  }
  (void)hipMemsetAsync(p.bar, 0, (size_t)XCD_BAR_WORDS * 4, stream);
  void* args[] = {&p};
  hipError_t e = hipLaunchCooperativeKernel((void*)mega_kernel, dim3(grid_blocks), dim3(NTHREADS), args, LDS_BYTES, stream);
  if (e != hipSuccess) fprintf(stderr, "cooperative launch failed: %s (grid %d)\n", hipGetErrorString(e), grid_blocks);
}
```
